# Optimizing an MI355X kernel written in HIP

```python
import math
import jax, jax.numpy as jnp
from jax import lax
import numpy as np

D_MODEL = 1024
BATCH = 16
SEQ = 2048
DEPTH = 1

HEAD_DIM = 64
D_RWKV = D_MODEL // 2
D_ATTN = D_MODEL - D_RWKV
H_RWKV = D_RWKV // HEAD_DIM
H_ATTN = D_ATTN // HEAD_DIM
DECAY_LORA = 64
ICLR_LORA = 64
GATE_LORA = 128
LNX_EPS = 64e-5
DIL_PATTERNS = ((128, 1), (512, 4), (2048, 16))
NEG_INF = -1e30
N_BUCKETS = 32
MAX_DISTANCE = 2048
N_GROUPS = 4
EXPERTS_PER_GROUP = 8
N_EXPERTS = N_GROUPS * EXPERTS_PER_GROUP
TOP_K = 2
D_EXPERT = 512
MOE_BLOCK = 128
D_PLE = 256
LN_EPS = 1e-5
ALPHA = (2 * DEPTH) ** 0.25
BETA = (8 * DEPTH) ** -0.25

kernel_name = "hymba_rwkv7_dilated_hmoe_deepnorm"


def layer_norm(x, g, b):
    xf = x.astype(jnp.float32)
    mu = jnp.mean(xf, -1, keepdims=True)
    var = jnp.mean(jnp.square(xf - mu), -1, keepdims=True)
    return ((xf - mu) * lax.rsqrt(var + LN_EPS) * g + b).astype(x.dtype)


def time_shift(t):
    return jnp.pad(t, ((0, 0), (1, 0), (0, 0)))[:, :-1]


def wkv7_scan(r, decay, k, v, aa, bb):
    B, S, H, N = r.shape

    def step(state, inp):
        r_t, w_t, k_t, v_t, a_t, b_t = inp
        sa = jnp.einsum('bhvk,bhk->bhv', state, a_t)
        state = (state * w_t[:, :, None, :] + sa[..., None] * b_t[:, :, None, :]
                 + v_t[..., None] * k_t[:, :, None, :])
        y_t = jnp.einsum('bhvk,bhk->bhv', state, r_t)
        return state, y_t

    xs = tuple(jnp.moveaxis(t, 1, 0) for t in (r, decay, k, v, aa, bb))
    state0 = jnp.zeros((B, H, N, N), jnp.float32)
    _, y = lax.scan(step, state0, xs)
    return jnp.moveaxis(y, 0, 1)


def rwkv7_mix(h, r_in, k_in, v_in, mu_rkv, mu_lora, w0, w1, w2, a0, a1, a2, g1, g2,
              k_k, k_a, r_k, lnx_g, lnx_b):
    B, S, _ = h.shape
    f32 = jnp.float32
    shift_mix = lambda t, mu: (t + (time_shift(t) - t) * mu).astype(f32)
    r = shift_mix(r_in, mu_rkv[0])
    k = shift_mix(k_in, mu_rkv[1])
    v = shift_mix(v_in, mu_rkv[2])
    dh = time_shift(h) - h
    xw = h + dh * mu_lora[0]
    xa = h + dh * mu_lora[1]
    xg = h + dh * mu_lora[2]
    w_log = -jax.nn.softplus(-(w0 + jnp.tanh(xw @ w1) @ w2).astype(f32)) - 0.5
    decay = jnp.exp(-jnp.exp(w_log))
    a = jax.nn.sigmoid((a0 + (xa @ a1) @ a2).astype(f32))
    g = (jax.nn.sigmoid(xg @ g1) @ g2).astype(f32)
    heads = lambda t: t.reshape(B, S, H_RWKV, HEAD_DIM)
    kk = heads(k * k_k)
    kk = kk * lax.rsqrt(jnp.maximum(jnp.sum(kk * kk, -1, keepdims=True), 1e-24))
    k = k * (1.0 + (a - 1.0) * k_a)
    r, k, v, a, decay = heads(r), heads(k), heads(v), heads(a), heads(decay)
    y = wkv7_scan(r, decay, k, v, -kk, kk * a)
    mu = jnp.mean(y, -1, keepdims=True)
    var = jnp.mean(jnp.square(y - mu), -1, keepdims=True)
    y = ((y - mu) * lax.rsqrt(var + LNX_EPS)).reshape(B, S, D_RWKV) * lnx_g + lnx_b
    bonus = jnp.sum(r * k * r_k, -1, keepdims=True) * v
    return ((y + bonus.reshape(B, S, D_RWKV)) * g).astype(h.dtype)


def t5_bucket(n):
    exact = N_BUCKETS // 2
    nf = np.maximum(n, 1).astype(np.float32)
    large = exact + (np.log(nf / exact) / math.log(MAX_DISTANCE / exact) * (N_BUCKETS - exact)).astype(np.int32)
    large = np.minimum(large, N_BUCKETS - 1)
    return np.where(n < exact, n, large).astype(np.int32)


def dilated_branch(q, k, v, rel_bias, window, dil):
    B, S, H, Dh = q.shape
    L = S // dil
    blk = window // dil
    nb = -(-L // blk)
    Lp = nb * blk

    def subsample(t):
        t = t.reshape(B, L, dil, H, Dh).transpose(0, 2, 3, 1, 4)
        return jnp.pad(t, ((0, 0), (0, 0), (0, 0), (0, Lp - L), (0, 0)))

    def band(t):
        t = jnp.pad(subsample(t), ((0, 0), (0, 0), (0, 0), (blk, 0), (0, 0))).reshape(B, dil, H, nb + 1, blk, Dh)
        return jnp.concatenate([t[:, :, :, :-1], t[:, :, :, 1:]], axis=4)

    qs = subsample(q).reshape(B, dil, H, nb, blk, Dh)
    kb, vb = band(k), band(v)
    rel = np.arange(blk)[:, None] + blk - np.arange(2 * blk)[None, :]
    kpos = np.arange(nb)[:, None] * blk + np.arange(2 * blk)[None, :] - blk
    valid = ((rel >= 0) & (rel <= blk))[None] & (kpos >= 0)[:, None, :]
    bias = jnp.transpose(rel_bias[t5_bucket(np.clip(rel, 0, None) * dil)], (2, 0, 1)).astype(jnp.float32)
    logits = jnp.einsum('bdhnqc,bdhnkc->bdhnqk', qs, kb) * (HEAD_DIM ** -0.5) + bias[None, None, :, None]
    logits = jnp.where(valid, logits, NEG_INF)
    m = jnp.max(logits, -1, keepdims=True)
    e = jnp.exp(logits - m)
    s = jnp.sum(e, -1, keepdims=True)
    o = jnp.einsum('bdhnqk,bdhnkc->bdhnqc', e, vb) / s
    lse = (m + jnp.log(s))[..., 0]

    def unsample(t):
        t = t.reshape(B, dil, H, Lp, *t.shape[5:])[:, :, :, :L]
        t = jnp.moveaxis(t, 3, 1)
        return t.reshape(B, S, H, *t.shape[4:])

    return unsample(o), unsample(lse)


def dilated_attention(q, k, v, rel_bias):
    outs, lses = [], []
    for window, dil in DIL_PATTERNS:
        o, l = dilated_branch(q, k, v, rel_bias, window, dil)
        outs.append(o)
        lses.append(l)
    wts = jax.nn.softmax(jnp.stack(lses, 0), axis=0)
    return jnp.einsum('pbsh,pbshc->bshc', wts, jnp.stack(outs, 0))


def hier_moe(x2, wr_g, br_g, wr_e, br_e, w_gate, w_up, w_down):
    N, D = x2.shape
    lg = (x2 @ wr_g).astype(jnp.float32) + br_g
    pg = jax.nn.softmax(lg, -1)
    grp = jnp.argmax(lg, -1)
    wg = jnp.take_along_axis(pg, grp[:, None], axis=-1)
    le = ((x2 @ wr_e).astype(jnp.float32) + br_e).reshape(N, N_GROUPS, EXPERTS_PER_GROUP)
    le = le[jnp.arange(N), grp]
    top_v, top_i = lax.top_k(le, TOP_K)
    we = jax.nn.softmax(top_v, -1) * wg
    eid = grp[:, None] * EXPERTS_PER_GROUP + top_i
    A = N * TOP_K
    e_flat = eid.reshape(A).astype(jnp.int32)
    w_flat = we.reshape(A)
    tok_flat = jnp.arange(A, dtype=jnp.int32) // TOP_K
    order = jnp.argsort(e_flat)
    e_sorted = e_flat[order]
    counts = jnp.bincount(e_flat, length=N_EXPERTS)
    start = jnp.cumsum(counts) - counts
    padded = (counts + MOE_BLOCK - 1) // MOE_BLOCK * MOE_BLOCK
    pend = jnp.cumsum(padded)
    pstart = pend - padded
    dest = pstart[e_sorted] + (jnp.arange(A) - start[e_sorted])
    nblk = -(-A // MOE_BLOCK) + N_EXPERTS
    P = nblk * MOE_BLOCK
    row_tok = jnp.zeros((P,), jnp.int32).at[dest].set(tok_flat[order])
    row_w = jnp.zeros((P,), jnp.float32).at[dest].set(w_flat[order])
    blk_e = jnp.minimum(jnp.searchsorted(pend, jnp.arange(nblk) * MOE_BLOCK, side='right'), N_EXPERTS - 1)
    xb = x2[row_tok].reshape(nblk, MOE_BLOCK, D)

    def run_block(args):
        xblk, e = args
        hdn = jax.nn.silu(xblk @ w_gate[e]) * (xblk @ w_up[e])
        return hdn @ w_down[e]

    yb = lax.map(run_block, (xb, blk_e)).reshape(P, D)
    return jnp.zeros((N, D), x2.dtype).at[row_tok].add((yb * row_w[:, None]).astype(x2.dtype))


def setup_inputs(seed: int = 0) -> dict:
    key = jax.random.key(seed)
    ks = iter(jax.random.split(key, 48))
    nrm = lambda shape, scale: jax.random.normal(next(ks), shape, jnp.float32) * scale
    L = DEPTH
    ramp = jnp.arange(D_RWKV, dtype=jnp.float32) / (D_RWKV - 1)
    d_in = 3 * D_RWKV + 3 * D_ATTN
    return {
        "x": nrm((BATCH, SEQ, D_MODEL), 1.0),
        "p": nrm((DEPTH, BATCH, SEQ, D_PLE), 1.0),
        "w_in": nrm((L, D_MODEL, d_in), D_MODEL ** -0.5),
        "mu_rkv": jax.random.uniform(next(ks), (L, 3, D_RWKV), jnp.float32),
        "mu_lora": jax.random.uniform(next(ks), (L, 3, D_MODEL), jnp.float32),
        "w0": (-6.5 + 5.0 * ramp ** 0.85)[None] + nrm((L, D_RWKV), 0.1),
        "w_lora1": nrm((L, D_MODEL, DECAY_LORA), D_MODEL ** -0.5),
        "w_lora2": nrm((L, DECAY_LORA, D_RWKV), 0.5 * DECAY_LORA ** -0.5),
        "a0": nrm((L, D_RWKV), 0.1),
        "a_lora1": nrm((L, D_MODEL, ICLR_LORA), D_MODEL ** -0.5),
        "a_lora2": nrm((L, ICLR_LORA, D_RWKV), ICLR_LORA ** -0.5),
        "g_lora1": nrm((L, D_MODEL, GATE_LORA), D_MODEL ** -0.5),
        "g_lora2": nrm((L, GATE_LORA, D_RWKV), GATE_LORA ** -0.5),
        "k_k": 0.85 + nrm((L, D_RWKV), 0.02),
        "k_a": 1.0 + nrm((L, D_RWKV), 0.02),
        "r_k": nrm((L, H_RWKV, HEAD_DIM), 0.1),
        "lnx_g": 1.0 + nrm((L, D_RWKV), 0.02),
        "lnx_b": nrm((L, D_RWKV), 0.02),
        "rel_bias": nrm((N_BUCKETS, H_ATTN), 0.5),
        "w_o": nrm((L, D_MODEL, D_MODEL), BETA * D_MODEL ** -0.5),
        "ln1_g": 1.0 + nrm((L, D_MODEL), 0.02),
        "ln1_b": nrm((L, D_MODEL), 0.02),
        "router_g": nrm((L, D_MODEL, N_GROUPS), D_MODEL ** -0.5),
        "router_g_b": nrm((L, N_GROUPS), 0.01),
        "router_e": nrm((L, D_MODEL, N_EXPERTS), D_MODEL ** -0.5),
        "router_e_b": nrm((L, N_EXPERTS), 0.01),
        "w_gate": nrm((L, N_EXPERTS, D_MODEL, D_EXPERT), D_MODEL ** -0.5),
        "w_up": nrm((L, N_EXPERTS, D_MODEL, D_EXPERT), D_MODEL ** -0.5),
        "w_down": nrm((L, N_EXPERTS, D_EXPERT, D_MODEL), BETA * D_EXPERT ** -0.5),
        "ple_gate": nrm((L, D_MODEL, D_MODEL), D_MODEL ** -0.5),
        "ple_proj": nrm((L, D_PLE, D_MODEL), BETA * D_PLE ** -0.5),
        "ln2_g": 1.0 + nrm((L, D_MODEL), 0.02),
        "ln2_b": nrm((L, D_MODEL), 0.02),
    }


def reference(x, p, w_in, mu_rkv, mu_lora, w0, w_lora1, w_lora2, a0, a_lora1, a_lora2,
              g_lora1, g_lora2, k_k, k_a, r_k, lnx_g, lnx_b, rel_bias, w_o, ln1_g, ln1_b,
              router_g, router_g_b, router_e, router_e_b, w_gate, w_up, w_down,
              ple_gate, ple_proj, ln2_g, ln2_b):
    B, S, D = x.shape
    splits = [D_RWKV, 2 * D_RWKV, 3 * D_RWKV, 3 * D_RWKV + D_ATTN, 3 * D_RWKV + 2 * D_ATTN]
    for i in range(DEPTH):
        h = x
        proj = h @ w_in[i]
        r_in, k_in, v_in, q_at, k_at, v_at = jnp.split(proj, splits, axis=-1)
        y_rwkv = rwkv7_mix(h, r_in, k_in, v_in, mu_rkv[i], mu_lora[i], w0[i], w_lora1[i], w_lora2[i],
                           a0[i], a_lora1[i], a_lora2[i], g_lora1[i], g_lora2[i],
                           k_k[i], k_a[i], r_k[i], lnx_g[i], lnx_b[i])
        to_heads = lambda t: t.astype(jnp.float32).reshape(B, S, H_ATTN, HEAD_DIM)
        y_att = dilated_attention(to_heads(q_at), to_heads(k_at), to_heads(v_at), rel_bias)
        y_att = y_att.reshape(B, S, D_ATTN).astype(x.dtype)
        mix = jnp.concatenate([y_rwkv, y_att], axis=-1) @ w_o[i]
        x = layer_norm(ALPHA * x + mix, ln1_g[i], ln1_b[i])
        moe = hier_moe(x.reshape(B * S, D), router_g[i], router_g_b[i], router_e[i], router_e_b[i],
                       w_gate[i], w_up[i], w_down[i]).reshape(B, S, D)
        ple = jax.nn.sigmoid(x @ ple_gate[i]) * (p[i] @ ple_proj[i])
        x = layer_norm(ALPHA * x + moe + ple, ln2_g[i], ln2_b[i])
    return x
```

```cpp
#include <hip/hip_runtime.h>
#include <cstdio>
#include <cstdint>

#ifndef MK_ONE_LAUNCH
#define MK_ONE_LAUNCH 0
#endif

#define GAS __attribute__((address_space(1)))
#define LAS __attribute__((address_space(3)))
typedef unsigned short bf16_t;
typedef short bf16x8 __attribute__((ext_vector_type(8)));
typedef float f32x4 __attribute__((ext_vector_type(4)));
typedef float f32x2 __attribute__((ext_vector_type(2)));
typedef unsigned u32x4 __attribute__((ext_vector_type(4)));
typedef unsigned u32x2 __attribute__((ext_vector_type(2)));
#define RLX_AGENT __ATOMIC_RELAXED, __HIP_MEMORY_SCOPE_AGENT
#define LDS_WAIT() asm volatile("s_waitcnt lgkmcnt(0)" ::: "memory")
#define VM_WAIT() asm volatile("s_waitcnt vmcnt(0)" ::: "memory")

__device__ __forceinline__ unsigned f2bf(float f) { unsigned u = __builtin_bit_cast(unsigned, f); return (u + 0x7fffu + ((u >> 16) & 1u)) >> 16; }
__device__ __forceinline__ unsigned pk2(float lo, float hi) { return f2bf(lo) | (f2bf(hi) << 16); }
__device__ __forceinline__ float bf_lo(unsigned w) { return __builtin_bit_cast(float, w << 16); }
__device__ __forceinline__ float bf_hi(unsigned w) { return __builtin_bit_cast(float, w & 0xffff0000u); }
__device__ __forceinline__ float bf2f(bf16_t b) { return __builtin_bit_cast(float, ((unsigned)b) << 16); }
__device__ __forceinline__ float sigmoidf_(float z) { return __builtin_amdgcn_rcpf(1.0f + __builtin_amdgcn_exp2f(-1.4426950408889634f * z)); }
__device__ __forceinline__ float wave_sum(float v) {
#pragma unroll
    for (int o = 1; o < 64; o <<= 1) v += __shfl_xor(v, o);
    return v;
}

namespace pg8 {
constexpr int BM = 256, BK = 64, HALF = 128, HTB = HALF * BK * 2, STAGE_BYTES = 8 * HTB, NXCD = 8, WGM = 8;
__host__ __device__ __forceinline__ int lds_byte(int r, int c) { const int st = (r >> 4) * 2 + (c >> 5), rr = r & 15, cc = c & 31, ob = rr * 64 + cc * 2; return st * 1024 + (ob ^ (((ob >> 9) & 1) << 5)); }
__host__ __device__ __forceinline__ void stage_rc(int b, int& R, int& C) { const int st = b / 1024, sb = b % 1024, swz = sb ^ (((sb >> 9) & 1) << 5); R = (st >> 1) * 16 + swz / 64; C = (st & 1) * 32 + (swz % 64) / 2; }
__host__ __device__ __forceinline__ int perm32(int rho) { const int n = rho >> 4, i = rho & 15; return 8 * (i >> 2) + 4 * n + (i & 3); }

struct Unit { int pm, pn, pb; };
struct Gemm { const bf16_t* A; const bf16_t* Bt; int K; };

struct StaticOrder {
    static constexpr bool GATHER = false;
    int nM, nN, nwg, G, c;
    __device__ void init(int M, int N, int G_, int c_) { nM = M / BM; nN = N / BM; nwg = nM * nN; G = G_; c = c_; }
    __device__ bool next(int i, Unit& u) const {
        const long L = (long)i * G + c; if (L >= nwg) return false;
        int wgid = (int)L; { const int q = nwg / NXCD, r = nwg % NXCD, xcd = wgid % NXCD, off = wgid / NXCD; wgid = (xcd < r ? xcd * (q + 1) : r * (q + 1) + (xcd - r) * q) + off; }
        const int nig = WGM * nN, gid = wgid / nig, fm = gid * WGM, gsz = (nM - fm) < WGM ? (nM - fm) : WGM;
        u.pm = fm + ((wgid % nig) % gsz); u.pn = (wgid % nig) / gsz; u.pb = u.pn; return true;
    }
    __device__ __forceinline__ unsigned a_row_off(const Unit&, int, unsigned) const { return 0u; }
};
template <bool GATHER_> struct MoeOrder {
    static constexpr bool GATHER = GATHER_;
    const int* tile_e; const int* row_tok; int ntiles, G, c;
    __device__ bool next(int i, Unit& u) const {
        const long L = (long)i * G + c; if (L >= (long)ntiles * 4) return false;
        const int tile = (int)(L >> 2), pn = (int)(L & 3);
        u.pm = tile; u.pn = pn; u.pb = tile_e[tile] * 4 + pn; return true;
    }
    __device__ __forceinline__ unsigned a_row_off(const Unit& u, int r, unsigned rowbytes) const { return (unsigned)row_tok[u.pm * 256 + r] * rowbytes; }
};

__device__ __forceinline__ unsigned cvt_pk_bf16(float lo, float hi) { unsigned r; asm volatile("v_cvt_pk_bf16_f32 %0, %1, %2" : "=v"(r) : "v"(lo), "v"(hi)); return r; }

template <class Epi, class Sched>
__device__ __forceinline__ void gemm_phase(LAS unsigned char* lds, const Gemm g, const Sched& S, const Epi& E) {
    const int tid = threadIdx.x, wid = __builtin_amdgcn_readfirstlane(tid >> 6), lane = tid & 63, wr = wid >> 2, wc = wid & 3, fr = lane & 15, fq = lane >> 4;
    const int K = g.K, nt = K / BK;
    int Rr[2], Cc[2];
    unsigned voffB[2];
#pragma unroll
    for (int i = 0; i < 2; ++i) { int R, C; stage_rc(tid * 16 + i * 8192, R, C); const int Rb = Epi::PERM ? ((R & ~31) + perm32(R & 31)) : R;
        Rr[i] = R; Cc[i] = C; voffB[i] = (unsigned)(Rb * K + C) * 2u; }
    const unsigned rowbytes = (unsigned)K * 2u;
    const size_t kstep = (size_t)(BK * 2);
    const size_t hstep = (size_t)HALF * K * 2;
    const size_t tstep = 2 * hstep;
    const unsigned ldsw = (unsigned)wid * 1024u;
    const int aoff = lds_byte(wr * 64 + fr, fq * 8), boff = lds_byte(wc * 32 + fr, fq * 8);
#define PG8_SA(b, h) (((b) * 2 + (h)) * HTB)
#define PG8_SB(b, h) ((4 + (b) * 2 + (h)) * HTB)
#define PG8_STAGE(bufoff, gbase, voff) do { _Pragma("unroll") for (int _i = 0; _i < 2; ++_i) \
        __builtin_amdgcn_global_load_lds((const unsigned*)((const char*)(gbase) + (voff)[_i]), (LAS unsigned*)(lds + (bufoff) + ldsw + _i * 8192), 16, 0, 0); } while (0)
#define PG8_STAGE_A(bufoff, gbase, vv, h) do { _Pragma("unroll") for (int _i = 0; _i < 2; ++_i) \
        __builtin_amdgcn_global_load_lds((const unsigned*)((const char*)(gbase) + (vv)[h][_i]), (LAS unsigned*)(lds + (bufoff) + ldsw + _i * 8192), 16, 0, 0); } while (0)
#define PG8_LDA(dst, b, h) do { _Pragma("unroll") for (int m = 0; m < 4; ++m) _Pragma("unroll") for (int k = 0; k < 2; ++k) dst[m][k] = *(const LAS bf16x8*)(lds + PG8_SA(b, h) + aoff + m * 2048 + k * 1024); } while (0)
#define PG8_LDB(dst, b, h) do { _Pragma("unroll") for (int n = 0; n < 2; ++n) _Pragma("unroll") for (int k = 0; k < 2; ++k) dst[n][k] = *(const LAS bf16x8*)(lds + PG8_SB(b, h) + boff + n * 2048 + k * 1024); } while (0)
#define PG8_MMA(ai, bj, At, Bt) do { __builtin_amdgcn_s_setprio(1); _Pragma("unroll") for (int m = 0; m < 4; ++m) _Pragma("unroll") for (int n = 0; n < 2; ++n) _Pragma("unroll") for (int k = 0; k < 2; ++k) \
        acc[ai][bj][m][n] = __builtin_amdgcn_mfma_f32_16x16x32_bf16(Bt[n][k], At[m][k], acc[ai][bj][m][n], 0, 0, 0); __builtin_amdgcn_s_setprio(0); } while (0)
#define PG8_WAIT_V(n) asm volatile("s_waitcnt vmcnt(" #n ")" ::: "memory")
#define PG8_WAIT_L(n) asm volatile("s_waitcnt lgkmcnt(" #n ")" ::: "memory")
#define PG8_BAR __builtin_amdgcn_s_barrier()
#define PG8_SCHED __builtin_amdgcn_sched_barrier(0)
#define PG8_SETOFF(vv, uu) do { _Pragma("unroll") for (int _h = 0; _h < 2; ++_h) _Pragma("unroll") for (int _i = 0; _i < 2; ++_i) { \
        if constexpr (Sched::GATHER) (vv)[_h][_i] = S.a_row_off((uu), _h * HALF + Rr[_i], rowbytes) + (unsigned)Cc[_i] * 2u; \
        else (vv)[_h][_i] = (unsigned)((_h * HALF + Rr[_i]) * K + Cc[_i]) * 2u; } } while (0)
    Unit cur, nxt; int ui = 0;
    if (!S.next(0, cur)) return;
    f32x4 acc[2][2][4][2];
#pragma unroll
    for (int a = 0; a < 2; ++a)
#pragma unroll
        for (int b = 0; b < 2; ++b)
#pragma unroll
            for (int m = 0; m < 4; ++m)
#pragma unroll
                for (int n = 0; n < 2; ++n) acc[a][b][m][n] = (f32x4){0.f, 0.f, 0.f, 0.f};
    bf16x8 At[4][2], B0[2][2], B1[2][2];
    unsigned vAc[2][2], vAn[2][2];
    PG8_SETOFF(vAc, cur);
    const char* cA = Sched::GATHER ? (const char*)g.A : (const char*)g.A + (size_t)cur.pm * tstep;
    const char* cB = (const char*)g.Bt + (size_t)cur.pb * tstep;
    PG8_STAGE(PG8_SB(0, 0), cB, voffB); PG8_STAGE(PG8_SB(0, 1), cB + hstep, voffB); PG8_STAGE_A(PG8_SA(0, 0), cA, vAc, 0); PG8_STAGE_A(PG8_SA(0, 1), cA, vAc, 1);
    if (wr == 1) PG8_BAR;
    PG8_WAIT_V(2); PG8_BAR;
    PG8_STAGE(PG8_SB(1, 0), cB + kstep, voffB); PG8_STAGE_A(PG8_SA(1, 0), cA + kstep, vAc, 0); PG8_STAGE(PG8_SB(1, 1), cB + hstep + kstep, voffB);
    PG8_WAIT_V(6); PG8_BAR;
    for (;;) {
        const bool has_next = S.next(ui + 1, nxt);
        const char* nA = cA; const char* nB = cB;
        if (has_next) { nA = Sched::GATHER ? (const char*)g.A : (const char*)g.A + (size_t)nxt.pm * tstep; nB = (const char*)g.Bt + (size_t)nxt.pb * tstep; }
        if constexpr (Sched::GATHER) {
            if (has_next) { PG8_SETOFF(vAn, nxt); }
            else {
#pragma unroll
                for (int h = 0; h < 2; ++h)
#pragma unroll
                    for (int i = 0; i < 2; ++i) vAn[h][i] = vAc[h][i];
            }
        }
#pragma unroll 1
        for (int t = 0; t < nt; t += 2) {
            const bool last = (t == nt - 2);
            const char* a1 = cA + (size_t)(t + 1) * kstep;
            const char* a2 = last ? nA : cA + (size_t)(t + 2) * kstep; const char* b2 = last ? nB : cB + (size_t)(t + 2) * kstep;
            const char* a3 = a2 + kstep; const char* b3 = b2 + kstep;
            unsigned vs[2][2];
#pragma unroll
            for (int h = 0; h < 2; ++h)
#pragma unroll
                for (int i = 0; i < 2; ++i) { if constexpr (Sched::GATHER) vs[h][i] = last ? vAn[h][i] : vAc[h][i]; else vs[h][i] = vAc[h][i]; }
            PG8_LDB(B0, 0, 0); PG8_LDB(B1, 0, 1); PG8_SCHED; PG8_LDA(At, 0, 0); PG8_STAGE_A(PG8_SA(1, 1), a1, vAc, 1);
            PG8_WAIT_V(8); PG8_WAIT_L(0); PG8_BAR; PG8_MMA(0, 0, At, B0); PG8_MMA(0, 1, At, B1); PG8_BAR; PG8_SCHED;
            PG8_LDA(At, 0, 1); PG8_STAGE(PG8_SB(0, 0), b2, voffB); PG8_STAGE(PG8_SB(0, 1), b2 + hstep, voffB); PG8_STAGE_A(PG8_SA(0, 0), a2, vs, 0);
            PG8_WAIT_V(8); PG8_WAIT_L(0); PG8_BAR; PG8_MMA(1, 0, At, B0); PG8_MMA(1, 1, At, B1); PG8_BAR; PG8_SCHED;
            PG8_LDB(B0, 1, 0); PG8_LDB(B1, 1, 1); PG8_SCHED; PG8_LDA(At, 1, 0); PG8_STAGE_A(PG8_SA(0, 1), a2, vs, 1);
            PG8_WAIT_V(8); PG8_WAIT_L(0); PG8_BAR; PG8_MMA(0, 0, At, B0); PG8_MMA(0, 1, At, B1); PG8_BAR; PG8_SCHED;
            PG8_LDA(At, 1, 1); PG8_STAGE(PG8_SB(1, 0), b3, voffB); PG8_STAGE(PG8_SB(1, 1), b3 + hstep, voffB); PG8_STAGE_A(PG8_SA(1, 0), a3, vs, 0);
            PG8_WAIT_V(8); PG8_WAIT_L(0); PG8_BAR; PG8_MMA(1, 0, At, B0); PG8_MMA(1, 1, At, B1); PG8_BAR; PG8_SCHED;
        }
        if (wr == 0) PG8_BAR;
        E(acc, cur, wr, wc, fr, fq);
        if (!has_next) break;
#pragma unroll
        for (int a = 0; a < 2; ++a)
#pragma unroll
            for (int b = 0; b < 2; ++b)
#pragma unroll
                for (int m = 0; m < 4; ++m)
#pragma unroll
                    for (int n = 0; n < 2; ++n) acc[a][b][m][n] = (f32x4){0.f, 0.f, 0.f, 0.f};
        cur = nxt; cA = nA; cB = nB; ++ui;
        if constexpr (Sched::GATHER) {
#pragma unroll
            for (int h = 0; h < 2; ++h)
#pragma unroll
                for (int i = 0; i < 2; ++i) vAc[h][i] = vAn[h][i];
        }
        if (wr == 1) PG8_BAR;
    }
    PG8_WAIT_V(0);
    PG8_BAR;
#undef PG8_SA
#undef PG8_SB
#undef PG8_STAGE
#undef PG8_STAGE_A
#undef PG8_LDA
#undef PG8_LDB
#undef PG8_MMA
#undef PG8_WAIT_V
#undef PG8_WAIT_L
#undef PG8_BAR
#undef PG8_SCHED
#undef PG8_SETOFF
}
}

#define XB_TMO      128
#define XB_XCNT(j)  (256  + 64 * (j))
#define XB_XSUB(j)  (1280 + 64 * (j))
#define XB_XGEN(j)  (2304 + 64 * (j))
#define XB_TOP      3328
#define XB_TOPGEN   3392
#define XCD_BAR_WORDS 3456
#define XB_SPIN_CAP (1u << 18)
__device__ __forceinline__ unsigned xb_ld(unsigned* p)              { return __hip_atomic_load(p, __ATOMIC_RELAXED, __HIP_MEMORY_SCOPE_AGENT); }
__device__ __forceinline__ unsigned xb_add(unsigned* p, unsigned v) { return __hip_atomic_fetch_add(p, v, __ATOMIC_RELAXED, __HIP_MEMORY_SCOPE_AGENT); }
__device__ __forceinline__ unsigned xb_xcc_id() { return (unsigned)__builtin_amdgcn_s_getreg((3 << 11) | 20) & 0xFu; }
#define XB_SPIN(cond, bar) do { unsigned _sp = 0; while (cond) { __builtin_amdgcn_s_sleep(1); \
    if ((++_sp & 255u) == 0u) { if (xb_ld(&(bar)[XB_TMO])) break; if (_sp > XB_SPIN_CAP) { atomicAdd(&(bar)[XB_TMO], 1u); break; } } } } while (0)
struct XcdBarrier { unsigned* bar; unsigned x; volatile LAS unsigned* st; };
__device__ __forceinline__ XcdBarrier xcd_barrier_post(unsigned* bar, volatile LAS unsigned* st) {
    XcdBarrier b; b.bar = bar; b.x = xb_xcc_id(); b.st = st;
    if (threadIdx.x == 0) (void)xb_add(&bar[XB_XCNT(b.x)], 1u);
    return b;
}
__device__ __forceinline__ void xcd_barrier_complete(unsigned* bar, unsigned x, unsigned& nloc, unsigned& nx) {
    const unsigned G = gridDim.x * gridDim.y * gridDim.z;
    unsigned sum, cnt, mine, sp = 0u;
    for (;;) {
        sum = 0u; cnt = 0u; mine = 0u;
#pragma unroll
        for (unsigned j = 0; j < 16; ++j) { const unsigned c = xb_ld(&bar[XB_XCNT(j)]); sum += c; cnt += (c > 0u) ? 1u : 0u; mine = (j == x) ? c : mine; }
        if (sum == G) break;
        __builtin_amdgcn_s_sleep(1);
        if ((++sp & 255u) == 0u) { if (xb_ld(&bar[XB_TMO])) break; if (sp > XB_SPIN_CAP) { atomicAdd(&bar[XB_TMO], 1u); break; } }
    }
    nloc = mine > 0u ? mine : 1u; nx = cnt > 0u ? cnt : 1u;
}
__device__ __forceinline__ void xcd_barrier(const XcdBarrier& b) {
    asm volatile("s_waitcnt vmcnt(0)" ::: "memory");
    __syncthreads();
    if (threadIdx.x == 0) {
        unsigned* bar = b.bar;
        __builtin_amdgcn_s_waitcnt(0);
        unsigned nloc = b.st[0], nx = b.st[1];
        if (nloc == 0u) { xcd_barrier_complete(bar, b.x, nloc, nx); b.st[0] = nloc; b.st[1] = nx; }
        const unsigned old = xb_add(&bar[XB_XSUB(b.x)], 1u);
        const unsigned gen = old / nloc;
        if (old + 1u == (gen + 1u) * nloc) {
            __builtin_amdgcn_fence(__ATOMIC_RELEASE, "agent");
            asm volatile("s_waitcnt vmcnt(0)" ::: "memory");
            const unsigned og = xb_add(&bar[XB_TOP], 1u);
            const unsigned tg = og / nx;
            if (og + 1u == (tg + 1u) * nx) xb_add(&bar[XB_TOPGEN], 1u);
            else XB_SPIN(xb_ld(&bar[XB_TOPGEN]) == tg, bar);
            __builtin_amdgcn_fence(__ATOMIC_ACQUIRE, "agent");
            xb_add(&bar[XB_XGEN(b.x)], 1u);
            asm volatile("s_waitcnt vmcnt(0)" ::: "memory");
        } else {
            XB_SPIN(xb_ld(&bar[XB_XGEN(b.x)]) == gen, bar);
            __builtin_amdgcn_fence(__ATOMIC_ACQUIRE, "agent");
            asm volatile("s_waitcnt vmcnt(0)" ::: "memory");
        }
    }
    __syncthreads();
}

constexpr int NWAVES = 8;
constexpr int SEQ = 2048, NB = 16, DM = 1024, NTOK = NB * SEQ;
constexpr int DRW = 512, HD = 64;
constexpr int NPROJ = 3072, NEXT = 3584, NL1 = 512, KL2 = 256, NL2 = 1536;
constexpr int NEXP = 32, DEXP = 512;
constexpr int PROWS_MAX = 65536 + 32 * 256, MAXTILES = PROWS_MAX / 256;
constexpr float LN_EPS = 1e-5f, LNX_EPS = 64e-5f, ALPHA = 1.189207115002721f;

constexpr size_t MiB = 1u << 20;
constexpr size_t WS_CTL = 0, CTL_ZERO_BYTES = 1 * MiB;
constexpr size_t WS_WINT = 1 * MiB;
constexpr size_t WS_W2T = 8 * MiB;
constexpr size_t WS_WOT = 9 * MiB;
constexpr size_t WS_GT = 11 * MiB;
constexpr size_t WS_PT = 13 * MiB;
constexpr size_t WS_BIAS = 13 * MiB + 512 * 1024;
constexpr size_t WS_TOKE = 14 * MiB;
constexpr size_t WS_TOKW = 14 * MiB + 256 * 1024;
constexpr size_t WS_ROWTOK = 14 * MiB + 512 * 1024;
constexpr size_t WS_ROWASG = 15 * MiB;
constexpr size_t WS_ROWW = 15 * MiB + 512 * 1024;
constexpr size_t WS_PB = 16 * MiB;
constexpr size_t WS_X1 = 33 * MiB;
constexpr size_t WS_XB = WS_X1, WS_LORA1 = WS_X1 + 64 * MiB;
constexpr size_t WS_LW = WS_X1, WS_AG = WS_X1 + 64 * MiB;
constexpr size_t WS_P = 161 * MiB;
constexpr size_t WS_WGUT = WS_P, WS_WDT = WS_P + 64 * MiB, WS_HDN = WS_P + 96 * MiB, WS_MOEHI = WS_P;
constexpr size_t WS_Y = 353 * MiB;
constexpr size_t WS_END = 417 * MiB;
constexpr int BIAS_LD = 132;
constexpr int CW_BAR = 4096;
constexpr int CW_CNT = 8192, CW_FILL = 8192 + 64, CW_NTILES = 8192 + 128, CW_TILEE = 8192 + 256;

constexpr int RING_OFF = 0, RING_BYTES = 131072;
constexpr int WRT_BYTES = 36 * 1024 * 4;
constexpr int LDSCTL_OFF = WRT_BYTES, MISC_OFF = LDSCTL_OFF;
constexpr int LDS_BYTES = LDSCTL_OFF + 1024;
constexpr int MW_HIST = 0, MW_CNT = 32, MW_RS = 64, MW_LBASE = 96, MW_LFILL = 128, MW_BAR = 160;

struct Frame {
    LAS unsigned char* lds;
    volatile LAS unsigned* MISC;
    unsigned* ctl;
    int tid, lane, wave, vcu, G;
    unsigned char* ws;
    const float* const* in;
    float* out;
};
enum InIdx { I_X = 0, I_P, I_WIN, I_MURKV, I_MULORA, I_W0, I_WL1, I_WL2, I_A0, I_AL1, I_AL2, I_GL1, I_GL2, I_KK, I_KA, I_RK, I_LNXG, I_LNXB, I_RELB, I_WO,
             I_LN1G, I_LN1B, I_RG, I_RGB, I_RE, I_REB, I_WG, I_WU, I_WD, I_PG, I_PP, I_LN2G, I_LN2B };

__device__ __forceinline__ void tr_item(const float* W, int ldw, int k0, int n0, bf16_t* dst, int ldt, const float* mu, int smode, LAS float* scr, int lane) {
#pragma unroll 8
    for (int i = 0; i < 32; ++i) { const int kk = 2 * i + (lane >> 5); float v = W[(size_t)(k0 + kk) * ldw + n0 + (lane & 31)];
        if (smode == 1) v *= (1.0f - mu[k0 + kk]); else if (smode == 2) v *= mu[k0 + kk];
        scr[kk * 33 + (lane & 31)] = v; }
    LDS_WAIT(); asm volatile("" ::: "memory");
    const int c = lane & 7;
#pragma unroll
    for (int j = 0; j < 4; ++j) { const int n = (lane >> 3) + 8 * j; const LAS float* s = scr + (8 * c) * 33 + n;
        u32x4 o; o.x = pk2(s[0 * 33], s[1 * 33]); o.y = pk2(s[2 * 33], s[3 * 33]); o.z = pk2(s[4 * 33], s[5 * 33]); o.w = pk2(s[6 * 33], s[7 * 33]);
        *(u32x4*)(dst + (size_t)n * ldt + k0 + 8 * c) = o; }
    LDS_WAIT(); asm volatile("" ::: "memory");
}
__device__ __forceinline__ int t5_bucket(int n) {
    if (n < 16) return n;
    int b = 16;
    b += (n >= 22); b += (n >= 30); b += (n >= 40); b += (n >= 54); b += (n >= 73); b += (n >= 99); b += (n >= 134); b += (n >= 182);
    b += (n >= 246); b += (n >= 332); b += (n >= 450); b += (n >= 609); b += (n >= 825); b += (n >= 1117); b += (n >= 1513);
    return b;
}

__device__ __forceinline__ void ph_prologue(Frame& F) {
    const int gt = F.vcu * 512 + F.tid, NGT = F.G * 512;
    const int gw = F.vcu * NWAVES + F.wave, NGW = F.G * NWAVES;
    { const f32x4* x4 = (const f32x4*)F.in[I_X]; u32x4* o = (u32x4*)(F.ws + WS_XB);
      for (int i = gt; i < NTOK * DM / 8; i += NGT) { const f32x4 a = x4[2 * i], b = x4[2 * i + 1]; u32x4 w; w.x = pk2(a.x, a.y); w.y = pk2(a.z, a.w); w.z = pk2(b.x, b.y); w.w = pk2(b.z, b.w); o[i] = w; } }
    { const f32x4* x4 = (const f32x4*)F.in[I_P]; u32x4* o = (u32x4*)(F.ws + WS_PB);
      for (int i = gt; i < NTOK * 256 / 8; i += NGT) { const f32x4 a = x4[2 * i], b = x4[2 * i + 1]; u32x4 w; w.x = pk2(a.x, a.y); w.y = pk2(a.z, a.w); w.z = pk2(b.x, b.y); w.w = pk2(b.z, b.w); o[i] = w; } }
    { bf16_t* w2t = (bf16_t*)(F.ws + WS_W2T);
      for (int i = gt; i < NL2 * KL2; i += NGT) { const int n = i / KL2, k = i % KL2; float v = 0.f;
          if (n < 512) { if (k < 64) v = F.in[I_WL2][k * 512 + n]; }
          else if (n < 1024) { if (k >= 64 && k < 128) v = F.in[I_AL2][(k - 64) * 512 + (n - 512)]; }
          else { if (k >= 128) v = F.in[I_GL2][(k - 128) * 512 + (n - 1024)]; }
          w2t[i] = (bf16_t)f2bf(v); } }
    { float* bt = (float*)(F.ws + WS_BIAS);
      for (int i = gt; i < 3 * 8 * BIAS_LD; i += NGT) { const int p = i / (8 * BIAS_LD), h = (i / BIAS_LD) % 8, m = i % BIAS_LD; const int dil = 1 << (2 * p);
          bt[i] = (m <= 128) ? F.in[I_RELB][t5_bucket(m * dil) * 8 + h] : 0.f; } }
    LAS float* scr = (LAS float*)(F.lds + RING_OFF + F.wave * 16384);
    constexpr int IT_WIN = 16 * 96, IT_L1 = 256, IT_WO = 512, IT_G = 512, IT_PP = 128;
    constexpr int NIT = IT_WIN + IT_L1 + IT_WO + IT_G + IT_PP;
    bf16_t* WinT = (bf16_t*)(F.ws + WS_WINT);
    for (int it = gw; it < NIT; it += NGW) {
        int r = it;
        if (r < IT_WIN) { const int kb = r / 96, nb = r % 96; tr_item(F.in[I_WIN], NPROJ, kb * 64, nb * 32, WinT + (size_t)(nb * 32) * DM, DM, nullptr, 0, scr, F.lane); continue; } r -= IT_WIN;
        if (r < IT_L1) {
            int piece, sub;
            if (r < 128) { piece = r / 32; sub = r % 32; } else { piece = 4 + (r - 128) / 64; sub = (r - 128) % 64; }
            const int which = piece >> 1, isprev = piece & 1;
            const int ncols = (which == 2) ? 128 : 64, nblk = ncols / 32;
            const int kb = sub / nblk, nb = sub % nblk;
            const float* src = (which == 0) ? F.in[I_WL1] : (which == 1) ? F.in[I_AL1] : F.in[I_GL1];
            const int rowbase = (which == 0) ? 3072 + 64 * isprev : (which == 1) ? 3200 + 64 * isprev : 3328 + 128 * isprev;
            tr_item(src, ncols, kb * 64, nb * 32, WinT + (size_t)(rowbase + nb * 32) * DM, DM, F.in[I_MULORA] + which * DM, isprev ? 2 : 1, scr, F.lane); continue; } r -= IT_L1;
        if (r < IT_WO) { const int kb = r / 32, nb = r % 32; tr_item(F.in[I_WO], DM, kb * 64, nb * 32, (bf16_t*)(F.ws + WS_WOT) + (size_t)(nb * 32) * DM, DM, nullptr, 0, scr, F.lane); continue; } r -= IT_WO;
        if (r < IT_G) { const int kb = r / 32, nb = r % 32; tr_item(F.in[I_PG], DM, kb * 64, nb * 32, (bf16_t*)(F.ws + WS_GT) + (size_t)(nb * 32) * DM, DM, nullptr, 0, scr, F.lane); continue; } r -= IT_G;
        { const int kb = r / 32, nb = r % 32; tr_item(F.in[I_PP], DM, kb * 64, nb * 32, (bf16_t*)(F.ws + WS_PT) + (size_t)(nb * 32) * 256, 256, nullptr, 0, scr, F.lane); }
    }
}
__device__ __forceinline__ void ph_moe_weights(Frame& F) {
    const int gw = F.vcu * NWAVES + F.wave, NGW = F.G * NWAVES;
    LAS float* scr = (LAS float*)(F.lds + RING_OFF + F.wave * 16384);
    constexpr int IT_GU = 64 * 256, IT_D = 32 * 256;
    for (int it = gw; it < IT_GU + IT_D; it += NGW) {
        if (it < IT_GU) { const int mat = it / 256, sub = it % 256, e = mat >> 1, up = mat & 1, kb = sub / 16, nb = sub % 16, n0 = nb * 32;
            const float* src = (up ? F.in[I_WU] : F.in[I_WG]) + (size_t)e * DM * DEXP;
            bf16_t* dst = (bf16_t*)(F.ws + WS_WGUT) + ((size_t)e * 1024 + (n0 >> 7) * 256 + up * 128 + (n0 & 127)) * DM;
            tr_item(src, DEXP, kb * 64, n0, dst, DM, nullptr, 0, scr, F.lane); }
        else { const int r = it - IT_GU, e = r / 256, sub = r % 256, kb = sub / 32, nb = sub % 32;
            const float* src = F.in[I_WD] + (size_t)e * DEXP * DM;
            bf16_t* dst = (bf16_t*)(F.ws + WS_WDT) + ((size_t)e * 1024 + nb * 32) * DEXP;
            tr_item(src, DM, kb * 64, nb * 32, dst, DEXP, nullptr, 0, scr, F.lane); }
    }
}

using pg8::Unit; using pg8::cvt_pk_bf16;
struct EpiProj {
    static constexpr bool PERM = true;
    bf16_t* proj; float* lora1;
    __device__ __forceinline__ void operator()(const f32x4 (&acc)[2][2][4][2], const Unit& u, int wr, int wc, int fr, int fq) const {
        const int row0 = u.pm * 256 + wr * 64 + fr;
        if (u.pn < 12) {
            const int col0 = u.pn * 256 + wc * 32 + 8 * fq;
#pragma unroll
            for (int ai = 0; ai < 2; ++ai)
#pragma unroll
                for (int m = 0; m < 4; ++m) { bf16_t* rowp = proj + (size_t)(row0 + ai * 128 + m * 16) * NPROJ + col0;
#pragma unroll
                    for (int bj = 0; bj < 2; ++bj) { const f32x4 v0 = acc[ai][bj][m][0], v1 = acc[ai][bj][m][1]; u32x4 w;
                        w.x = cvt_pk_bf16(v0[0], v0[1]); w.y = cvt_pk_bf16(v0[2], v0[3]); w.z = cvt_pk_bf16(v1[0], v1[1]); w.w = cvt_pk_bf16(v1[2], v1[3]);
                        *(u32x4*)(rowp + bj * 128) = w; } }
        } else {
            const int col0 = (u.pn - 12) * 256 + wc * 32 + 8 * fq;
#pragma unroll
            for (int ai = 0; ai < 2; ++ai)
#pragma unroll
                for (int m = 0; m < 4; ++m) { float* rowp = lora1 + (size_t)(row0 + ai * 128 + m * 16) * NL1 + col0;
#pragma unroll
                    for (int bj = 0; bj < 2; ++bj) { *(f32x4*)(rowp + bj * 128) = acc[ai][bj][m][0]; *(f32x4*)(rowp + bj * 128 + 4) = acc[ai][bj][m][1]; } }
        }
    }
};
struct EpiDag {
    static constexpr bool PERM = true;
    float* lw; bf16_t* ag; const float* w0; const float* a0;
    __device__ __forceinline__ void operator()(const f32x4 (&acc)[2][2][4][2], const Unit& u, int wr, int wc, int fr, int fq) const {
        const int row0 = u.pm * 256 + wr * 64 + fr;
        const int colt = u.pn * 256 + wc * 32 + 8 * fq;
        if (u.pn < 2) {
#pragma unroll
            for (int bj = 0; bj < 2; ++bj) {
                const f32x4 b0 = *(const f32x4*)(w0 + colt + bj * 128), b1 = *(const f32x4*)(w0 + colt + bj * 128 + 4);
#pragma unroll
                for (int ai = 0; ai < 2; ++ai)
#pragma unroll
                    for (int m = 0; m < 4; ++m) { float* rowp = lw + (size_t)(row0 + ai * 128 + m * 16) * 512 + colt + bj * 128;
                        const f32x4 z0 = acc[ai][bj][m][0] + b0, z1 = acc[ai][bj][m][1] + b1; f32x4 o0, o1;
#pragma unroll
                        for (int j = 0; j < 4; ++j) { o0[j] = -0.6065306597126334f * sigmoidf_(z0[j]); o1[j] = -0.6065306597126334f * sigmoidf_(z1[j]); }
                        *(f32x4*)(rowp) = o0; *(f32x4*)(rowp + 4) = o1; }
                asm volatile("" ::: "memory");
            }
        } else {
            const bool isa = (u.pn < 4);
#pragma unroll
            for (int bj = 0; bj < 2; ++bj) {
                f32x4 b0 = (f32x4){0.f, 0.f, 0.f, 0.f}, b1 = (f32x4){0.f, 0.f, 0.f, 0.f};
                if (isa) { b0 = *(const f32x4*)(a0 + (colt - 512) + bj * 128); b1 = *(const f32x4*)(a0 + (colt - 512) + bj * 128 + 4); }
#pragma unroll
                for (int ai = 0; ai < 2; ++ai)
#pragma unroll
                    for (int m = 0; m < 4; ++m) { bf16_t* rowp = ag + (size_t)(row0 + ai * 128 + m * 16) * 1024 + (colt - 512) + bj * 128;
                        f32x4 v0 = acc[ai][bj][m][0] + b0, v1 = acc[ai][bj][m][1] + b1;
                        if (isa) {
#pragma unroll
                            for (int j = 0; j < 4; ++j) { v0[j] = sigmoidf_(v0[j]); v1[j] = sigmoidf_(v1[j]); } }
                        u32x4 w; w.x = cvt_pk_bf16(v0[0], v0[1]); w.y = cvt_pk_bf16(v0[2], v0[3]); w.z = cvt_pk_bf16(v1[0], v1[1]); w.w = cvt_pk_bf16(v1[2], v1[3]);
                        *(u32x4*)(rowp) = w; }
                asm volatile("" ::: "memory");
            }
        }
    }
};
struct EpiWo {
    static constexpr bool PERM = false;
    const float* x; float* pre1;
    __device__ __forceinline__ void operator()(const f32x4 (&acc)[2][2][4][2], const Unit& u, int wr, int wc, int fr, int fq) const {
        const int row0 = u.pm * 256 + wr * 64 + fr, col0 = u.pn * 256 + wc * 32 + 4 * fq;
#pragma unroll
        for (int ai = 0; ai < 2; ++ai)
#pragma unroll
            for (int m = 0; m < 4; ++m) { const size_t off = (size_t)(row0 + ai * 128 + m * 16) * DM + col0;
#pragma unroll
                for (int bj = 0; bj < 2; ++bj)
#pragma unroll
                    for (int n = 0; n < 2; ++n) { const f32x4 xv = *(const f32x4*)(x + off + bj * 128 + n * 16); *(f32x4*)(pre1 + off + bj * 128 + n * 16) = xv * ALPHA + acc[ai][bj][m][n]; }
                asm volatile("" ::: "memory"); }
    }
};
struct EpiF32 {
    static constexpr bool PERM = false;
    float* C; int ldc;
    __device__ __forceinline__ void operator()(const f32x4 (&acc)[2][2][4][2], const Unit& u, int wr, int wc, int fr, int fq) const {
        const int row0 = u.pm * 256 + wr * 64 + fr, col0 = u.pn * 256 + wc * 32 + 4 * fq;
#pragma unroll
        for (int ai = 0; ai < 2; ++ai)
#pragma unroll
            for (int m = 0; m < 4; ++m) { float* rowp = C + (size_t)(row0 + ai * 128 + m * 16) * ldc + col0;
#pragma unroll
                for (int bj = 0; bj < 2; ++bj)
#pragma unroll
                    for (int n = 0; n < 2; ++n) *(f32x4*)(rowp + bj * 128 + n * 16) = acc[ai][bj][m][n]; }
    }
};
struct EpiPle {
    static constexpr bool PERM = false;
    float* C; int ldc;
    __device__ __forceinline__ void operator()(const f32x4 (&acc)[2][2][4][2], const Unit& u, int wr, int wc, int fr, int fq) const {
        const int row0 = u.pm * 256 + wr * 64 + fr, col0 = u.pn * 256 + wc * 32 + 4 * fq;
#pragma unroll
        for (int ai = 0; ai < 2; ++ai)
#pragma unroll
            for (int m = 0; m < 4; ++m) { float* rowp = C + (size_t)(row0 + ai * 128 + m * 16) * ldc + col0;
#pragma unroll
                for (int bj = 0; bj < 2; ++bj)
#pragma unroll
                    for (int n = 0; n < 2; ++n) { const f32x4 pv = *(const f32x4*)(rowp + bj * 128 + n * 16); const f32x4 a = acc[ai][bj][m][n]; f32x4 o;
#pragma unroll
                        for (int j = 0; j < 4; ++j) o[j] = sigmoidf_(a[j]) * pv[j];
                        *(f32x4*)(rowp + bj * 128 + n * 16) = o; }
                asm volatile("" ::: "memory"); }
    }
};
struct EpiGU {
    static constexpr bool PERM = true;
    bf16_t* hdn;
    __device__ __forceinline__ void operator()(const f32x4 (&acc)[2][2][4][2], const Unit& u, int wr, int wc, int fr, int fq) const {
        const int row0 = u.pm * 256 + wr * 64 + fr, col0 = u.pn * 128 + wc * 32 + 8 * fq;
#pragma unroll
        for (int ai = 0; ai < 2; ++ai)
#pragma unroll
            for (int m = 0; m < 4; ++m) { bf16_t* rowp = hdn + (size_t)(row0 + ai * 128 + m * 16) * DEXP + col0; float h[8];
#pragma unroll
                for (int n = 0; n < 2; ++n)
#pragma unroll
                    for (int j = 0; j < 4; ++j) { const float gt = acc[ai][0][m][n][j], up = acc[ai][1][m][n][j]; h[4 * n + j] = gt * sigmoidf_(gt) * up; }
                u32x4 w; w.x = cvt_pk_bf16(h[0], h[1]); w.y = cvt_pk_bf16(h[2], h[3]); w.z = cvt_pk_bf16(h[4], h[5]); w.w = cvt_pk_bf16(h[6], h[7]);
                *(u32x4*)rowp = w; }
    }
};
struct EpiDown {
    static constexpr bool PERM = true;
    bf16_t* lo; bf16_t* hi; const int* row_asg; const float* row_w;
    __device__ __forceinline__ void operator()(const f32x4 (&acc)[2][2][4][2], const Unit& u, int wr, int wc, int fr, int fq) const {
        const int row0 = u.pm * 256 + wr * 64 + fr, col0 = u.pn * 256 + wc * 32 + 8 * fq;
#pragma unroll
        for (int ai = 0; ai < 2; ++ai)
#pragma unroll
            for (int m = 0; m < 4; ++m) { const int prow = row0 + ai * 128 + m * 16; const int asg = row_asg[prow]; const float w = row_w[prow];
                if (asg >= 0) { bf16_t* rowp = (asg < 32768 ? lo + (size_t)asg * DM : hi + (size_t)(asg - 32768) * DM) + col0;
#pragma unroll
                    for (int bj = 0; bj < 2; ++bj) { const f32x4 v0 = acc[ai][bj][m][0] * w, v1 = acc[ai][bj][m][1] * w; u32x4 o;
                        o.x = cvt_pk_bf16(v0[0], v0[1]); o.y = cvt_pk_bf16(v0[2], v0[3]); o.z = cvt_pk_bf16(v1[0], v1[1]); o.w = cvt_pk_bf16(v1[2], v1[3]);
                        *(u32x4*)(rowp + bj * 128) = o; } } }
    }
};

__device__ __forceinline__ void ph_lora_act(Frame& F) {
    const int gt = F.vcu * 512 + F.tid, NGT = F.G * 512;
    const float* l1 = (const float*)(F.ws + WS_LORA1); bf16_t* act = (bf16_t*)(F.ws + WS_Y);
    for (int i = gt; i < NTOK * 64; i += NGT) {
        const int t = i >> 6, c4 = (i & 63) * 4; const bool first = (t % SEQ) == 0;
        int ca, cb, mode;
        if (c4 < 64) { ca = c4; cb = 64 + c4; mode = 0; } else if (c4 < 128) { ca = 128 + (c4 - 64); cb = 192 + (c4 - 64); mode = 1; } else { ca = 256 + (c4 - 128); cb = 384 + (c4 - 128); mode = 2; }
        f32x4 a = *(const f32x4*)(l1 + (size_t)t * NL1 + ca);
        if (!first) a += *(const f32x4*)(l1 + (size_t)(t - 1) * NL1 + cb);
        float o[4];
#pragma unroll
        for (int j = 0; j < 4; ++j) o[j] = (mode == 0) ? tanhf(a[j]) : (mode == 1) ? a[j] : sigmoidf_(a[j]);
        u32x2 w; w.x = pk2(o[0], o[1]); w.y = pk2(o[2], o[3]);
        *(u32x2*)(act + (size_t)t * KL2 + c4) = w;
    }
}

__device__ __forceinline__ void ph_scan_simple(Frame& F) {
    if (F.vcu >= 128 || F.wave != 0) return;
    const int bh = F.vcu, b = bh >> 3, h = bh & 7, lane = F.lane, c = h * 64 + lane;
    LAS float* vec = (LAS float*)(F.lds + RING_OFF);
    const bf16_t* proj = (const bf16_t*)(F.ws + WS_P); const float* lwb = (const float*)(F.ws + WS_LW); const bf16_t* ag = (const bf16_t*)(F.ws + WS_AG);
    bf16_t* ycat = (bf16_t*)(F.ws + WS_Y);
    const float mu_r = F.in[I_MURKV][c], mu_k = F.in[I_MURKV][512 + c], mu_v = F.in[I_MURKV][1024 + c];
    const float k_k = F.in[I_KK][c], k_a = F.in[I_KA][c], r_k = F.in[I_RK][c], lg = F.in[I_LNXG][c], lb = F.in[I_LNXB][c];
    float S[64];
#pragma unroll
    for (int k = 0; k < 64; ++k) S[k] = 0.f;
    float rp = 0.f, kp = 0.f, vp = 0.f;
    for (int s = 0; s < SEQ; ++s) {
        const size_t t = (size_t)b * SEQ + s;
        const float r_in = bf2f(proj[t * NPROJ + c]), k_in = bf2f(proj[t * NPROJ + 512 + c]), v_in = bf2f(proj[t * NPROJ + 1024 + c]);
        const float r = r_in + (rp - r_in) * mu_r, k = k_in + (kp - k_in) * mu_k, v = v_in + (vp - v_in) * mu_v;
        rp = r_in; kp = k_in; vp = v_in;
        const float w = __expf(lwb[t * 512 + c]);
        const float a = bf2f(ag[t * 1024 + c]), g = bf2f(ag[t * 1024 + 512 + c]);
        float kk = k * k_k; const float ss = wave_sum(kk * kk); kk *= rsqrtf(fmaxf(ss, 1e-24f));
        const float kq = k * (1.0f + (a - 1.0f) * k_a);
        const float bonus = wave_sum(r * kq * r_k);
        vec[lane] = -kk; vec[64 + lane] = w; vec[128 + lane] = kk * a; vec[192 + lane] = kq; vec[256 + lane] = r;
        LDS_WAIT();
        float sa = 0.f;
#pragma unroll
        for (int q = 0; q < 16; ++q) { const f32x4 a4 = *(const LAS f32x4*)(vec + 4 * q); sa += S[4 * q] * a4[0]; sa += S[4 * q + 1] * a4[1]; sa += S[4 * q + 2] * a4[2]; sa += S[4 * q + 3] * a4[3]; if ((q & 3) == 3) __builtin_amdgcn_sched_barrier(0); }
        float y = 0.f;
#pragma unroll
        for (int q = 0; q < 16; ++q) { const f32x4 w4 = *(const LAS f32x4*)(vec + 64 + 4 * q), b4 = *(const LAS f32x4*)(vec + 128 + 4 * q), k4 = *(const LAS f32x4*)(vec + 192 + 4 * q), r4 = *(const LAS f32x4*)(vec + 256 + 4 * q);
#pragma unroll
            for (int j = 0; j < 4; ++j) { const float sn = S[4 * q + j] * w4[j] + sa * b4[j] + v * k4[j]; S[4 * q + j] = sn; y += sn * r4[j]; }
            __builtin_amdgcn_sched_barrier(0); }
        LDS_WAIT();
        const float mean = wave_sum(y) * (1.0f / 64.0f); const float d = y - mean; const float var = wave_sum(d * d) * (1.0f / 64.0f);
        const float yn = d * rsqrtf(var + LNX_EPS) * lg + lb;
        ycat[t * DM + c] = (bf16_t)f2bf((yn + bonus * v) * g);
    }
}

__device__ __forceinline__ void ph_attn_simple(Frame& F) {
    const int gw = F.vcu * NWAVES + F.wave, NGW = F.G * NWAVES;
    const bf16_t* proj = (const bf16_t*)(F.ws + WS_P); bf16_t* ycat = (bf16_t*)(F.ws + WS_Y); const float* bt = (const float*)(F.ws + WS_BIAS);
    for (int it = gw; it < NB * 8 * (SEQ / 64); it += NGW) {
        const int sblk = it % (SEQ / 64), h = (it / (SEQ / 64)) % 8, b = it / (8 * (SEQ / 64));
        const int s = sblk * 64 + F.lane; const size_t t = (size_t)b * SEQ + s;
        float q[64], o[64];
        { const u32x4* qp = (const u32x4*)(proj + t * NPROJ + 1536 + h * 64);
#pragma unroll
          for (int i = 0; i < 8; ++i) { const u32x4 w = qp[i]; q[8 * i] = bf_lo(w.x) * 0.125f; q[8 * i + 1] = bf_hi(w.x) * 0.125f; q[8 * i + 2] = bf_lo(w.y) * 0.125f; q[8 * i + 3] = bf_hi(w.y) * 0.125f;
              q[8 * i + 4] = bf_lo(w.z) * 0.125f; q[8 * i + 5] = bf_hi(w.z) * 0.125f; q[8 * i + 6] = bf_lo(w.w) * 0.125f; q[8 * i + 7] = bf_hi(w.w) * 0.125f; } }
#pragma unroll
        for (int d = 0; d < 64; ++d) o[d] = 0.f;
        float mx = -1e30f, l = 0.f;
        for (int p = 0; p < 3; ++p) {
            const int dil = 1 << (2 * p); const float* bp = bt + (p * 8 + h) * BIAS_LD;
            for (int m = 0; m <= 128; ++m) {
                const int sp = s - m * dil;
                if (sp >= 0) {
                    const size_t tk = t - (size_t)(m * dil);
                    const u32x4* kp = (const u32x4*)(proj + tk * NPROJ + 2048 + h * 64);
                    float dot = 0.f;
#pragma unroll
                    for (int i = 0; i < 8; ++i) { const u32x4 w = kp[i];
                        dot += q[8 * i] * bf_lo(w.x) + q[8 * i + 1] * bf_hi(w.x) + q[8 * i + 2] * bf_lo(w.y) + q[8 * i + 3] * bf_hi(w.y)
                             + q[8 * i + 4] * bf_lo(w.z) + q[8 * i + 5] * bf_hi(w.z) + q[8 * i + 6] * bf_lo(w.w) + q[8 * i + 7] * bf_hi(w.w); }
                    const float logit = dot + bp[m];
                    const float nm = fmaxf(mx, logit); const float alpha = __expf(mx - nm), pe = __expf(logit - nm);
                    l = l * alpha + pe; mx = nm;
                    const u32x4* vp = (const u32x4*)(proj + tk * NPROJ + 2560 + h * 64);
#pragma unroll
                    for (int i = 0; i < 8; ++i) { const u32x4 w = vp[i];
                        o[8 * i] = o[8 * i] * alpha + pe * bf_lo(w.x); o[8 * i + 1] = o[8 * i + 1] * alpha + pe * bf_hi(w.x);
                        o[8 * i + 2] = o[8 * i + 2] * alpha + pe * bf_lo(w.y); o[8 * i + 3] = o[8 * i + 3] * alpha + pe * bf_hi(w.y);
                        o[8 * i + 4] = o[8 * i + 4] * alpha + pe * bf_lo(w.z); o[8 * i + 5] = o[8 * i + 5] * alpha + pe * bf_hi(w.z);
                        o[8 * i + 6] = o[8 * i + 6] * alpha + pe * bf_lo(w.w); o[8 * i + 7] = o[8 * i + 7] * alpha + pe * bf_hi(w.w); }
                }
            }
        }
        const float inv = 1.0f / l;
        u32x4* op = (u32x4*)(ycat + t * DM + 512 + h * 64);
#pragma unroll
        for (int i = 0; i < 8; ++i) { u32x4 w; w.x = pk2(o[8 * i] * inv, o[8 * i + 1] * inv); w.y = pk2(o[8 * i + 2] * inv, o[8 * i + 3] * inv);
            w.z = pk2(o[8 * i + 4] * inv, o[8 * i + 5] * inv); w.w = pk2(o[8 * i + 6] * inv, o[8 * i + 7] * inv); op[i] = w; }
    }
}

__device__ __forceinline__ void ph_ln1_router(Frame& F) {
    const int gw = F.vcu * NWAVES + F.wave, NGW = F.G * NWAVES, lane = F.lane;
    LAS float* wrt = (LAS float*)(F.lds);
    for (int idx = F.tid; idx < 36 * 1024; idx += 512) { const int cc = idx >> 10, k = idx & 1023;
        wrt[idx] = (cc < 4) ? F.in[I_RG][k * 4 + cc] : F.in[I_RE][k * 32 + (cc - 4)]; }
    if (F.tid < 32) F.MISC[MW_HIST + F.tid] = 0u;
    __syncthreads();
    float* x1 = (float*)(F.ws + WS_X1); bf16_t* x1b = (bf16_t*)(F.ws + WS_Y);
    int* toke = (int*)(F.ws + WS_TOKE); float* tokw = (float*)(F.ws + WS_TOKW);
    f32x4 gv[4], bv[4];
#pragma unroll
    for (int j = 0; j < 4; ++j) { gv[j] = *(const f32x4*)(F.in[I_LN1G] + 4 * lane + 256 * j); bv[j] = *(const f32x4*)(F.in[I_LN1B] + 4 * lane + 256 * j); }
    for (int row = gw; row < NTOK; row += NGW) {
        f32x4 v[4]; float s = 0.f;
        float* xr = x1 + (size_t)row * DM + 4 * lane;
#pragma unroll
        for (int j = 0; j < 4; ++j) { v[j] = *(const f32x4*)(xr + 256 * j); s += (v[j][0] + v[j][1]) + (v[j][2] + v[j][3]); }
        const float mean = wave_sum(s) * (1.0f / DM); float s2 = 0.f;
#pragma unroll
        for (int j = 0; j < 4; ++j) { v[j] = v[j] - mean; s2 += (v[j][0] * v[j][0] + v[j][1] * v[j][1]) + (v[j][2] * v[j][2] + v[j][3] * v[j][3]); }
        const float rstd = rsqrtf(wave_sum(s2) * (1.0f / DM) + LN_EPS);
#pragma unroll
        for (int j = 0; j < 4; ++j) { v[j] = v[j] * rstd * gv[j] + bv[j]; *(f32x4*)(xr + 256 * j) = v[j];
            u32x2 w; w.x = pk2(v[j][0], v[j][1]); w.y = pk2(v[j][2], v[j][3]); *(u32x2*)(x1b + (size_t)row * DM + 4 * lane + 256 * j) = w; }
        float lg[36];
#pragma unroll
        for (int cc = 0; cc < 36; ++cc) { float a = 0.f;
#pragma unroll
            for (int j = 0; j < 4; ++j) { const f32x4 w4 = *(const LAS f32x4*)(wrt + cc * 1024 + 4 * lane + 256 * j); a += v[j][0] * w4[0] + v[j][1] * w4[1] + v[j][2] * w4[2] + v[j][3] * w4[3]; }
            lg[cc] = wave_sum(a); }
        float gl[4];
#pragma unroll
        for (int i = 0; i < 4; ++i) gl[i] = lg[i] + F.in[I_RGB][i];
        int grp = 0; float gm = gl[0];
#pragma unroll
        for (int i = 1; i < 4; ++i) if (gl[i] > gm) { gm = gl[i]; grp = i; }
        float se = 0.f;
#pragma unroll
        for (int i = 0; i < 4; ++i) se += __expf(gl[i] - gm);
        const float wg = 1.0f / se;
        float le[8];
#pragma unroll
        for (int i = 0; i < 8; ++i) { float vsel = lg[4 + i];
#pragma unroll
            for (int gq = 1; gq < 4; ++gq) vsel = (grp == gq) ? lg[4 + gq * 8 + i] : vsel;
            le[i] = vsel + F.in[I_REB][grp * 8 + i]; }
        int i0 = 0; float v0 = le[0];
#pragma unroll
        for (int i = 1; i < 8; ++i) if (le[i] > v0) { v0 = le[i]; i0 = i; }
        int i1 = -1; float v1 = -3.0e38f;
#pragma unroll
        for (int i = 0; i < 8; ++i) if (i != i0 && le[i] > v1) { v1 = le[i]; i1 = i; }
        const float e1 = __expf(v1 - v0); const float w0 = wg / (1.0f + e1), w1 = wg * e1 / (1.0f + e1);
        const int ex0 = grp * 8 + i0, ex1 = grp * 8 + i1;
        if (lane == 0) { toke[2 * row] = ex0; toke[2 * row + 1] = ex1; tokw[2 * row] = w0; tokw[2 * row + 1] = w1;
            atomicAdd((unsigned*)&F.MISC[MW_HIST + ex0], 1u); atomicAdd((unsigned*)&F.MISC[MW_HIST + ex1], 1u); }
    }
    __syncthreads();
    if (F.tid < 32) { const unsigned hc = F.MISC[MW_HIST + F.tid]; if (hc) atomicAdd(F.ctl + CW_CNT + F.tid, hc); }
}

__device__ __forceinline__ void ph_positions(Frame& F) {
    int* toke = (int*)(F.ws + WS_TOKE); float* tokw = (float*)(F.ws + WS_TOKW);
    int* row_tok = (int*)(F.ws + WS_ROWTOK); int* row_asg = (int*)(F.ws + WS_ROWASG); float* row_w = (float*)(F.ws + WS_ROWW);
    if (F.tid < 32) { F.MISC[MW_CNT + F.tid] = __hip_atomic_load(F.ctl + CW_CNT + F.tid, RLX_AGENT); F.MISC[MW_HIST + F.tid] = 0u; F.MISC[MW_LFILL + F.tid] = 0u; }
    __syncthreads();
    if (F.tid == 0) {
        unsigned rs = 0;
        for (int e = 0; e < 32; ++e) { F.MISC[MW_RS + e] = rs; const unsigned nt = (F.MISC[MW_CNT + e] + 255u) >> 8;
            if (blockIdx.x == 0) { for (unsigned q = 0; q < nt; ++q) F.ctl[CW_TILEE + (rs >> 8) + q] = (unsigned)e; }
            rs += nt << 8; }
        if (blockIdx.x == 0) F.ctl[CW_NTILES] = rs >> 8;
    }
    __syncthreads();
    const int per = (NTOK + F.G - 1) / F.G;
    const int base = F.vcu * per;
    for (int a0 = 0; a0 < 2 * per; a0 += 512) {
        const int a = a0 + F.tid; const int tok = base + (a >> 1), j = a & 1; const bool ok = (a < 2 * per) && (tok < NTOK);
        int e = 0; if (ok) { e = toke[2 * tok + j]; atomicAdd((unsigned*)&F.MISC[MW_HIST + e], 1u); }
        __syncthreads();
        if (F.tid < 32) { const unsigned hc = F.MISC[MW_HIST + F.tid]; F.MISC[MW_LBASE + F.tid] = hc ? atomicAdd(F.ctl + CW_FILL + F.tid, hc) : 0u; }
        __syncthreads();
        if (ok) { const unsigned pos = F.MISC[MW_RS + e] + F.MISC[MW_LBASE + e] + atomicAdd((unsigned*)&F.MISC[MW_LFILL + e], 1u);
            row_tok[pos] = tok; row_asg[pos] = 2 * tok + j; row_w[pos] = tokw[2 * tok + j]; }
        __syncthreads();
        if (F.tid < 32) { F.MISC[MW_HIST + F.tid] = 0u; F.MISC[MW_LFILL + F.tid] = 0u; }
        __syncthreads();
    }
    if (F.vcu < 32) { const int e = F.vcu; const unsigned cnt = F.MISC[MW_CNT + e], rs = F.MISC[MW_RS + e], end = ((cnt + 255u) >> 8) << 8;
        for (unsigned r = cnt + F.tid; r < end; r += 512) { row_tok[rs + r] = 0; row_asg[rs + r] = -1; row_w[rs + r] = 0.f; } }
}

__device__ __forceinline__ void ph_final(Frame& F) {
    const int gw = F.vcu * NWAVES + F.wave, NGW = F.G * NWAVES, lane = F.lane;
    const float* x1 = (const float*)(F.ws + WS_X1); const bf16_t* lo = (const bf16_t*)(F.ws + WS_Y); const bf16_t* hi = (const bf16_t*)(F.ws + WS_MOEHI);
    f32x4 gv[4], bv[4];
#pragma unroll
    for (int j = 0; j < 4; ++j) { gv[j] = *(const f32x4*)(F.in[I_LN2G] + 4 * lane + 256 * j); bv[j] = *(const f32x4*)(F.in[I_LN2B] + 4 * lane + 256 * j); }
    for (int row = gw; row < NTOK; row += NGW) {
        const bf16_t* m0 = (row < 16384) ? lo + (size_t)(2 * row) * DM : hi + (size_t)(2 * row - 32768) * DM;
        f32x4 v[4]; float s = 0.f;
#pragma unroll
        for (int j = 0; j < 4; ++j) { const int cix = 4 * lane + 256 * j;
            const f32x4 xv = *(const f32x4*)(x1 + (size_t)row * DM + cix), pv = *(const f32x4*)(F.out + (size_t)row * DM + cix);
            const u32x2 a = *(const u32x2*)(m0 + cix), b = *(const u32x2*)(m0 + DM + cix);
            f32x4 mv; mv[0] = bf_lo(a.x) + bf_lo(b.x); mv[1] = bf_hi(a.x) + bf_hi(b.x); mv[2] = bf_lo(a.y) + bf_lo(b.y); mv[3] = bf_hi(a.y) + bf_hi(b.y);
            v[j] = xv * ALPHA + mv + pv; s += (v[j][0] + v[j][1]) + (v[j][2] + v[j][3]); }
        const float mean = wave_sum(s) * (1.0f / DM); float s2 = 0.f;
#pragma unroll
        for (int j = 0; j < 4; ++j) { v[j] = v[j] - mean; s2 += (v[j][0] * v[j][0] + v[j][1] * v[j][1]) + (v[j][2] * v[j][2] + v[j][3] * v[j][3]); }
        const float rstd = rsqrtf(wave_sum(s2) * (1.0f / DM) + LN_EPS);
#pragma unroll
        for (int j = 0; j < 4; ++j) *(f32x4*)(F.out + (size_t)row * DM + 4 * lane + 256 * j) = v[j] * rstd * gv[j] + bv[j];
    }
}

constexpr int NPHASE = 12;
struct Args { const float* in[33]; float* out; unsigned char* ws; int ph_lo, ph_hi; };
#ifndef PH_MASK
#define PH_MASK 0xfff
#endif
__global__ void __launch_bounds__(NWAVES * 64, 2) hymba_fwd(const Args args) {
    extern __shared__ __attribute__((aligned(16))) unsigned char lds[];
    Frame F;
    F.lds = (LAS unsigned char*)lds;
    F.MISC = (volatile LAS unsigned*)(F.lds + MISC_OFF);
    F.tid = threadIdx.x; F.lane = F.tid & 63; F.wave = __builtin_amdgcn_readfirstlane(F.tid >> 6);
    F.G = gridDim.x; { const int bx = blockIdx.x; F.vcu = (F.G % 8 == 0) ? (bx % 8) * (F.G / 8) + bx / 8 : bx; }
    F.ws = args.ws; F.ctl = (unsigned*)(args.ws + WS_CTL); F.out = args.out;
    F.in = args.in;
    for (int u = F.tid; u < (LDS_BYTES - LDSCTL_OFF) / 4; u += NWAVES * 64) ((LAS unsigned*)(F.lds + LDSCTL_OFF))[u] = 0u;
    __syncthreads();
    const int lo = args.ph_lo, hi = args.ph_hi;
    XcdBarrier bar; bar.bar = F.ctl + CW_BAR; bar.x = 0; bar.st = nullptr;
    if (hi - lo > 1) bar = xcd_barrier_post(F.ctl + CW_BAR, F.MISC + MW_BAR);
#define IN(k) (((PH_MASK >> (k)) & 1) && lo <= (k) && (k) < hi)
#define SEAM(k) do { if (IN(k) && IN((k) + 1)) xcd_barrier(bar); } while (0)
    LAS unsigned char* ring = F.lds + RING_OFF;

    if (IN(0)) { ph_prologue(F); } SEAM(0);
    if (IN(1)) {
        pg8::Gemm g{(const bf16_t*)(F.ws + WS_XB), (const bf16_t*)(F.ws + WS_WINT), DM}; pg8::StaticOrder S; S.init(NTOK, NEXT, F.G, (int)blockIdx.x);
        EpiProj E{(bf16_t*)(F.ws + WS_P), (float*)(F.ws + WS_LORA1)};
        pg8::gemm_phase<EpiProj, pg8::StaticOrder>(ring, g, S, E);
    } SEAM(1);
    if (IN(2)) { ph_lora_act(F); } SEAM(2);
    if (IN(3)) {
        pg8::Gemm g{(const bf16_t*)(F.ws + WS_Y), (const bf16_t*)(F.ws + WS_W2T), KL2}; pg8::StaticOrder S; S.init(NTOK, NL2, F.G, (int)blockIdx.x);
        EpiDag E{(float*)(F.ws + WS_LW), (bf16_t*)(F.ws + WS_AG), F.in[I_W0], F.in[I_A0]};
        pg8::gemm_phase<EpiDag, pg8::StaticOrder>(ring, g, S, E);
    } SEAM(3);
    if (IN(4)) { ph_scan_simple(F); ph_attn_simple(F); } SEAM(4);
    if (IN(5)) {
        pg8::Gemm g{(const bf16_t*)(F.ws + WS_Y), (const bf16_t*)(F.ws + WS_WOT), DM}; pg8::StaticOrder S; S.init(NTOK, DM, F.G, (int)blockIdx.x);
        EpiWo E{F.in[I_X], (float*)(F.ws + WS_X1)};
        pg8::gemm_phase<EpiWo, pg8::StaticOrder>(ring, g, S, E);
    } SEAM(5);
    if (IN(6)) { ph_moe_weights(F); __syncthreads(); ph_ln1_router(F); } SEAM(6);
    if (IN(7)) { ph_positions(F); } SEAM(7);
    if (IN(8)) {
        {
            pg8::MoeOrder<true> S{(const int*)(F.ctl + CW_TILEE), (const int*)(F.ws + WS_ROWTOK), (int)__hip_atomic_load(F.ctl + CW_NTILES, RLX_AGENT), F.G, F.vcu};
            pg8::Gemm g{(const bf16_t*)(F.ws + WS_Y), (const bf16_t*)(F.ws + WS_WGUT), DM};
            EpiGU E{(bf16_t*)(F.ws + WS_HDN)};
            pg8::gemm_phase<EpiGU, pg8::MoeOrder<true>>(ring, g, S, E);
        }
    } SEAM(8);
    if (IN(9)) {
        {
            pg8::Gemm g{(const bf16_t*)(F.ws + WS_PB), (const bf16_t*)(F.ws + WS_PT), 256}; pg8::StaticOrder S; S.init(NTOK, DM, F.G, (int)blockIdx.x);
            EpiF32 E{F.out, DM};
            pg8::gemm_phase<EpiF32, pg8::StaticOrder>(ring, g, S, E);
        }
        {
            pg8::Gemm g{(const bf16_t*)(F.ws + WS_Y), (const bf16_t*)(F.ws + WS_GT), DM}; pg8::StaticOrder S; S.init(NTOK, DM, F.G, (int)blockIdx.x);
            EpiPle E{F.out, DM};
            pg8::gemm_phase<EpiPle, pg8::StaticOrder>(ring, g, S, E);
        }
    } SEAM(9);
    if (IN(10)) {
        pg8::MoeOrder<false> S{(const int*)(F.ctl + CW_TILEE), (const int*)(F.ws + WS_ROWTOK), (int)__hip_atomic_load(F.ctl + CW_NTILES, RLX_AGENT), F.G, F.vcu};
        pg8::Gemm g{(const bf16_t*)(F.ws + WS_HDN), (const bf16_t*)(F.ws + WS_WDT), DEXP};
        EpiDown E{(bf16_t*)(F.ws + WS_Y), (bf16_t*)(F.ws + WS_MOEHI), (const int*)(F.ws + WS_ROWASG), (const float*)(F.ws + WS_ROWW)};
        pg8::gemm_phase<EpiDown, pg8::MoeOrder<false>>(ring, g, S, E);
    } SEAM(10);
    if (IN(11)) { ph_final(F); }
#undef IN
#undef SEAM
}

extern "C" void kernel_launch(void* const* d_in, const int* in_sizes, int n_in, void* d_out, int out_size, void* d_ws, size_t ws_size, hipStream_t stream) {
    static int grid = 0;
    if (grid == 0) {
        if (n_in != 33 || in_sizes[0] != NTOK * DM || out_size != NTOK * DM || ws_size < WS_END) { fprintf(stderr, "kernel_launch: unexpected problem (n_in %d, in0 %d, out %d, ws %zu)\n", n_in, n_in > 0 ? in_sizes[0] : -1, out_size, ws_size); grid = -1; return; }
        int dev = 0, cus = 0;
        if (hipGetDevice(&dev) != hipSuccess || hipDeviceGetAttribute(&cus, hipDeviceAttributeMultiprocessorCount, dev) != hipSuccess) { grid = -1; return; }
        if (hipFuncSetAttribute((const void*)hymba_fwd, hipFuncAttributeMaxDynamicSharedMemorySize, LDS_BYTES) != hipSuccess) { fprintf(stderr, "kernel_launch: hipFuncSetAttribute failed\n"); grid = -1; return; }
        int per_cu = 0;
        if (hipOccupancyMaxActiveBlocksPerMultiprocessor(&per_cu, (const void*)hymba_fwd, NWAVES * 64, LDS_BYTES) != hipSuccess || per_cu < 1) fprintf(stderr, "kernel_launch: occupancy query reports %d\n", per_cu);
        (void)hipGetLastError();
        grid = cus;
    }
    if (grid < 0) return;
    if (hipMemsetAsync((char*)d_ws + WS_CTL, 0, CTL_ZERO_BYTES, stream) != hipSuccess) return;
    Args a{};
    for (int i = 0; i < 33; ++i) a.in[i] = (const float*)d_in[i];
    a.out = (float*)d_out; a.ws = (unsigned char*)d_ws;
#if MK_ONE_LAUNCH
    a.ph_lo = 0; a.ph_hi = NPHASE;
    hipLaunchKernelGGL(hymba_fwd, dim3(grid), dim3(NWAVES * 64), LDS_BYTES, stream, a);
#else
    for (int ph = 0; ph < NPHASE; ++ph) { a.ph_lo = ph; a.ph_hi = ph + 1; hipLaunchKernelGGL(hymba_fwd, dim3(grid), dim3(NWAVES * 64), LDS_BYTES, stream, a); }
#endif
}
```

```cpp
#include <hip/hip_runtime.h>
#include <cstdio>
#include <cstdint>

#ifndef MK_ONE_LAUNCH
#define MK_ONE_LAUNCH 1
#endif

#define GAS __attribute__((address_space(1)))
#define LAS __attribute__((address_space(3)))
typedef unsigned short bf16_t;
typedef short bf16x8 __attribute__((ext_vector_type(8)));
typedef float f32x4 __attribute__((ext_vector_type(4)));
typedef float f32x2 __attribute__((ext_vector_type(2)));
typedef unsigned u32x4 __attribute__((ext_vector_type(4)));
typedef unsigned u32x2 __attribute__((ext_vector_type(2)));
#define RLX_AGENT __ATOMIC_RELAXED, __HIP_MEMORY_SCOPE_AGENT
#define LDS_WAIT() asm volatile("s_waitcnt lgkmcnt(0)" ::: "memory")
#define VM_WAIT() asm volatile("s_waitcnt vmcnt(0)" ::: "memory")

__device__ __forceinline__ unsigned f2bf(float f) { unsigned u = __builtin_bit_cast(unsigned, f); return (u + 0x7fffu + ((u >> 16) & 1u)) >> 16; }
__device__ __forceinline__ unsigned pk2(float lo, float hi) { return f2bf(lo) | (f2bf(hi) << 16); }
__device__ __forceinline__ float bf_lo(unsigned w) { return __builtin_bit_cast(float, w << 16); }
__device__ __forceinline__ float bf_hi(unsigned w) { return __builtin_bit_cast(float, w & 0xffff0000u); }
__device__ __forceinline__ float bf2f(bf16_t b) { return __builtin_bit_cast(float, ((unsigned)b) << 16); }
__device__ __forceinline__ float sigmoidf_(float z) { return __builtin_amdgcn_rcpf(1.0f + __builtin_amdgcn_exp2f(-1.4426950408889634f * z)); }
__device__ __forceinline__ float wave_sum(float v) {
#pragma unroll
    for (int o = 1; o < 64; o <<= 1) v += __shfl_xor(v, o);
    return v;
}

namespace pg8 {
constexpr int BM = 256, BK = 64, HALF = 128, HTB = HALF * BK * 2, STAGE_BYTES = 8 * HTB, NXCD = 8, WGM = 8;
__host__ __device__ __forceinline__ int lds_byte(int r, int c) { const int st = (r >> 4) * 2 + (c >> 5), rr = r & 15, cc = c & 31, ob = rr * 64 + cc * 2; return st * 1024 + (ob ^ (((ob >> 9) & 1) << 5)); }
__host__ __device__ __forceinline__ void stage_rc(int b, int& R, int& C) { const int st = b / 1024, sb = b % 1024, swz = sb ^ (((sb >> 9) & 1) << 5); R = (st >> 1) * 16 + swz / 64; C = (st & 1) * 32 + (swz % 64) / 2; }
__host__ __device__ __forceinline__ int perm32(int rho) { const int n = rho >> 4, i = rho & 15; return 8 * (i >> 2) + 4 * n + (i & 3); }

struct Unit { int pm, pn, pb; };
struct Gemm { const bf16_t* A; const bf16_t* Bt; int K; };

struct StaticOrder {
    static constexpr bool GATHER = false;
    int nM, nN, nwg, G, c;
    __device__ void init(int M, int N, int G_, int c_) { nM = M / BM; nN = N / BM; nwg = nM * nN; G = G_; c = c_; }
    __device__ bool next(int i, Unit& u) const {
        const long L = (long)i * G + c; if (L >= nwg) return false;
        int wgid = (int)L; { const int q = nwg / NXCD, r = nwg % NXCD, xcd = wgid % NXCD, off = wgid / NXCD; wgid = (xcd < r ? xcd * (q + 1) : r * (q + 1) + (xcd - r) * q) + off; }
        const int nig = WGM * nN, gid = wgid / nig, fm = gid * WGM, gsz = (nM - fm) < WGM ? (nM - fm) : WGM;
        u.pm = fm + ((wgid % nig) % gsz); u.pn = (wgid % nig) / gsz; u.pb = u.pn; return true;
    }
    __device__ __forceinline__ unsigned a_row_off(const Unit&, int, unsigned) const { return 0u; }
};
template <bool GATHER_> struct MoeOrder {
    static constexpr bool GATHER = GATHER_;
    const int* tile_e; const int* row_tok; int ntiles, G, c;
    __device__ bool next(int i, Unit& u) const {
        const long L = (long)i * G + c; if (L >= (long)ntiles * 4) return false;
        const int tile = (int)(L >> 2), pn = (int)(L & 3);
        u.pm = tile; u.pn = pn; u.pb = tile_e[tile] * 4 + pn; return true;
    }
    __device__ __forceinline__ unsigned a_row_off(const Unit& u, int r, unsigned rowbytes) const { return (unsigned)row_tok[u.pm * 256 + r] * rowbytes; }
};

__device__ __forceinline__ unsigned cvt_pk_bf16(float lo, float hi) { unsigned r; asm volatile("v_cvt_pk_bf16_f32 %0, %1, %2" : "=v"(r) : "v"(lo), "v"(hi)); return r; }

template <class Epi, class Sched>
__device__ __forceinline__ void gemm_phase(LAS unsigned char* lds, const Gemm g, const Sched& S, const Epi& E) {
    const int tid = threadIdx.x, wid = __builtin_amdgcn_readfirstlane(tid >> 6), lane = tid & 63, wr = wid >> 2, wc = wid & 3, fr = lane & 15, fq = lane >> 4;
    const int K = g.K, nt = K / BK;
    int Rr[2], Cc[2];
    unsigned voffB[2];
#pragma unroll
    for (int i = 0; i < 2; ++i) { int R, C; stage_rc(tid * 16 + i * 8192, R, C); const int Rb = Epi::PERM ? ((R & ~31) + perm32(R & 31)) : R;
        Rr[i] = R; Cc[i] = C; voffB[i] = (unsigned)(Rb * K + C) * 2u; }
    const unsigned rowbytes = (unsigned)K * 2u;
    const size_t kstep = (size_t)(BK * 2);
    const size_t hstep = (size_t)HALF * K * 2;
    const size_t tstep = 2 * hstep;
    const unsigned ldsw = (unsigned)wid * 1024u;
    const int aoff = lds_byte(wr * 64 + fr, fq * 8), boff = lds_byte(wc * 32 + fr, fq * 8);
#define PG8_SA(b, h) (((b) * 2 + (h)) * HTB)
#define PG8_SB(b, h) ((4 + (b) * 2 + (h)) * HTB)
#define PG8_STAGE(bufoff, gbase, voff) do { _Pragma("unroll") for (int _i = 0; _i < 2; ++_i) \
        __builtin_amdgcn_global_load_lds((const unsigned*)((const char*)(gbase) + (voff)[_i]), (LAS unsigned*)(lds + (bufoff) + ldsw + _i * 8192), 16, 0, 0); } while (0)
#define PG8_STAGE_A(bufoff, gbase, vv, h) do { _Pragma("unroll") for (int _i = 0; _i < 2; ++_i) \
        __builtin_amdgcn_global_load_lds((const unsigned*)((const char*)(gbase) + (vv)[h][_i]), (LAS unsigned*)(lds + (bufoff) + ldsw + _i * 8192), 16, 0, 0); } while (0)
#define PG8_LDA(dst, b, h) do { _Pragma("unroll") for (int m = 0; m < 4; ++m) _Pragma("unroll") for (int k = 0; k < 2; ++k) dst[m][k] = *(const LAS bf16x8*)(lds + PG8_SA(b, h) + aoff + m * 2048 + k * 1024); } while (0)
#define PG8_LDB(dst, b, h) do { _Pragma("unroll") for (int n = 0; n < 2; ++n) _Pragma("unroll") for (int k = 0; k < 2; ++k) dst[n][k] = *(const LAS bf16x8*)(lds + PG8_SB(b, h) + boff + n * 2048 + k * 1024); } while (0)
#define PG8_MMA(ai, bj, At, Bt) do { __builtin_amdgcn_s_setprio(1); _Pragma("unroll") for (int m = 0; m < 4; ++m) _Pragma("unroll") for (int n = 0; n < 2; ++n) _Pragma("unroll") for (int k = 0; k < 2; ++k) \
        acc[ai][bj][m][n] = __builtin_amdgcn_mfma_f32_16x16x32_bf16(Bt[n][k], At[m][k], acc[ai][bj][m][n], 0, 0, 0); __builtin_amdgcn_s_setprio(0); } while (0)
#define PG8_WAIT_V(n) asm volatile("s_waitcnt vmcnt(" #n ")" ::: "memory")
#define PG8_WAIT_L(n) asm volatile("s_waitcnt lgkmcnt(" #n ")" ::: "memory")
#define PG8_BAR __builtin_amdgcn_s_barrier()
#define PG8_SCHED __builtin_amdgcn_sched_barrier(0)
#define PG8_SETOFF(vv, uu) do { _Pragma("unroll") for (int _h = 0; _h < 2; ++_h) _Pragma("unroll") for (int _i = 0; _i < 2; ++_i) { \
        if constexpr (Sched::GATHER) (vv)[_h][_i] = S.a_row_off((uu), _h * HALF + Rr[_i], rowbytes) + (unsigned)Cc[_i] * 2u; \
        else (vv)[_h][_i] = (unsigned)((_h * HALF + Rr[_i]) * K + Cc[_i]) * 2u; } } while (0)
    Unit cur, nxt; int ui = 0;
    if (!S.next(0, cur)) return;
    f32x4 acc[2][2][4][2];
#pragma unroll
    for (int a = 0; a < 2; ++a)
#pragma unroll
        for (int b = 0; b < 2; ++b)
#pragma unroll
            for (int m = 0; m < 4; ++m)
#pragma unroll
                for (int n = 0; n < 2; ++n) acc[a][b][m][n] = (f32x4){0.f, 0.f, 0.f, 0.f};
    bf16x8 At[4][2], B0[2][2], B1[2][2];
    unsigned vAc[2][2], vAn[2][2];
    PG8_SETOFF(vAc, cur);
    const char* cA = Sched::GATHER ? (const char*)g.A : (const char*)g.A + (size_t)cur.pm * tstep;
    const char* cB = (const char*)g.Bt + (size_t)cur.pb * tstep;
    PG8_STAGE(PG8_SB(0, 0), cB, voffB); PG8_STAGE(PG8_SB(0, 1), cB + hstep, voffB); PG8_STAGE_A(PG8_SA(0, 0), cA, vAc, 0); PG8_STAGE_A(PG8_SA(0, 1), cA, vAc, 1);
    if (wr == 1) PG8_BAR;
    PG8_WAIT_V(2); PG8_BAR;
    PG8_STAGE(PG8_SB(1, 0), cB + kstep, voffB); PG8_STAGE_A(PG8_SA(1, 0), cA + kstep, vAc, 0); PG8_STAGE(PG8_SB(1, 1), cB + hstep + kstep, voffB);
    PG8_WAIT_V(6); PG8_BAR;
    for (;;) {
        const bool has_next = S.next(ui + 1, nxt);
        const char* nA = cA; const char* nB = cB;
        if (has_next) { nA = Sched::GATHER ? (const char*)g.A : (const char*)g.A + (size_t)nxt.pm * tstep; nB = (const char*)g.Bt + (size_t)nxt.pb * tstep; }
        if constexpr (Sched::GATHER) {
            if (has_next) { PG8_SETOFF(vAn, nxt); }
            else {
#pragma unroll
                for (int h = 0; h < 2; ++h)
#pragma unroll
                    for (int i = 0; i < 2; ++i) vAn[h][i] = vAc[h][i];
            }
        }
#pragma unroll 1
        for (int t = 0; t < nt; t += 2) {
            const bool last = (t == nt - 2);
            const char* a1 = cA + (size_t)(t + 1) * kstep;
            const char* a2 = last ? nA : cA + (size_t)(t + 2) * kstep; const char* b2 = last ? nB : cB + (size_t)(t + 2) * kstep;
            const char* a3 = a2 + kstep; const char* b3 = b2 + kstep;
            unsigned vs[2][2];
#pragma unroll
            for (int h = 0; h < 2; ++h)
#pragma unroll
                for (int i = 0; i < 2; ++i) { if constexpr (Sched::GATHER) vs[h][i] = last ? vAn[h][i] : vAc[h][i]; else vs[h][i] = vAc[h][i]; }
            PG8_LDB(B0, 0, 0); PG8_LDB(B1, 0, 1); PG8_SCHED; PG8_LDA(At, 0, 0); PG8_STAGE_A(PG8_SA(1, 1), a1, vAc, 1);
            PG8_WAIT_V(8); PG8_WAIT_L(0); PG8_BAR; PG8_MMA(0, 0, At, B0); PG8_MMA(0, 1, At, B1); PG8_BAR; PG8_SCHED;
            PG8_LDA(At, 0, 1); PG8_STAGE(PG8_SB(0, 0), b2, voffB); PG8_STAGE(PG8_SB(0, 1), b2 + hstep, voffB); PG8_STAGE_A(PG8_SA(0, 0), a2, vs, 0);
            PG8_WAIT_V(8); PG8_WAIT_L(0); PG8_BAR; PG8_MMA(1, 0, At, B0); PG8_MMA(1, 1, At, B1); PG8_BAR; PG8_SCHED;
            PG8_LDB(B0, 1, 0); PG8_LDB(B1, 1, 1); PG8_SCHED; PG8_LDA(At, 1, 0); PG8_STAGE_A(PG8_SA(0, 1), a2, vs, 1);
            PG8_WAIT_V(8); PG8_WAIT_L(0); PG8_BAR; PG8_MMA(0, 0, At, B0); PG8_MMA(0, 1, At, B1); PG8_BAR; PG8_SCHED;
            PG8_LDA(At, 1, 1); PG8_STAGE(PG8_SB(1, 0), b3, voffB); PG8_STAGE(PG8_SB(1, 1), b3 + hstep, voffB); PG8_STAGE_A(PG8_SA(1, 0), a3, vs, 0);
            PG8_WAIT_V(8); PG8_WAIT_L(0); PG8_BAR; PG8_MMA(1, 0, At, B0); PG8_MMA(1, 1, At, B1); PG8_BAR; PG8_SCHED;
        }
        if (wr == 0) PG8_BAR;
        E(acc, cur, wr, wc, fr, fq);
        if (!has_next) break;
#pragma unroll
        for (int a = 0; a < 2; ++a)
#pragma unroll
            for (int b = 0; b < 2; ++b)
#pragma unroll
                for (int m = 0; m < 4; ++m)
#pragma unroll
                    for (int n = 0; n < 2; ++n) acc[a][b][m][n] = (f32x4){0.f, 0.f, 0.f, 0.f};
        cur = nxt; cA = nA; cB = nB; ++ui;
        if constexpr (Sched::GATHER) {
#pragma unroll
            for (int h = 0; h < 2; ++h)
#pragma unroll
                for (int i = 0; i < 2; ++i) vAc[h][i] = vAn[h][i];
        }
        if (wr == 1) PG8_BAR;
    }
    PG8_WAIT_V(0);
    PG8_BAR;
#undef PG8_SA
#undef PG8_SB
#undef PG8_STAGE
#undef PG8_STAGE_A
#undef PG8_LDA
#undef PG8_LDB
#undef PG8_MMA
#undef PG8_WAIT_V
#undef PG8_WAIT_L
#undef PG8_BAR
#undef PG8_SCHED
#undef PG8_SETOFF
}
}

#define XB_TMO      128
#define XB_XCNT(j)  (256  + 64 * (j))
#define XB_XSUB(j)  (1280 + 64 * (j))
#define XB_XGEN(j)  (2304 + 64 * (j))
#define XB_TOP      3328
#define XB_TOPGEN   3392
#define XCD_BAR_WORDS 3456
#define XB_SPIN_CAP (1u << 18)
__device__ __forceinline__ unsigned xb_ld(unsigned* p)              { return __hip_atomic_load(p, __ATOMIC_RELAXED, __HIP_MEMORY_SCOPE_AGENT); }
__device__ __forceinline__ unsigned xb_add(unsigned* p, unsigned v) { return __hip_atomic_fetch_add(p, v, __ATOMIC_RELAXED, __HIP_MEMORY_SCOPE_AGENT); }
__device__ __forceinline__ unsigned xb_xcc_id() { return (unsigned)__builtin_amdgcn_s_getreg((3 << 11) | 20) & 0xFu; }
#define XB_SPIN(cond, bar) do { unsigned _sp = 0; while (cond) { __builtin_amdgcn_s_sleep(1); \
    if ((++_sp & 255u) == 0u) { if (xb_ld(&(bar)[XB_TMO])) break; if (_sp > XB_SPIN_CAP) { atomicAdd(&(bar)[XB_TMO], 1u); break; } } } } while (0)
struct XcdBarrier { unsigned* bar; unsigned x; volatile LAS unsigned* st; };
__device__ __forceinline__ XcdBarrier xcd_barrier_post(unsigned* bar, volatile LAS unsigned* st) {
    XcdBarrier b; b.bar = bar; b.x = xb_xcc_id(); b.st = st;
    if (threadIdx.x == 0) (void)xb_add(&bar[XB_XCNT(b.x)], 1u);
    return b;
}
__device__ __forceinline__ void xcd_barrier_complete(unsigned* bar, unsigned x, unsigned& nloc, unsigned& nx) {
    const unsigned G = gridDim.x * gridDim.y * gridDim.z;
    unsigned sum, cnt, mine, sp = 0u;
    for (;;) {
        sum = 0u; cnt = 0u; mine = 0u;
#pragma unroll
        for (unsigned j = 0; j < 16; ++j) { const unsigned c = xb_ld(&bar[XB_XCNT(j)]); sum += c; cnt += (c > 0u) ? 1u : 0u; mine = (j == x) ? c : mine; }
        if (sum == G) break;
        __builtin_amdgcn_s_sleep(1);
        if ((++sp & 255u) == 0u) { if (xb_ld(&bar[XB_TMO])) break; if (sp > XB_SPIN_CAP) { atomicAdd(&bar[XB_TMO], 1u); break; } }
    }
    nloc = mine > 0u ? mine : 1u; nx = cnt > 0u ? cnt : 1u;
}
__device__ __forceinline__ void xcd_barrier(const XcdBarrier& b) {
    asm volatile("s_waitcnt vmcnt(0)" ::: "memory");
    __syncthreads();
    if (threadIdx.x == 0) {
        unsigned* bar = b.bar;
        __builtin_amdgcn_s_waitcnt(0);
        unsigned nloc = b.st[0], nx = b.st[1];
        if (nloc == 0u) { xcd_barrier_complete(bar, b.x, nloc, nx); b.st[0] = nloc; b.st[1] = nx; }
        const unsigned old = xb_add(&bar[XB_XSUB(b.x)], 1u);
        const unsigned gen = old / nloc;
        if (old + 1u == (gen + 1u) * nloc) {
            __builtin_amdgcn_fence(__ATOMIC_RELEASE, "agent");
            asm volatile("s_waitcnt vmcnt(0)" ::: "memory");
            const unsigned og = xb_add(&bar[XB_TOP], 1u);
            const unsigned tg = og / nx;
            if (og + 1u == (tg + 1u) * nx) xb_add(&bar[XB_TOPGEN], 1u);
            else XB_SPIN(xb_ld(&bar[XB_TOPGEN]) == tg, bar);
            __builtin_amdgcn_fence(__ATOMIC_ACQUIRE, "agent");
            xb_add(&bar[XB_XGEN(b.x)], 1u);
            asm volatile("s_waitcnt vmcnt(0)" ::: "memory");
        } else {
            XB_SPIN(xb_ld(&bar[XB_XGEN(b.x)]) == gen, bar);
            __builtin_amdgcn_fence(__ATOMIC_ACQUIRE, "agent");
            asm volatile("s_waitcnt vmcnt(0)" ::: "memory");
        }
    }
    __syncthreads();
}

constexpr int NWAVES = 8;
constexpr int SEQ = 2048, NB = 16, DM = 1024, NTOK = NB * SEQ;
constexpr int DRW = 512, HD = 64;
constexpr int NPROJ = 3072, NEXT = 3584, NL1 = 512, KL2 = 256, NL2 = 1536;
constexpr int NEXP = 32, DEXP = 512;
constexpr int PROWS_MAX = 65536 + 32 * 256, MAXTILES = PROWS_MAX / 256;
constexpr float LN_EPS = 1e-5f, LNX_EPS = 64e-5f, ALPHA = 1.189207115002721f;

constexpr size_t MiB = 1u << 20;
constexpr size_t WS_CTL = 0, CTL_ZERO_BYTES = 1 * MiB;
constexpr size_t WS_WINT = 1 * MiB;
constexpr size_t WS_W2T = 8 * MiB;
constexpr size_t WS_WOT = 9 * MiB;
constexpr size_t WS_GT = 11 * MiB;
constexpr size_t WS_PT = 13 * MiB;
constexpr size_t WS_BIAS = 13 * MiB + 512 * 1024;
constexpr size_t WS_TOKE = 14 * MiB;
constexpr size_t WS_TOKW = 14 * MiB + 256 * 1024;
constexpr size_t WS_ROWTOK = 14 * MiB + 512 * 1024;
constexpr size_t WS_ROWASG = 15 * MiB;
constexpr size_t WS_ROWW = 15 * MiB + 512 * 1024;
constexpr size_t WS_PB = 16 * MiB;
constexpr size_t WS_X1 = 33 * MiB;
constexpr size_t WS_XB = WS_X1, WS_LORA1 = WS_X1 + 64 * MiB;
constexpr size_t WS_LW = WS_X1, WS_AG = WS_X1 + 64 * MiB;
constexpr size_t WS_P = 161 * MiB;
constexpr size_t WS_WGUT = WS_P, WS_WDT = WS_P + 64 * MiB, WS_HDN = WS_P + 96 * MiB, WS_MOEHI = WS_P;
constexpr size_t WS_Y = 353 * MiB;
constexpr size_t WS_END = 417 * MiB;
constexpr int BIAS_LD = 132;
constexpr int CW_BAR = 4096;
constexpr int CW_CNT = 8192, CW_FILL = 8192 + 64, CW_NTILES = 8192 + 128, CW_TILEE = 8192 + 256;

constexpr int RING_OFF = 0, RING_BYTES = 131072;
constexpr int WRT_BYTES = 36 * 1024 * 4;
constexpr int LDSCTL_OFF = WRT_BYTES, MISC_OFF = LDSCTL_OFF;
constexpr int LDS_BYTES = LDSCTL_OFF + 1024;
constexpr int MW_HIST = 0, MW_CNT = 32, MW_RS = 64, MW_LBASE = 96, MW_LFILL = 128, MW_BAR = 160;

struct Frame {
    LAS unsigned char* lds;
    volatile LAS unsigned* MISC;
    unsigned* ctl;
    int tid, lane, wave, vcu, G;
    unsigned char* ws;
    const float* const* in;
    float* out;
};
enum InIdx { I_X = 0, I_P, I_WIN, I_MURKV, I_MULORA, I_W0, I_WL1, I_WL2, I_A0, I_AL1, I_AL2, I_GL1, I_GL2, I_KK, I_KA, I_RK, I_LNXG, I_LNXB, I_RELB, I_WO,
             I_LN1G, I_LN1B, I_RG, I_RGB, I_RE, I_REB, I_WG, I_WU, I_WD, I_PG, I_PP, I_LN2G, I_LN2B };

__device__ __forceinline__ void tr_item(const float* W, int ldw, int k0, int n0, bf16_t* dst, int ldt, const float* mu, int smode, LAS float* scr, int lane) {
#pragma unroll 8
    for (int i = 0; i < 32; ++i) { const int kk = 2 * i + (lane >> 5); float v = W[(size_t)(k0 + kk) * ldw + n0 + (lane & 31)];
        if (smode == 1) v *= (1.0f - mu[k0 + kk]); else if (smode == 2) v *= mu[k0 + kk];
        scr[kk * 33 + (lane & 31)] = v; }
    LDS_WAIT(); asm volatile("" ::: "memory");
    const int c = lane & 7;
#pragma unroll
    for (int j = 0; j < 4; ++j) { const int n = (lane >> 3) + 8 * j; const LAS float* s = scr + (8 * c) * 33 + n;
        u32x4 o; o.x = pk2(s[0 * 33], s[1 * 33]); o.y = pk2(s[2 * 33], s[3 * 33]); o.z = pk2(s[4 * 33], s[5 * 33]); o.w = pk2(s[6 * 33], s[7 * 33]);
        *(u32x4*)(dst + (size_t)n * ldt + k0 + 8 * c) = o; }
    LDS_WAIT(); asm volatile("" ::: "memory");
}
__device__ __forceinline__ int t5_bucket(int n) {
    if (n < 16) return n;
    int b = 16;
    b += (n >= 22); b += (n >= 30); b += (n >= 40); b += (n >= 54); b += (n >= 73); b += (n >= 99); b += (n >= 134); b += (n >= 182);
    b += (n >= 246); b += (n >= 332); b += (n >= 450); b += (n >= 609); b += (n >= 825); b += (n >= 1117); b += (n >= 1513);
    return b;
}

__device__ __forceinline__ void ph_prologue(Frame& F) {
    const int gt = F.vcu * 512 + F.tid, NGT = F.G * 512;
    const int gw = F.vcu * NWAVES + F.wave, NGW = F.G * NWAVES;
    { const f32x4* x4 = (const f32x4*)F.in[I_X]; u32x4* o = (u32x4*)(F.ws + WS_XB);
      for (int i = gt; i < NTOK * DM / 8; i += NGT) { const f32x4 a = x4[2 * i], b = x4[2 * i + 1]; u32x4 w; w.x = pk2(a.x, a.y); w.y = pk2(a.z, a.w); w.z = pk2(b.x, b.y); w.w = pk2(b.z, b.w); o[i] = w; } }
    { const f32x4* x4 = (const f32x4*)F.in[I_P]; u32x4* o = (u32x4*)(F.ws + WS_PB);
      for (int i = gt; i < NTOK * 256 / 8; i += NGT) { const f32x4 a = x4[2 * i], b = x4[2 * i + 1]; u32x4 w; w.x = pk2(a.x, a.y); w.y = pk2(a.z, a.w); w.z = pk2(b.x, b.y); w.w = pk2(b.z, b.w); o[i] = w; } }
    { bf16_t* w2t = (bf16_t*)(F.ws + WS_W2T);
      for (int i = gt; i < NL2 * KL2; i += NGT) { const int n = i / KL2, k = i % KL2; float v = 0.f;
          if (n < 512) { if (k < 64) v = F.in[I_WL2][k * 512 + n]; }
          else if (n < 1024) { if (k >= 64 && k < 128) v = F.in[I_AL2][(k - 64) * 512 + (n - 512)]; }
          else { if (k >= 128) v = F.in[I_GL2][(k - 128) * 512 + (n - 1024)]; }
          w2t[i] = (bf16_t)f2bf(v); } }
    { float* bt = (float*)(F.ws + WS_BIAS);
      for (int i = gt; i < 3 * 8 * BIAS_LD; i += NGT) { const int p = i / (8 * BIAS_LD), h = (i / BIAS_LD) % 8, m = i % BIAS_LD; const int dil = 1 << (2 * p);
          bt[i] = (m <= 128) ? F.in[I_RELB][t5_bucket(m * dil) * 8 + h] : 0.f; } }
    LAS float* scr = (LAS float*)(F.lds + RING_OFF + F.wave * 16384);
    constexpr int IT_WIN = 16 * 96, IT_L1 = 256, IT_WO = 512, IT_G = 512, IT_PP = 128;
    constexpr int NIT = IT_WIN + IT_L1 + IT_WO + IT_G + IT_PP;
    bf16_t* WinT = (bf16_t*)(F.ws + WS_WINT);
    for (int it = gw; it < NIT; it += NGW) {
        int r = it;
        if (r < IT_WIN) { const int kb = r / 96, nb = r % 96; tr_item(F.in[I_WIN], NPROJ, kb * 64, nb * 32, WinT + (size_t)(nb * 32) * DM, DM, nullptr, 0, scr, F.lane); continue; } r -= IT_WIN;
        if (r < IT_L1) {
            int piece, sub;
            if (r < 128) { piece = r / 32; sub = r % 32; } else { piece = 4 + (r - 128) / 64; sub = (r - 128) % 64; }
            const int which = piece >> 1, isprev = piece & 1;
            const int ncols = (which == 2) ? 128 : 64, nblk = ncols / 32;
            const int kb = sub / nblk, nb = sub % nblk;
            const float* src = (which == 0) ? F.in[I_WL1] : (which == 1) ? F.in[I_AL1] : F.in[I_GL1];
            const int rowbase = (which == 0) ? 3072 + 64 * isprev : (which == 1) ? 3200 + 64 * isprev : 3328 + 128 * isprev;
            tr_item(src, ncols, kb * 64, nb * 32, WinT + (size_t)(rowbase + nb * 32) * DM, DM, F.in[I_MULORA] + which * DM, isprev ? 2 : 1, scr, F.lane); continue; } r -= IT_L1;
        if (r < IT_WO) { const int kb = r / 32, nb = r % 32; tr_item(F.in[I_WO], DM, kb * 64, nb * 32, (bf16_t*)(F.ws + WS_WOT) + (size_t)(nb * 32) * DM, DM, nullptr, 0, scr, F.lane); continue; } r -= IT_WO;
        if (r < IT_G) { const int kb = r / 32, nb = r % 32; tr_item(F.in[I_PG], DM, kb * 64, nb * 32, (bf16_t*)(F.ws + WS_GT) + (size_t)(nb * 32) * DM, DM, nullptr, 0, scr, F.lane); continue; } r -= IT_G;
        { const int kb = r / 32, nb = r % 32; tr_item(F.in[I_PP], DM, kb * 64, nb * 32, (bf16_t*)(F.ws + WS_PT) + (size_t)(nb * 32) * 256, 256, nullptr, 0, scr, F.lane); }
    }
}
__device__ __forceinline__ void ph_moe_weights(Frame& F) {
    const int gw = F.vcu * NWAVES + F.wave, NGW = F.G * NWAVES;
    LAS float* scr = (LAS float*)(F.lds + RING_OFF + F.wave * 16384);
    constexpr int IT_GU = 64 * 256, IT_D = 32 * 256;
    for (int it = gw; it < IT_GU + IT_D; it += NGW) {
        if (it < IT_GU) { const int mat = it / 256, sub = it % 256, e = mat >> 1, up = mat & 1, kb = sub / 16, nb = sub % 16, n0 = nb * 32;
            const float* src = (up ? F.in[I_WU] : F.in[I_WG]) + (size_t)e * DM * DEXP;
            bf16_t* dst = (bf16_t*)(F.ws + WS_WGUT) + ((size_t)e * 1024 + (n0 >> 7) * 256 + up * 128 + (n0 & 127)) * DM;
            tr_item(src, DEXP, kb * 64, n0, dst, DM, nullptr, 0, scr, F.lane); }
        else { const int r = it - IT_GU, e = r / 256, sub = r % 256, kb = sub / 32, nb = sub % 32;
            const float* src = F.in[I_WD] + (size_t)e * DEXP * DM;
            bf16_t* dst = (bf16_t*)(F.ws + WS_WDT) + ((size_t)e * 1024 + nb * 32) * DEXP;
            tr_item(src, DM, kb * 64, nb * 32, dst, DEXP, nullptr, 0, scr, F.lane); }
    }
}

using pg8::Unit; using pg8::cvt_pk_bf16;
struct EpiProj {
    static constexpr bool PERM = true;
    bf16_t* proj; float* lora1;
    __device__ __forceinline__ void operator()(const f32x4 (&acc)[2][2][4][2], const Unit& u, int wr, int wc, int fr, int fq) const {
        const int row0 = u.pm * 256 + wr * 64 + fr;
        if (u.pn < 12) {
            const int col0 = u.pn * 256 + wc * 32 + 8 * fq;
#pragma unroll
            for (int ai = 0; ai < 2; ++ai)
#pragma unroll
                for (int m = 0; m < 4; ++m) { bf16_t* rowp = proj + (size_t)(row0 + ai * 128 + m * 16) * NPROJ + col0;
#pragma unroll
                    for (int bj = 0; bj < 2; ++bj) { const f32x4 v0 = acc[ai][bj][m][0], v1 = acc[ai][bj][m][1]; u32x4 w;
                        w.x = cvt_pk_bf16(v0[0], v0[1]); w.y = cvt_pk_bf16(v0[2], v0[3]); w.z = cvt_pk_bf16(v1[0], v1[1]); w.w = cvt_pk_bf16(v1[2], v1[3]);
                        *(u32x4*)(rowp + bj * 128) = w; } }
        } else {
            const int col0 = (u.pn - 12) * 256 + wc * 32 + 8 * fq;
#pragma unroll
            for (int ai = 0; ai < 2; ++ai)
#pragma unroll
                for (int m = 0; m < 4; ++m) { float* rowp = lora1 + (size_t)(row0 + ai * 128 + m * 16) * NL1 + col0;
#pragma unroll
                    for (int bj = 0; bj < 2; ++bj) { *(f32x4*)(rowp + bj * 128) = acc[ai][bj][m][0]; *(f32x4*)(rowp + bj * 128 + 4) = acc[ai][bj][m][1]; } }
        }
    }
};
struct EpiDag {
    static constexpr bool PERM = true;
    float* lw; bf16_t* ag; const float* w0; const float* a0;
    __device__ __forceinline__ void operator()(const f32x4 (&acc)[2][2][4][2], const Unit& u, int wr, int wc, int fr, int fq) const {
        const int row0 = u.pm * 256 + wr * 64 + fr;
        const int colt = u.pn * 256 + wc * 32 + 8 * fq;
        if (u.pn < 2) {
#pragma unroll
            for (int bj = 0; bj < 2; ++bj) {
                const f32x4 b0 = *(const f32x4*)(w0 + colt + bj * 128), b1 = *(const f32x4*)(w0 + colt + bj * 128 + 4);
#pragma unroll
                for (int ai = 0; ai < 2; ++ai)
#pragma unroll
                    for (int m = 0; m < 4; ++m) { float* rowp = lw + (size_t)(row0 + ai * 128 + m * 16) * 512 + colt + bj * 128;
                        const f32x4 z0 = acc[ai][bj][m][0] + b0, z1 = acc[ai][bj][m][1] + b1; f32x4 o0, o1;
#pragma unroll
                        for (int j = 0; j < 4; ++j) { o0[j] = -0.6065306597126334f * sigmoidf_(z0[j]); o1[j] = -0.6065306597126334f * sigmoidf_(z1[j]); }
                        *(f32x4*)(rowp) = o0; *(f32x4*)(rowp + 4) = o1; }
                asm volatile("" ::: "memory");
            }
        } else {
            const bool isa = (u.pn < 4);
#pragma unroll
            for (int bj = 0; bj < 2; ++bj) {
                f32x4 b0 = (f32x4){0.f, 0.f, 0.f, 0.f}, b1 = (f32x4){0.f, 0.f, 0.f, 0.f};
                if (isa) { b0 = *(const f32x4*)(a0 + (colt - 512) + bj * 128); b1 = *(const f32x4*)(a0 + (colt - 512) + bj * 128 + 4); }
#pragma unroll
                for (int ai = 0; ai < 2; ++ai)
#pragma unroll
                    for (int m = 0; m < 4; ++m) { bf16_t* rowp = ag + (size_t)(row0 + ai * 128 + m * 16) * 1024 + (colt - 512) + bj * 128;
                        f32x4 v0 = acc[ai][bj][m][0] + b0, v1 = acc[ai][bj][m][1] + b1;
                        if (isa) {
#pragma unroll
                            for (int j = 0; j < 4; ++j) { v0[j] = sigmoidf_(v0[j]); v1[j] = sigmoidf_(v1[j]); } }
                        u32x4 w; w.x = cvt_pk_bf16(v0[0], v0[1]); w.y = cvt_pk_bf16(v0[2], v0[3]); w.z = cvt_pk_bf16(v1[0], v1[1]); w.w = cvt_pk_bf16(v1[2], v1[3]);
                        *(u32x4*)(rowp) = w; }
                asm volatile("" ::: "memory");
            }
        }
    }
};
struct EpiWo {
    static constexpr bool PERM = false;
    const float* x; float* pre1;
    __device__ __forceinline__ void operator()(const f32x4 (&acc)[2][2][4][2], const Unit& u, int wr, int wc, int fr, int fq) const {
        const int row0 = u.pm * 256 + wr * 64 + fr, col0 = u.pn * 256 + wc * 32 + 4 * fq;
#pragma unroll
        for (int ai = 0; ai < 2; ++ai)
#pragma unroll
            for (int m = 0; m < 4; ++m) { const size_t off = (size_t)(row0 + ai * 128 + m * 16) * DM + col0;
#pragma unroll
                for (int bj = 0; bj < 2; ++bj)
#pragma unroll
                    for (int n = 0; n < 2; ++n) { const f32x4 xv = *(const f32x4*)(x + off + bj * 128 + n * 16); *(f32x4*)(pre1 + off + bj * 128 + n * 16) = xv * ALPHA + acc[ai][bj][m][n]; }
                asm volatile("" ::: "memory"); }
    }
};
struct EpiF32 {
    static constexpr bool PERM = false;
    float* C; int ldc;
    __device__ __forceinline__ void operator()(const f32x4 (&acc)[2][2][4][2], const Unit& u, int wr, int wc, int fr, int fq) const {
        const int row0 = u.pm * 256 + wr * 64 + fr, col0 = u.pn * 256 + wc * 32 + 4 * fq;
#pragma unroll
        for (int ai = 0; ai < 2; ++ai)
#pragma unroll
            for (int m = 0; m < 4; ++m) { float* rowp = C + (size_t)(row0 + ai * 128 + m * 16) * ldc + col0;
#pragma unroll
                for (int bj = 0; bj < 2; ++bj)
#pragma unroll
                    for (int n = 0; n < 2; ++n) *(f32x4*)(rowp + bj * 128 + n * 16) = acc[ai][bj][m][n]; }
    }
};
struct EpiPle {
    static constexpr bool PERM = false;
    float* C; int ldc;
    __device__ __forceinline__ void operator()(const f32x4 (&acc)[2][2][4][2], const Unit& u, int wr, int wc, int fr, int fq) const {
        const int row0 = u.pm * 256 + wr * 64 + fr, col0 = u.pn * 256 + wc * 32 + 4 * fq;
#pragma unroll
        for (int ai = 0; ai < 2; ++ai)
#pragma unroll
            for (int m = 0; m < 4; ++m) { float* rowp = C + (size_t)(row0 + ai * 128 + m * 16) * ldc + col0;
#pragma unroll
                for (int bj = 0; bj < 2; ++bj)
#pragma unroll
                    for (int n = 0; n < 2; ++n) { const f32x4 pv = *(const f32x4*)(rowp + bj * 128 + n * 16); const f32x4 a = acc[ai][bj][m][n]; f32x4 o;
#pragma unroll
                        for (int j = 0; j < 4; ++j) o[j] = sigmoidf_(a[j]) * pv[j];
                        *(f32x4*)(rowp + bj * 128 + n * 16) = o; }
                asm volatile("" ::: "memory"); }
    }
};
struct EpiGU {
    static constexpr bool PERM = true;
    bf16_t* hdn;
    __device__ __forceinline__ void operator()(const f32x4 (&acc)[2][2][4][2], const Unit& u, int wr, int wc, int fr, int fq) const {
        const int row0 = u.pm * 256 + wr * 64 + fr, col0 = u.pn * 128 + wc * 32 + 8 * fq;
#pragma unroll
        for (int ai = 0; ai < 2; ++ai)
#pragma unroll
            for (int m = 0; m < 4; ++m) { bf16_t* rowp = hdn + (size_t)(row0 + ai * 128 + m * 16) * DEXP + col0; float h[8];
#pragma unroll
                for (int n = 0; n < 2; ++n)
#pragma unroll
                    for (int j = 0; j < 4; ++j) { const float gt = acc[ai][0][m][n][j], up = acc[ai][1][m][n][j]; h[4 * n + j] = gt * sigmoidf_(gt) * up; }
                u32x4 w; w.x = cvt_pk_bf16(h[0], h[1]); w.y = cvt_pk_bf16(h[2], h[3]); w.z = cvt_pk_bf16(h[4], h[5]); w.w = cvt_pk_bf16(h[6], h[7]);
                *(u32x4*)rowp = w; }
    }
};
struct EpiDown {
    static constexpr bool PERM = true;
    bf16_t* lo; bf16_t* hi; const int* row_asg; const float* row_w;
    __device__ __forceinline__ void operator()(const f32x4 (&acc)[2][2][4][2], const Unit& u, int wr, int wc, int fr, int fq) const {
        const int row0 = u.pm * 256 + wr * 64 + fr, col0 = u.pn * 256 + wc * 32 + 8 * fq;
#pragma unroll
        for (int ai = 0; ai < 2; ++ai)
#pragma unroll
            for (int m = 0; m < 4; ++m) { const int prow = row0 + ai * 128 + m * 16; const int asg = row_asg[prow]; const float w = row_w[prow];
                if (asg >= 0) { bf16_t* rowp = (asg < 32768 ? lo + (size_t)asg * DM : hi + (size_t)(asg - 32768) * DM) + col0;
#pragma unroll
                    for (int bj = 0; bj < 2; ++bj) { const f32x4 v0 = acc[ai][bj][m][0] * w, v1 = acc[ai][bj][m][1] * w; u32x4 o;
                        o.x = cvt_pk_bf16(v0[0], v0[1]); o.y = cvt_pk_bf16(v0[2], v0[3]); o.z = cvt_pk_bf16(v1[0], v1[1]); o.w = cvt_pk_bf16(v1[2], v1[3]);
                        *(u32x4*)(rowp + bj * 128) = o; } } }
    }
};

__device__ __forceinline__ void ph_lora_act(Frame& F) {
    const int gt = F.vcu * 512 + F.tid, NGT = F.G * 512;
    const float* l1 = (const float*)(F.ws + WS_LORA1); bf16_t* act = (bf16_t*)(F.ws + WS_Y);
    for (int i = gt; i < NTOK * 64; i += NGT) {
        const int t = i >> 6, c4 = (i & 63) * 4; const bool first = (t % SEQ) == 0;
        int ca, cb, mode;
        if (c4 < 64) { ca = c4; cb = 64 + c4; mode = 0; } else if (c4 < 128) { ca = 128 + (c4 - 64); cb = 192 + (c4 - 64); mode = 1; } else { ca = 256 + (c4 - 128); cb = 384 + (c4 - 128); mode = 2; }
        f32x4 a = *(const f32x4*)(l1 + (size_t)t * NL1 + ca);
        if (!first) a += *(const f32x4*)(l1 + (size_t)(t - 1) * NL1 + cb);
        float o[4];
#pragma unroll
        for (int j = 0; j < 4; ++j) o[j] = (mode == 0) ? tanhf(a[j]) : (mode == 1) ? a[j] : sigmoidf_(a[j]);
        u32x2 w; w.x = pk2(o[0], o[1]); w.y = pk2(o[2], o[3]);
        *(u32x2*)(act + (size_t)t * KL2 + c4) = w;
    }
}

__device__ __forceinline__ void ph_scan_simple(Frame& F) {
    if (F.vcu >= 128 || F.wave != 0) return;
    const int bh = F.vcu, b = bh >> 3, h = bh & 7, lane = F.lane, c = h * 64 + lane;
    LAS float* vec = (LAS float*)(F.lds + RING_OFF);
    const bf16_t* proj = (const bf16_t*)(F.ws + WS_P); const float* lwb = (const float*)(F.ws + WS_LW); const bf16_t* ag = (const bf16_t*)(F.ws + WS_AG);
    bf16_t* ycat = (bf16_t*)(F.ws + WS_Y);
    const float mu_r = F.in[I_MURKV][c], mu_k = F.in[I_MURKV][512 + c], mu_v = F.in[I_MURKV][1024 + c];
    const float k_k = F.in[I_KK][c], k_a = F.in[I_KA][c], r_k = F.in[I_RK][c], lg = F.in[I_LNXG][c], lb = F.in[I_LNXB][c];
    float S[64];
#pragma unroll
    for (int k = 0; k < 64; ++k) S[k] = 0.f;
    float rp = 0.f, kp = 0.f, vp = 0.f;
    for (int s = 0; s < SEQ; ++s) {
        const size_t t = (size_t)b * SEQ + s;
        const float r_in = bf2f(proj[t * NPROJ + c]), k_in = bf2f(proj[t * NPROJ + 512 + c]), v_in = bf2f(proj[t * NPROJ + 1024 + c]);
        const float r = r_in + (rp - r_in) * mu_r, k = k_in + (kp - k_in) * mu_k, v = v_in + (vp - v_in) * mu_v;
        rp = r_in; kp = k_in; vp = v_in;
        const float w = __expf(lwb[t * 512 + c]);
        const float a = bf2f(ag[t * 1024 + c]), g = bf2f(ag[t * 1024 + 512 + c]);
        float kk = k * k_k; const float ss = wave_sum(kk * kk); kk *= rsqrtf(fmaxf(ss, 1e-24f));
        const float kq = k * (1.0f + (a - 1.0f) * k_a);
        const float bonus = wave_sum(r * kq * r_k);
        vec[lane] = -kk; vec[64 + lane] = w; vec[128 + lane] = kk * a; vec[192 + lane] = kq; vec[256 + lane] = r;
        LDS_WAIT();
        float sa = 0.f;
#pragma unroll
        for (int q = 0; q < 16; ++q) { const f32x4 a4 = *(const LAS f32x4*)(vec + 4 * q); sa += S[4 * q] * a4[0]; sa += S[4 * q + 1] * a4[1]; sa += S[4 * q + 2] * a4[2]; sa += S[4 * q + 3] * a4[3]; if ((q & 3) == 3) __builtin_amdgcn_sched_barrier(0); }
        float y = 0.f;
#pragma unroll
        for (int q = 0; q < 16; ++q) { const f32x4 w4 = *(const LAS f32x4*)(vec + 64 + 4 * q), b4 = *(const LAS f32x4*)(vec + 128 + 4 * q), k4 = *(const LAS f32x4*)(vec + 192 + 4 * q), r4 = *(const LAS f32x4*)(vec + 256 + 4 * q);
#pragma unroll
            for (int j = 0; j < 4; ++j) { const float sn = S[4 * q + j] * w4[j] + sa * b4[j] + v * k4[j]; S[4 * q + j] = sn; y += sn * r4[j]; }
            __builtin_amdgcn_sched_barrier(0); }
        LDS_WAIT();
        const float mean = wave_sum(y) * (1.0f / 64.0f); const float d = y - mean; const float var = wave_sum(d * d) * (1.0f / 64.0f);
        const float yn = d * rsqrtf(var + LNX_EPS) * lg + lb;
        ycat[t * DM + c] = (bf16_t)f2bf((yn + bonus * v) * g);
    }
}

__device__ __forceinline__ void ph_attn_simple(Frame& F) {
    const int gw = F.vcu * NWAVES + F.wave, NGW = F.G * NWAVES;
    const bf16_t* proj = (const bf16_t*)(F.ws + WS_P); bf16_t* ycat = (bf16_t*)(F.ws + WS_Y); const float* bt = (const float*)(F.ws + WS_BIAS);
    for (int it = gw; it < NB * 8 * (SEQ / 64); it += NGW) {
        const int sblk = it % (SEQ / 64), h = (it / (SEQ / 64)) % 8, b = it / (8 * (SEQ / 64));
        const int s = sblk * 64 + F.lane; const size_t t = (size_t)b * SEQ + s;
        float q[64], o[64];
        { const u32x4* qp = (const u32x4*)(proj + t * NPROJ + 1536 + h * 64);
#pragma unroll
          for (int i = 0; i < 8; ++i) { const u32x4 w = qp[i]; q[8 * i] = bf_lo(w.x) * 0.125f; q[8 * i + 1] = bf_hi(w.x) * 0.125f; q[8 * i + 2] = bf_lo(w.y) * 0.125f; q[8 * i + 3] = bf_hi(w.y) * 0.125f;
              q[8 * i + 4] = bf_lo(w.z) * 0.125f; q[8 * i + 5] = bf_hi(w.z) * 0.125f; q[8 * i + 6] = bf_lo(w.w) * 0.125f; q[8 * i + 7] = bf_hi(w.w) * 0.125f; } }
#pragma unroll
        for (int d = 0; d < 64; ++d) o[d] = 0.f;
        float mx = -1e30f, l = 0.f;
        for (int p = 0; p < 3; ++p) {
            const int dil = 1 << (2 * p); const float* bp = bt + (p * 8 + h) * BIAS_LD;
            for (int m = 0; m <= 128; ++m) {
                const int sp = s - m * dil;
                if (sp >= 0) {
                    const size_t tk = t - (size_t)(m * dil);
                    const u32x4* kp = (const u32x4*)(proj + tk * NPROJ + 2048 + h * 64);
                    float dot = 0.f;
#pragma unroll
                    for (int i = 0; i < 8; ++i) { const u32x4 w = kp[i];
                        dot += q[8 * i] * bf_lo(w.x) + q[8 * i + 1] * bf_hi(w.x) + q[8 * i + 2] * bf_lo(w.y) + q[8 * i + 3] * bf_hi(w.y)
                             + q[8 * i + 4] * bf_lo(w.z) + q[8 * i + 5] * bf_hi(w.z) + q[8 * i + 6] * bf_lo(w.w) + q[8 * i + 7] * bf_hi(w.w); }
                    const float logit = dot + bp[m];
                    const float nm = fmaxf(mx, logit); const float alpha = __expf(mx - nm), pe = __expf(logit - nm);
                    l = l * alpha + pe; mx = nm;
                    const u32x4* vp = (const u32x4*)(proj + tk * NPROJ + 2560 + h * 64);
#pragma unroll
                    for (int i = 0; i < 8; ++i) { const u32x4 w = vp[i];
                        o[8 * i] = o[8 * i] * alpha + pe * bf_lo(w.x); o[8 * i + 1] = o[8 * i + 1] * alpha + pe * bf_hi(w.x);
                        o[8 * i + 2] = o[8 * i + 2] * alpha + pe * bf_lo(w.y); o[8 * i + 3] = o[8 * i + 3] * alpha + pe * bf_hi(w.y);
                        o[8 * i + 4] = o[8 * i + 4] * alpha + pe * bf_lo(w.z); o[8 * i + 5] = o[8 * i + 5] * alpha + pe * bf_hi(w.z);
                        o[8 * i + 6] = o[8 * i + 6] * alpha + pe * bf_lo(w.w); o[8 * i + 7] = o[8 * i + 7] * alpha + pe * bf_hi(w.w); }
                }
            }
        }
        const float inv = 1.0f / l;
        u32x4* op = (u32x4*)(ycat + t * DM + 512 + h * 64);
#pragma unroll
        for (int i = 0; i < 8; ++i) { u32x4 w; w.x = pk2(o[8 * i] * inv, o[8 * i + 1] * inv); w.y = pk2(o[8 * i + 2] * inv, o[8 * i + 3] * inv);
            w.z = pk2(o[8 * i + 4] * inv, o[8 * i + 5] * inv); w.w = pk2(o[8 * i + 6] * inv, o[8 * i + 7] * inv); op[i] = w; }
    }
}

__device__ __forceinline__ void ph_ln1_router(Frame& F) {
    const int gw = F.vcu * NWAVES + F.wave, NGW = F.G * NWAVES, lane = F.lane;
    LAS float* wrt = (LAS float*)(F.lds);
    for (int idx = F.tid; idx < 36 * 1024; idx += 512) { const int cc = idx >> 10, k = idx & 1023;
        wrt[idx] = (cc < 4) ? F.in[I_RG][k * 4 + cc] : F.in[I_RE][k * 32 + (cc - 4)]; }
    if (F.tid < 32) F.MISC[MW_HIST + F.tid] = 0u;
    __syncthreads();
    float* x1 = (float*)(F.ws + WS_X1); bf16_t* x1b = (bf16_t*)(F.ws + WS_Y);
    int* toke = (int*)(F.ws + WS_TOKE); float* tokw = (float*)(F.ws + WS_TOKW);
    f32x4 gv[4], bv[4];
#pragma unroll
    for (int j = 0; j < 4; ++j) { gv[j] = *(const f32x4*)(F.in[I_LN1G] + 4 * lane + 256 * j); bv[j] = *(const f32x4*)(F.in[I_LN1B] + 4 * lane + 256 * j); }
    for (int row = gw; row < NTOK; row += NGW) {
        f32x4 v[4]; float s = 0.f;
        float* xr = x1 + (size_t)row * DM + 4 * lane;
#pragma unroll
        for (int j = 0; j < 4; ++j) { v[j] = *(const f32x4*)(xr + 256 * j); s += (v[j][0] + v[j][1]) + (v[j][2] + v[j][3]); }
        const float mean = wave_sum(s) * (1.0f / DM); float s2 = 0.f;
#pragma unroll
        for (int j = 0; j < 4; ++j) { v[j] = v[j] - mean; s2 += (v[j][0] * v[j][0] + v[j][1] * v[j][1]) + (v[j][2] * v[j][2] + v[j][3] * v[j][3]); }
        const float rstd = rsqrtf(wave_sum(s2) * (1.0f / DM) + LN_EPS);
#pragma unroll
        for (int j = 0; j < 4; ++j) { v[j] = v[j] * rstd * gv[j] + bv[j]; *(f32x4*)(xr + 256 * j) = v[j];
            u32x2 w; w.x = pk2(v[j][0], v[j][1]); w.y = pk2(v[j][2], v[j][3]); *(u32x2*)(x1b + (size_t)row * DM + 4 * lane + 256 * j) = w; }
        float lg[36];
#pragma unroll
        for (int cc = 0; cc < 36; ++cc) { float a = 0.f;
#pragma unroll
            for (int j = 0; j < 4; ++j) { const f32x4 w4 = *(const LAS f32x4*)(wrt + cc * 1024 + 4 * lane + 256 * j); a += v[j][0] * w4[0] + v[j][1] * w4[1] + v[j][2] * w4[2] + v[j][3] * w4[3]; }
            lg[cc] = wave_sum(a); }
        float gl[4];
#pragma unroll
        for (int i = 0; i < 4; ++i) gl[i] = lg[i] + F.in[I_RGB][i];
        int grp = 0; float gm = gl[0];
#pragma unroll
        for (int i = 1; i < 4; ++i) if (gl[i] > gm) { gm = gl[i]; grp = i; }
        float se = 0.f;
#pragma unroll
        for (int i = 0; i < 4; ++i) se += __expf(gl[i] - gm);
        const float wg = 1.0f / se;
        float le[8];
#pragma unroll
        for (int i = 0; i < 8; ++i) { float vsel = lg[4 + i];
#pragma unroll
            for (int gq = 1; gq < 4; ++gq) vsel = (grp == gq) ? lg[4 + gq * 8 + i] : vsel;
            le[i] = vsel + F.in[I_REB][grp * 8 + i]; }
        int i0 = 0; float v0 = le[0];
#pragma unroll
        for (int i = 1; i < 8; ++i) if (le[i] > v0) { v0 = le[i]; i0 = i; }
        int i1 = -1; float v1 = -3.0e38f;
#pragma unroll
        for (int i = 0; i < 8; ++i) if (i != i0 && le[i] > v1) { v1 = le[i]; i1 = i; }
        const float e1 = __expf(v1 - v0); const float w0 = wg / (1.0f + e1), w1 = wg * e1 / (1.0f + e1);
        const int ex0 = grp * 8 + i0, ex1 = grp * 8 + i1;
        if (lane == 0) { toke[2 * row] = ex0; toke[2 * row + 1] = ex1; tokw[2 * row] = w0; tokw[2 * row + 1] = w1;
            atomicAdd((unsigned*)&F.MISC[MW_HIST + ex0], 1u); atomicAdd((unsigned*)&F.MISC[MW_HIST + ex1], 1u); }
    }
    __syncthreads();
    if (F.tid < 32) { const unsigned hc = F.MISC[MW_HIST + F.tid]; if (hc) atomicAdd(F.ctl + CW_CNT + F.tid, hc); }
}

__device__ __forceinline__ void ph_positions(Frame& F) {
    int* toke = (int*)(F.ws + WS_TOKE); float* tokw = (float*)(F.ws + WS_TOKW);
    int* row_tok = (int*)(F.ws + WS_ROWTOK); int* row_asg = (int*)(F.ws + WS_ROWASG); float* row_w = (float*)(F.ws + WS_ROWW);
    if (F.tid < 32) { F.MISC[MW_CNT + F.tid] = __hip_atomic_load(F.ctl + CW_CNT + F.tid, RLX_AGENT); F.MISC[MW_HIST + F.tid] = 0u; F.MISC[MW_LFILL + F.tid] = 0u; }
    __syncthreads();
    if (F.tid == 0) {
        unsigned rs = 0;
        for (int e = 0; e < 32; ++e) { F.MISC[MW_RS + e] = rs; const unsigned nt = (F.MISC[MW_CNT + e] + 255u) >> 8;
            if (blockIdx.x == 0) { for (unsigned q = 0; q < nt; ++q) F.ctl[CW_TILEE + (rs >> 8) + q] = (unsigned)e; }
            rs += nt << 8; }
        if (blockIdx.x == 0) F.ctl[CW_NTILES] = rs >> 8;
    }
    __syncthreads();
    const int per = (NTOK + F.G - 1) / F.G;
    const int base = F.vcu * per;
    for (int a0 = 0; a0 < 2 * per; a0 += 512) {
        const int a = a0 + F.tid; const int tok = base + (a >> 1), j = a & 1; const bool ok = (a < 2 * per) && (tok < NTOK);
        int e = 0; if (ok) { e = toke[2 * tok + j]; atomicAdd((unsigned*)&F.MISC[MW_HIST + e], 1u); }
        __syncthreads();
        if (F.tid < 32) { const unsigned hc = F.MISC[MW_HIST + F.tid]; F.MISC[MW_LBASE + F.tid] = hc ? atomicAdd(F.ctl + CW_FILL + F.tid, hc) : 0u; }
        __syncthreads();
        if (ok) { const unsigned pos = F.MISC[MW_RS + e] + F.MISC[MW_LBASE + e] + atomicAdd((unsigned*)&F.MISC[MW_LFILL + e], 1u);
            row_tok[pos] = tok; row_asg[pos] = 2 * tok + j; row_w[pos] = tokw[2 * tok + j]; }
        __syncthreads();
        if (F.tid < 32) { F.MISC[MW_HIST + F.tid] = 0u; F.MISC[MW_LFILL + F.tid] = 0u; }
        __syncthreads();
    }
    if (F.vcu < 32) { const int e = F.vcu; const unsigned cnt = F.MISC[MW_CNT + e], rs = F.MISC[MW_RS + e], end = ((cnt + 255u) >> 8) << 8;
        for (unsigned r = cnt + F.tid; r < end; r += 512) { row_tok[rs + r] = 0; row_asg[rs + r] = -1; row_w[rs + r] = 0.f; } }
}

__device__ __forceinline__ void ph_final(Frame& F) {
    const int gw = F.vcu * NWAVES + F.wave, NGW = F.G * NWAVES, lane = F.lane;
    const float* x1 = (const float*)(F.ws + WS_X1); const bf16_t* lo = (const bf16_t*)(F.ws + WS_Y); const bf16_t* hi = (const bf16_t*)(F.ws + WS_MOEHI);
    f32x4 gv[4], bv[4];
#pragma unroll
    for (int j = 0; j < 4; ++j) { gv[j] = *(const f32x4*)(F.in[I_LN2G] + 4 * lane + 256 * j); bv[j] = *(const f32x4*)(F.in[I_LN2B] + 4 * lane + 256 * j); }
    for (int row = gw; row < NTOK; row += NGW) {
        const bf16_t* m0 = (row < 16384) ? lo + (size_t)(2 * row) * DM : hi + (size_t)(2 * row - 32768) * DM;
        f32x4 v[4]; float s = 0.f;
#pragma unroll
        for (int j = 0; j < 4; ++j) { const int cix = 4 * lane + 256 * j;
            const f32x4 xv = *(const f32x4*)(x1 + (size_t)row * DM + cix), pv = *(const f32x4*)(F.out + (size_t)row * DM + cix);
            const u32x2 a = *(const u32x2*)(m0 + cix), b = *(const u32x2*)(m0 + DM + cix);
            f32x4 mv; mv[0] = bf_lo(a.x) + bf_lo(b.x); mv[1] = bf_hi(a.x) + bf_hi(b.x); mv[2] = bf_lo(a.y) + bf_lo(b.y); mv[3] = bf_hi(a.y) + bf_hi(b.y);
            v[j] = xv * ALPHA + mv + pv; s += (v[j][0] + v[j][1]) + (v[j][2] + v[j][3]); }
        const float mean = wave_sum(s) * (1.0f / DM); float s2 = 0.f;
#pragma unroll
        for (int j = 0; j < 4; ++j) { v[j] = v[j] - mean; s2 += (v[j][0] * v[j][0] + v[j][1] * v[j][1]) + (v[j][2] * v[j][2] + v[j][3] * v[j][3]); }
        const float rstd = rsqrtf(wave_sum(s2) * (1.0f / DM) + LN_EPS);
#pragma unroll
        for (int j = 0; j < 4; ++j) *(f32x4*)(F.out + (size_t)row * DM + 4 * lane + 256 * j) = v[j] * rstd * gv[j] + bv[j];
    }
}

constexpr int NPHASE = 12;
struct Args { const float* in[33]; float* out; unsigned char* ws; int ph_lo, ph_hi; };
#ifndef PH_MASK
#define PH_MASK 0xfff
#endif
__global__ void __launch_bounds__(NWAVES * 64, 2) hymba_fwd(const Args args) {
    extern __shared__ __attribute__((aligned(16))) unsigned char lds[];
    Frame F;
    F.lds = (LAS unsigned char*)lds;
    F.MISC = (volatile LAS unsigned*)(F.lds + MISC_OFF);
    F.tid = threadIdx.x; F.lane = F.tid & 63; F.wave = __builtin_amdgcn_readfirstlane(F.tid >> 6);
    F.G = gridDim.x; { const int bx = blockIdx.x; F.vcu = (F.G % 8 == 0) ? (bx % 8) * (F.G / 8) + bx / 8 : bx; }
    F.ws = args.ws; F.ctl = (unsigned*)(args.ws + WS_CTL); F.out = args.out;
    F.in = args.in;
    for (int u = F.tid; u < (LDS_BYTES - LDSCTL_OFF) / 4; u += NWAVES * 64) ((LAS unsigned*)(F.lds + LDSCTL_OFF))[u] = 0u;
    __syncthreads();
    const int lo = args.ph_lo, hi = args.ph_hi;
    XcdBarrier bar; bar.bar = F.ctl + CW_BAR; bar.x = 0; bar.st = nullptr;
    if (hi - lo > 1) bar = xcd_barrier_post(F.ctl + CW_BAR, F.MISC + MW_BAR);
#define IN(k) (((PH_MASK >> (k)) & 1) && lo <= (k) && (k) < hi)
#define SEAM(k) do { if (IN(k) && IN((k) + 1)) xcd_barrier(bar); } while (0)
    LAS unsigned char* ring = F.lds + RING_OFF;

    if (IN(0)) { ph_prologue(F); } SEAM(0);
    if (IN(1)) {
        pg8::Gemm g{(const bf16_t*)(F.ws + WS_XB), (const bf16_t*)(F.ws + WS_WINT), DM}; pg8::StaticOrder S; S.init(NTOK, NEXT, F.G, (int)blockIdx.x);
        EpiProj E{(bf16_t*)(F.ws + WS_P), (float*)(F.ws + WS_LORA1)};
        pg8::gemm_phase<EpiProj, pg8::StaticOrder>(ring, g, S, E);
    } SEAM(1);
    if (IN(2)) { ph_lora_act(F); } SEAM(2);
    if (IN(3)) {
        pg8::Gemm g{(const bf16_t*)(F.ws + WS_Y), (const bf16_t*)(F.ws + WS_W2T), KL2}; pg8::StaticOrder S; S.init(NTOK, NL2, F.G, (int)blockIdx.x);
        EpiDag E{(float*)(F.ws + WS_LW), (bf16_t*)(F.ws + WS_AG), F.in[I_W0], F.in[I_A0]};
        pg8::gemm_phase<EpiDag, pg8::StaticOrder>(ring, g, S, E);
    } SEAM(3);
    if (IN(4)) { ph_scan_simple(F); ph_attn_simple(F); } SEAM(4);
    if (IN(5)) {
        pg8::Gemm g{(const bf16_t*)(F.ws + WS_Y), (const bf16_t*)(F.ws + WS_WOT), DM}; pg8::StaticOrder S; S.init(NTOK, DM, F.G, (int)blockIdx.x);
        EpiWo E{F.in[I_X], (float*)(F.ws + WS_X1)};
        pg8::gemm_phase<EpiWo, pg8::StaticOrder>(ring, g, S, E);
    } SEAM(5);
    if (IN(6)) { ph_moe_weights(F); __syncthreads(); ph_ln1_router(F); } SEAM(6);
    if (IN(7)) { ph_positions(F); } SEAM(7);
    if (IN(8)) {
        {
            pg8::MoeOrder<true> S{(const int*)(F.ctl + CW_TILEE), (const int*)(F.ws + WS_ROWTOK), (int)__hip_atomic_load(F.ctl + CW_NTILES, RLX_AGENT), F.G, F.vcu};
            pg8::Gemm g{(const bf16_t*)(F.ws + WS_Y), (const bf16_t*)(F.ws + WS_WGUT), DM};
            EpiGU E{(bf16_t*)(F.ws + WS_HDN)};
            pg8::gemm_phase<EpiGU, pg8::MoeOrder<true>>(ring, g, S, E);
        }
    } SEAM(8);
    if (IN(9)) {
        {
            pg8::Gemm g{(const bf16_t*)(F.ws + WS_PB), (const bf16_t*)(F.ws + WS_PT), 256}; pg8::StaticOrder S; S.init(NTOK, DM, F.G, (int)blockIdx.x);
            EpiF32 E{F.out, DM};
            pg8::gemm_phase<EpiF32, pg8::StaticOrder>(ring, g, S, E);
        }
        {
            pg8::Gemm g{(const bf16_t*)(F.ws + WS_Y), (const bf16_t*)(F.ws + WS_GT), DM}; pg8::StaticOrder S; S.init(NTOK, DM, F.G, (int)blockIdx.x);
            EpiPle E{F.out, DM};
            pg8::gemm_phase<EpiPle, pg8::StaticOrder>(ring, g, S, E);
        }
    } SEAM(9);
    if (IN(10)) {
        pg8::MoeOrder<false> S{(const int*)(F.ctl + CW_TILEE), (const int*)(F.ws + WS_ROWTOK), (int)__hip_atomic_load(F.ctl + CW_NTILES, RLX_AGENT), F.G, F.vcu};
        pg8::Gemm g{(const bf16_t*)(F.ws + WS_HDN), (const bf16_t*)(F.ws + WS_WDT), DEXP};
        EpiDown E{(bf16_t*)(F.ws + WS_Y), (bf16_t*)(F.ws + WS_MOEHI), (const int*)(F.ws + WS_ROWASG), (const float*)(F.ws + WS_ROWW)};
        pg8::gemm_phase<EpiDown, pg8::MoeOrder<false>>(ring, g, S, E);
    } SEAM(10);
    if (IN(11)) { ph_final(F); }
#undef IN
#undef SEAM
}

extern "C" void kernel_launch(void* const* d_in, const int* in_sizes, int n_in, void* d_out, int out_size, void* d_ws, size_t ws_size, hipStream_t stream) {
    static int grid = 0;
    if (grid == 0) {
        if (n_in != 33 || in_sizes[0] != NTOK * DM || out_size != NTOK * DM || ws_size < WS_END) { fprintf(stderr, "kernel_launch: unexpected problem (n_in %d, in0 %d, out %d, ws %zu)\n", n_in, n_in > 0 ? in_sizes[0] : -1, out_size, ws_size); grid = -1; return; }
        int dev = 0, cus = 0;
        if (hipGetDevice(&dev) != hipSuccess || hipDeviceGetAttribute(&cus, hipDeviceAttributeMultiprocessorCount, dev) != hipSuccess) { grid = -1; return; }
        if (hipFuncSetAttribute((const void*)hymba_fwd, hipFuncAttributeMaxDynamicSharedMemorySize, LDS_BYTES) != hipSuccess) { fprintf(stderr, "kernel_launch: hipFuncSetAttribute failed\n"); grid = -1; return; }
        int per_cu = 0;
        if (hipOccupancyMaxActiveBlocksPerMultiprocessor(&per_cu, (const void*)hymba_fwd, NWAVES * 64, LDS_BYTES) != hipSuccess || per_cu < 1) fprintf(stderr, "kernel_launch: occupancy query reports %d\n", per_cu);
        (void)hipGetLastError();
        grid = cus;
    }
    if (grid < 0) return;
    if (hipMemsetAsync((char*)d_ws + WS_CTL, 0, CTL_ZERO_BYTES, stream) != hipSuccess) return;
    Args a{};
    for (int i = 0; i < 33; ++i) a.in[i] = (const float*)d_in[i];
    a.out = (float*)d_out; a.ws = (unsigned char*)d_ws;
#if MK_ONE_LAUNCH
    a.ph_lo = 0; a.ph_hi = NPHASE;
    hipLaunchKernelGGL(hymba_fwd, dim3(grid), dim3(NWAVES * 64), LDS_BYTES, stream, a);
#else
    for (int ph = 0; ph < NPHASE; ++ph) { a.ph_lo = ph; a.ph_hi = ph + 1; hipLaunchKernelGGL(hymba_fwd, dim3(grid), dim3(NWAVES * 64), LDS_BYTES, stream, a); }
#endif
}
```

```cpp
#include <hip/hip_runtime.h>
#include <cstdio>
#include <cstdint>

#ifndef MK_ONE_LAUNCH
#define MK_ONE_LAUNCH 1
#endif

#define GAS __attribute__((address_space(1)))
#define LAS __attribute__((address_space(3)))
typedef unsigned short bf16_t;
typedef short bf16x8 __attribute__((ext_vector_type(8)));
typedef float f32x4 __attribute__((ext_vector_type(4)));
typedef float f32x2 __attribute__((ext_vector_type(2)));
typedef unsigned u32x4 __attribute__((ext_vector_type(4)));
typedef unsigned u32x2 __attribute__((ext_vector_type(2)));
#define RLX_AGENT __ATOMIC_RELAXED, __HIP_MEMORY_SCOPE_AGENT
#define LDS_WAIT() asm volatile("s_waitcnt lgkmcnt(0)" ::: "memory")
#define VM_WAIT() asm volatile("s_waitcnt vmcnt(0)" ::: "memory")

__device__ __forceinline__ unsigned f2bf(float f) { unsigned u = __builtin_bit_cast(unsigned, f); return (u + 0x7fffu + ((u >> 16) & 1u)) >> 16; }
__device__ __forceinline__ unsigned pk2(float lo, float hi) { return f2bf(lo) | (f2bf(hi) << 16); }
__device__ __forceinline__ float bf_lo(unsigned w) { return __builtin_bit_cast(float, w << 16); }
__device__ __forceinline__ float bf_hi(unsigned w) { return __builtin_bit_cast(float, w & 0xffff0000u); }
__device__ __forceinline__ float bf2f(bf16_t b) { return __builtin_bit_cast(float, ((unsigned)b) << 16); }
__device__ __forceinline__ float sigmoidf_(float z) { return __builtin_amdgcn_rcpf(1.0f + __builtin_amdgcn_exp2f(-1.4426950408889634f * z)); }
__device__ __forceinline__ float wave_sum(float v) {
#pragma unroll
    for (int o = 1; o < 64; o <<= 1) v += __shfl_xor(v, o);
    return v;
}

namespace pg8 {
constexpr int BM = 256, BK = 64, HALF = 128, HTB = HALF * BK * 2, STAGE_BYTES = 8 * HTB, NXCD = 8, WGM = 8;
__host__ __device__ __forceinline__ int lds_byte(int r, int c) { const int st = (r >> 4) * 2 + (c >> 5), rr = r & 15, cc = c & 31, ob = rr * 64 + cc * 2; return st * 1024 + (ob ^ (((ob >> 9) & 1) << 5)); }
__host__ __device__ __forceinline__ void stage_rc(int b, int& R, int& C) { const int st = b / 1024, sb = b % 1024, swz = sb ^ (((sb >> 9) & 1) << 5); R = (st >> 1) * 16 + swz / 64; C = (st & 1) * 32 + (swz % 64) / 2; }
__host__ __device__ __forceinline__ int perm32(int rho) { const int n = rho >> 4, i = rho & 15; return 8 * (i >> 2) + 4 * n + (i & 3); }

struct Unit { int pm, pn, pb; };
struct Gemm { const bf16_t* A; const bf16_t* Bt; int K; };

struct StaticOrder {
    static constexpr bool GATHER = false;
    int nM, nN, nwg, G, c;
    __device__ void init(int M, int N, int G_, int c_) { nM = M / BM; nN = N / BM; nwg = nM * nN; G = G_; c = c_; }
    __device__ bool next(int i, Unit& u) const {
        const long L = (long)i * G + c; if (L >= nwg) return false;
        int wgid = (int)L; { const int q = nwg / NXCD, r = nwg % NXCD, xcd = wgid % NXCD, off = wgid / NXCD; wgid = (xcd < r ? xcd * (q + 1) : r * (q + 1) + (xcd - r) * q) + off; }
        const int nig = WGM * nN, gid = wgid / nig, fm = gid * WGM, gsz = (nM - fm) < WGM ? (nM - fm) : WGM;
        u.pm = fm + ((wgid % nig) % gsz); u.pn = (wgid % nig) / gsz; u.pb = u.pn; return true;
    }
    __device__ __forceinline__ unsigned a_row_off(const Unit&, int, unsigned) const { return 0u; }
};
template <bool GATHER_> struct MoeOrder {
    static constexpr bool GATHER = GATHER_;
    const int* tile_e; const int* row_tok; int ntiles, G, c;
    __device__ bool next(int i, Unit& u) const {
        const long L = (long)i * G + c; if (L >= (long)ntiles * 4) return false;
        const int tile = (int)(L >> 2), pn = (int)(L & 3);
        u.pm = tile; u.pn = pn; u.pb = tile_e[tile] * 4 + pn; return true;
    }
    __device__ __forceinline__ unsigned a_row_off(const Unit& u, int r, unsigned rowbytes) const { return (unsigned)row_tok[u.pm * 256 + r] * rowbytes; }
};

__device__ __forceinline__ unsigned cvt_pk_bf16(float lo, float hi) { unsigned r; asm volatile("v_cvt_pk_bf16_f32 %0, %1, %2" : "=v"(r) : "v"(lo), "v"(hi)); return r; }

template <class Epi, class Sched>
__device__ __forceinline__ void gemm_phase(LAS unsigned char* lds, const Gemm g, const Sched& S, const Epi& E) {
    const int tid = threadIdx.x, wid = __builtin_amdgcn_readfirstlane(tid >> 6), lane = tid & 63, wr = wid >> 2, wc = wid & 3, fr = lane & 15, fq = lane >> 4;
    const int K = g.K, nt = K / BK;
    int Rr[2], Cc[2];
    unsigned voffB[2];
#pragma unroll
    for (int i = 0; i < 2; ++i) { int R, C; stage_rc(tid * 16 + i * 8192, R, C); const int Rb = Epi::PERM ? ((R & ~31) + perm32(R & 31)) : R;
        Rr[i] = R; Cc[i] = C; voffB[i] = (unsigned)(Rb * K + C) * 2u; }
    const unsigned rowbytes = (unsigned)K * 2u;
    const size_t kstep = (size_t)(BK * 2);
    const size_t hstep = (size_t)HALF * K * 2;
    const size_t tstep = 2 * hstep;
    const unsigned ldsw = (unsigned)wid * 1024u;
    const int aoff = lds_byte(wr * 64 + fr, fq * 8), boff = lds_byte(wc * 32 + fr, fq * 8);
#define PG8_SA(b, h) (((b) * 2 + (h)) * HTB)
#define PG8_SB(b, h) ((4 + (b) * 2 + (h)) * HTB)
#define PG8_STAGE(bufoff, gbase, voff) do { _Pragma("unroll") for (int _i = 0; _i < 2; ++_i) \
        __builtin_amdgcn_global_load_lds((const unsigned*)((const char*)(gbase) + (voff)[_i]), (LAS unsigned*)(lds + (bufoff) + ldsw + _i * 8192), 16, 0, 0); } while (0)
#define PG8_STAGE_A(bufoff, gbase, vv, h) do { _Pragma("unroll") for (int _i = 0; _i < 2; ++_i) \
        __builtin_amdgcn_global_load_lds((const unsigned*)((const char*)(gbase) + (vv)[h][_i]), (LAS unsigned*)(lds + (bufoff) + ldsw + _i * 8192), 16, 0, 0); } while (0)
#define PG8_LDA(dst, b, h) do { _Pragma("unroll") for (int m = 0; m < 4; ++m) _Pragma("unroll") for (int k = 0; k < 2; ++k) dst[m][k] = *(const LAS bf16x8*)(lds + PG8_SA(b, h) + aoff + m * 2048 + k * 1024); } while (0)
#define PG8_LDB(dst, b, h) do { _Pragma("unroll") for (int n = 0; n < 2; ++n) _Pragma("unroll") for (int k = 0; k < 2; ++k) dst[n][k] = *(const LAS bf16x8*)(lds + PG8_SB(b, h) + boff + n * 2048 + k * 1024); } while (0)
#define PG8_MMA(ai, bj, At, Bt) do { __builtin_amdgcn_s_setprio(1); _Pragma("unroll") for (int m = 0; m < 4; ++m) _Pragma("unroll") for (int n = 0; n < 2; ++n) _Pragma("unroll") for (int k = 0; k < 2; ++k) \
        acc[ai][bj][m][n] = __builtin_amdgcn_mfma_f32_16x16x32_bf16(Bt[n][k], At[m][k], acc[ai][bj][m][n], 0, 0, 0); __builtin_amdgcn_s_setprio(0); } while (0)
#define PG8_WAIT_V(n) asm volatile("s_waitcnt vmcnt(" #n ")" ::: "memory")
#define PG8_WAIT_L(n) asm volatile("s_waitcnt lgkmcnt(" #n ")" ::: "memory")
#define PG8_BAR __builtin_amdgcn_s_barrier()
#define PG8_SCHED __builtin_amdgcn_sched_barrier(0)
#define PG8_SETOFF(vv, uu) do { _Pragma("unroll") for (int _h = 0; _h < 2; ++_h) _Pragma("unroll") for (int _i = 0; _i < 2; ++_i) { \
        if constexpr (Sched::GATHER) (vv)[_h][_i] = S.a_row_off((uu), _h * HALF + Rr[_i], rowbytes) + (unsigned)Cc[_i] * 2u; \
        else (vv)[_h][_i] = (unsigned)((_h * HALF + Rr[_i]) * K + Cc[_i]) * 2u; } } while (0)
    Unit cur, nxt; int ui = 0;
    if (!S.next(0, cur)) return;
    f32x4 acc[2][2][4][2];
#pragma unroll
    for (int a = 0; a < 2; ++a)
#pragma unroll
        for (int b = 0; b < 2; ++b)
#pragma unroll
            for (int m = 0; m < 4; ++m)
#pragma unroll
                for (int n = 0; n < 2; ++n) acc[a][b][m][n] = (f32x4){0.f, 0.f, 0.f, 0.f};
    bf16x8 At[4][2], B0[2][2], B1[2][2];
    unsigned vAc[2][2], vAn[2][2];
    PG8_SETOFF(vAc, cur);
    const char* cA = Sched::GATHER ? (const char*)g.A : (const char*)g.A + (size_t)cur.pm * tstep;
    const char* cB = (const char*)g.Bt + (size_t)cur.pb * tstep;
    PG8_STAGE(PG8_SB(0, 0), cB, voffB); PG8_STAGE(PG8_SB(0, 1), cB + hstep, voffB); PG8_STAGE_A(PG8_SA(0, 0), cA, vAc, 0); PG8_STAGE_A(PG8_SA(0, 1), cA, vAc, 1);
    if (wr == 1) PG8_BAR;
    PG8_WAIT_V(2); PG8_BAR;
    PG8_STAGE(PG8_SB(1, 0), cB + kstep, voffB); PG8_STAGE_A(PG8_SA(1, 0), cA + kstep, vAc, 0); PG8_STAGE(PG8_SB(1, 1), cB + hstep + kstep, voffB);
    PG8_WAIT_V(6); PG8_BAR;
    for (;;) {
        const bool has_next = S.next(ui + 1, nxt);
        const char* nA = cA; const char* nB = cB;
        if (has_next) { nA = Sched::GATHER ? (const char*)g.A : (const char*)g.A + (size_t)nxt.pm * tstep; nB = (const char*)g.Bt + (size_t)nxt.pb * tstep; }
        if constexpr (Sched::GATHER) {
            if (has_next) { PG8_SETOFF(vAn, nxt); }
            else {
#pragma unroll
                for (int h = 0; h < 2; ++h)
#pragma unroll
                    for (int i = 0; i < 2; ++i) vAn[h][i] = vAc[h][i];
            }
        }
#pragma unroll 1
        for (int t = 0; t < nt; t += 2) {
            const bool last = (t == nt - 2);
            const char* a1 = cA + (size_t)(t + 1) * kstep;
            const char* a2 = last ? nA : cA + (size_t)(t + 2) * kstep; const char* b2 = last ? nB : cB + (size_t)(t + 2) * kstep;
            const char* a3 = a2 + kstep; const char* b3 = b2 + kstep;
            unsigned vs[2][2];
#pragma unroll
            for (int h = 0; h < 2; ++h)
#pragma unroll
                for (int i = 0; i < 2; ++i) { if constexpr (Sched::GATHER) vs[h][i] = last ? vAn[h][i] : vAc[h][i]; else vs[h][i] = vAc[h][i]; }
            PG8_LDB(B0, 0, 0); PG8_LDB(B1, 0, 1); PG8_SCHED; PG8_LDA(At, 0, 0); PG8_STAGE_A(PG8_SA(1, 1), a1, vAc, 1);
            PG8_WAIT_V(8); PG8_WAIT_L(0); PG8_BAR; PG8_MMA(0, 0, At, B0); PG8_MMA(0, 1, At, B1); PG8_BAR; PG8_SCHED;
            PG8_LDA(At, 0, 1); PG8_STAGE(PG8_SB(0, 0), b2, voffB); PG8_STAGE(PG8_SB(0, 1), b2 + hstep, voffB); PG8_STAGE_A(PG8_SA(0, 0), a2, vs, 0);
            PG8_WAIT_V(8); PG8_WAIT_L(0); PG8_BAR; PG8_MMA(1, 0, At, B0); PG8_MMA(1, 1, At, B1); PG8_BAR; PG8_SCHED;
            PG8_LDB(B0, 1, 0); PG8_LDB(B1, 1, 1); PG8_SCHED; PG8_LDA(At, 1, 0); PG8_STAGE_A(PG8_SA(0, 1), a2, vs, 1);
            PG8_WAIT_V(8); PG8_WAIT_L(0); PG8_BAR; PG8_MMA(0, 0, At, B0); PG8_MMA(0, 1, At, B1); PG8_BAR; PG8_SCHED;
            PG8_LDA(At, 1, 1); PG8_STAGE(PG8_SB(1, 0), b3, voffB); PG8_STAGE(PG8_SB(1, 1), b3 + hstep, voffB); PG8_STAGE_A(PG8_SA(1, 0), a3, vs, 0);
            PG8_WAIT_V(8); PG8_WAIT_L(0); PG8_BAR; PG8_MMA(1, 0, At, B0); PG8_MMA(1, 1, At, B1); PG8_BAR; PG8_SCHED;
        }
        if (wr == 0) PG8_BAR;
        E(acc, cur, wr, wc, fr, fq);
        if (!has_next) break;
#pragma unroll
        for (int a = 0; a < 2; ++a)
#pragma unroll
            for (int b = 0; b < 2; ++b)
#pragma unroll
                for (int m = 0; m < 4; ++m)
#pragma unroll
                    for (int n = 0; n < 2; ++n) acc[a][b][m][n] = (f32x4){0.f, 0.f, 0.f, 0.f};
        cur = nxt; cA = nA; cB = nB; ++ui;
        if constexpr (Sched::GATHER) {
#pragma unroll
            for (int h = 0; h < 2; ++h)
#pragma unroll
                for (int i = 0; i < 2; ++i) vAc[h][i] = vAn[h][i];
        }
        if (wr == 1) PG8_BAR;
    }
    PG8_WAIT_V(0);
    PG8_BAR;
#undef PG8_SA
#undef PG8_SB
#undef PG8_STAGE
#undef PG8_STAGE_A
#undef PG8_LDA
#undef PG8_LDB
#undef PG8_MMA
#undef PG8_WAIT_V
#undef PG8_WAIT_L
#undef PG8_BAR
#undef PG8_SCHED
#undef PG8_SETOFF
}
}

#define XB_TMO      128
#define XB_XCNT(j)  (256  + 64 * (j))
#define XB_XSUB(j)  (1280 + 64 * (j))
#define XB_XGEN(j)  (2304 + 64 * (j))
#define XB_TOP      3328
#define XB_TOPGEN   3392
#define XCD_BAR_WORDS 3456
#define XB_SPIN_CAP (1u << 18)
__device__ __forceinline__ unsigned xb_ld(unsigned* p)              { return __hip_atomic_load(p, __ATOMIC_RELAXED, __HIP_MEMORY_SCOPE_AGENT); }
__device__ __forceinline__ unsigned xb_add(unsigned* p, unsigned v) { return __hip_atomic_fetch_add(p, v, __ATOMIC_RELAXED, __HIP_MEMORY_SCOPE_AGENT); }
__device__ __forceinline__ unsigned xb_xcc_id() { return (unsigned)__builtin_amdgcn_s_getreg((3 << 11) | 20) & 0xFu; }
#define XB_SPIN(cond, bar) do { unsigned _sp = 0; while (cond) { __builtin_amdgcn_s_sleep(1); \
    if ((++_sp & 255u) == 0u) { if (xb_ld(&(bar)[XB_TMO])) break; if (_sp > XB_SPIN_CAP) { atomicAdd(&(bar)[XB_TMO], 1u); break; } } } } while (0)
struct XcdBarrier { unsigned* bar; unsigned x; volatile LAS unsigned* st; };
__device__ __forceinline__ XcdBarrier xcd_barrier_post(unsigned* bar, volatile LAS unsigned* st) {
    XcdBarrier b; b.bar = bar; b.x = xb_xcc_id(); b.st = st;
    if (threadIdx.x == 0) (void)xb_add(&bar[XB_XCNT(b.x)], 1u);
    return b;
}
__device__ __forceinline__ void xcd_barrier_complete(unsigned* bar, unsigned x, unsigned& nloc, unsigned& nx) {
    const unsigned G = gridDim.x * gridDim.y * gridDim.z;
    unsigned sum, cnt, mine, sp = 0u;
    for (;;) {
        sum = 0u; cnt = 0u; mine = 0u;
#pragma unroll
        for (unsigned j = 0; j < 16; ++j) { const unsigned c = xb_ld(&bar[XB_XCNT(j)]); sum += c; cnt += (c > 0u) ? 1u : 0u; mine = (j == x) ? c : mine; }
        if (sum == G) break;
        __builtin_amdgcn_s_sleep(1);
        if ((++sp & 255u) == 0u) { if (xb_ld(&bar[XB_TMO])) break; if (sp > XB_SPIN_CAP) { atomicAdd(&bar[XB_TMO], 1u); break; } }
    }
    nloc = mine > 0u ? mine : 1u; nx = cnt > 0u ? cnt : 1u;
}
__device__ __forceinline__ void xcd_barrier(const XcdBarrier& b) {
    asm volatile("s_waitcnt vmcnt(0)" ::: "memory");
    __syncthreads();
    if (threadIdx.x == 0) {
        unsigned* bar = b.bar;
        __builtin_amdgcn_s_waitcnt(0);
        unsigned nloc = b.st[0], nx = b.st[1];
        if (nloc == 0u) { xcd_barrier_complete(bar, b.x, nloc, nx); b.st[0] = nloc; b.st[1] = nx; }
        const unsigned old = xb_add(&bar[XB_XSUB(b.x)], 1u);
        const unsigned gen = old / nloc;
        if (old + 1u == (gen + 1u) * nloc) {
            __builtin_amdgcn_fence(__ATOMIC_RELEASE, "agent");
            asm volatile("s_waitcnt vmcnt(0)" ::: "memory");
            const unsigned og = xb_add(&bar[XB_TOP], 1u);
            const unsigned tg = og / nx;
            if (og + 1u == (tg + 1u) * nx) xb_add(&bar[XB_TOPGEN], 1u);
            else XB_SPIN(xb_ld(&bar[XB_TOPGEN]) == tg, bar);
            __builtin_amdgcn_fence(__ATOMIC_ACQUIRE, "agent");
            xb_add(&bar[XB_XGEN(b.x)], 1u);
            asm volatile("s_waitcnt vmcnt(0)" ::: "memory");
        } else {
            XB_SPIN(xb_ld(&bar[XB_XGEN(b.x)]) == gen, bar);
            __builtin_amdgcn_fence(__ATOMIC_ACQUIRE, "agent");
            asm volatile("s_waitcnt vmcnt(0)" ::: "memory");
        }
    }
    __syncthreads();
}

constexpr int NWAVES = 8;
constexpr int SEQ = 2048, NB = 16, DM = 1024, NTOK = NB * SEQ;
constexpr int DRW = 512, HD = 64;
constexpr int NPROJ = 3072, NEXT = 3584, NL1 = 512, KL2 = 256, NL2 = 1536;
constexpr int NEXP = 32, DEXP = 512;
constexpr int PROWS_MAX = 65536 + 32 * 256, MAXTILES = PROWS_MAX / 256;
constexpr float LN_EPS = 1e-5f, LNX_EPS = 64e-5f, ALPHA = 1.189207115002721f;

constexpr size_t MiB = 1u << 20;
constexpr size_t WS_CTL = 0, CTL_ZERO_BYTES = 1 * MiB;
constexpr size_t WS_WINT = 1 * MiB;
constexpr size_t WS_W2T = 8 * MiB;
constexpr size_t WS_WOT = 9 * MiB;
constexpr size_t WS_GT = 11 * MiB;
constexpr size_t WS_PT = 13 * MiB;
constexpr size_t WS_BIAS = 13 * MiB + 512 * 1024;
constexpr size_t WS_TOKE = 14 * MiB;
constexpr size_t WS_TOKW = 14 * MiB + 256 * 1024;
constexpr size_t WS_ROWTOK = 14 * MiB + 512 * 1024;
constexpr size_t WS_ROWASG = 15 * MiB;
constexpr size_t WS_ROWW = 15 * MiB + 512 * 1024;
constexpr size_t WS_PB = 16 * MiB;
constexpr size_t WS_X1 = 33 * MiB;
constexpr size_t WS_XB = WS_X1, WS_LORA1 = WS_X1 + 64 * MiB;
constexpr size_t WS_LW = WS_X1, WS_AG = WS_X1 + 64 * MiB;
constexpr size_t WS_P = 161 * MiB;
constexpr size_t WS_WGUT = WS_P, WS_WDT = WS_P + 64 * MiB, WS_HDN = WS_P + 96 * MiB, WS_MOEHI = WS_P;
constexpr size_t WS_Y = 353 * MiB;
constexpr size_t WS_END = 417 * MiB;
constexpr int BIAS_LD = 132;
constexpr int CW_BAR = 4096;
constexpr int CW_CNT = 8192, CW_FILL = 8192 + 64, CW_NTILES = 8192 + 128, CW_TILEE = 8192 + 256;

constexpr int RING_OFF = 0, RING_BYTES = 131072;
constexpr int WRT_BYTES = 36 * 1024 * 4;
constexpr int LDSCTL_OFF = WRT_BYTES, MISC_OFF = LDSCTL_OFF;
constexpr int LDS_BYTES = LDSCTL_OFF + 1024;
constexpr int MW_HIST = 0, MW_CNT = 32, MW_RS = 64, MW_LBASE = 96, MW_LFILL = 128, MW_BAR = 160;

struct Frame {
    LAS unsigned char* lds;
    volatile LAS unsigned* MISC;
    unsigned* ctl;
    int tid, lane, wave, vcu, G;
    unsigned char* ws;
    const float* const* in;
    float* out;
};
enum InIdx { I_X = 0, I_P, I_WIN, I_MURKV, I_MULORA, I_W0, I_WL1, I_WL2, I_A0, I_AL1, I_AL2, I_GL1, I_GL2, I_KK, I_KA, I_RK, I_LNXG, I_LNXB, I_RELB, I_WO,
             I_LN1G, I_LN1B, I_RG, I_RGB, I_RE, I_REB, I_WG, I_WU, I_WD, I_PG, I_PP, I_LN2G, I_LN2B };

__device__ __forceinline__ void tr_item(const float* W, int ldw, int k0, int n0, bf16_t* dst, int ldt, const float* mu, int smode, LAS float* scr, int lane) {
#pragma unroll 8
    for (int i = 0; i < 32; ++i) { const int kk = 2 * i + (lane >> 5); float v = W[(size_t)(k0 + kk) * ldw + n0 + (lane & 31)];
        if (smode == 1) v *= (1.0f - mu[k0 + kk]); else if (smode == 2) v *= mu[k0 + kk];
        scr[kk * 33 + (lane & 31)] = v; }
    LDS_WAIT(); asm volatile("" ::: "memory");
    const int c = lane & 7;
#pragma unroll
    for (int j = 0; j < 4; ++j) { const int n = (lane >> 3) + 8 * j; const LAS float* s = scr + (8 * c) * 33 + n;
        u32x4 o; o.x = pk2(s[0 * 33], s[1 * 33]); o.y = pk2(s[2 * 33], s[3 * 33]); o.z = pk2(s[4 * 33], s[5 * 33]); o.w = pk2(s[6 * 33], s[7 * 33]);
        *(u32x4*)(dst + (size_t)n * ldt + k0 + 8 * c) = o; }
    LDS_WAIT(); asm volatile("" ::: "memory");
}
__device__ __forceinline__ int t5_bucket(int n) {
    if (n < 16) return n;
    int b = 16;
    b += (n >= 22); b += (n >= 30); b += (n >= 40); b += (n >= 54); b += (n >= 73); b += (n >= 99); b += (n >= 134); b += (n >= 182);
    b += (n >= 246); b += (n >= 332); b += (n >= 450); b += (n >= 609); b += (n >= 825); b += (n >= 1117); b += (n >= 1513);
    return b;
}

__device__ __forceinline__ void ph_prologue(Frame& F) {
    const int gt = F.vcu * 512 + F.tid, NGT = F.G * 512;
    const int gw = F.vcu * NWAVES + F.wave, NGW = F.G * NWAVES;
    { const f32x4* x4 = (const f32x4*)F.in[I_X]; u32x4* o = (u32x4*)(F.ws + WS_XB);
      for (int i = gt; i < NTOK * DM / 8; i += NGT) { const f32x4 a = x4[2 * i], b = x4[2 * i + 1]; u32x4 w; w.x = pk2(a.x, a.y); w.y = pk2(a.z, a.w); w.z = pk2(b.x, b.y); w.w = pk2(b.z, b.w); o[i] = w; } }
    { const f32x4* x4 = (const f32x4*)F.in[I_P]; u32x4* o = (u32x4*)(F.ws + WS_PB);
      for (int i = gt; i < NTOK * 256 / 8; i += NGT) { const f32x4 a = x4[2 * i], b = x4[2 * i + 1]; u32x4 w; w.x = pk2(a.x, a.y); w.y = pk2(a.z, a.w); w.z = pk2(b.x, b.y); w.w = pk2(b.z, b.w); o[i] = w; } }
    { bf16_t* w2t = (bf16_t*)(F.ws + WS_W2T);
      for (int i = gt; i < NL2 * KL2; i += NGT) { const int n = i / KL2, k = i % KL2; float v = 0.f;
          if (n < 512) { if (k < 64) v = F.in[I_WL2][k * 512 + n]; }
          else if (n < 1024) { if (k >= 64 && k < 128) v = F.in[I_AL2][(k - 64) * 512 + (n - 512)]; }
          else { if (k >= 128) v = F.in[I_GL2][(k - 128) * 512 + (n - 1024)]; }
          w2t[i] = (bf16_t)f2bf(v); } }
    { float* bt = (float*)(F.ws + WS_BIAS);
      for (int i = gt; i < 3 * 8 * BIAS_LD; i += NGT) { const int p = i / (8 * BIAS_LD), h = (i / BIAS_LD) % 8, m = i % BIAS_LD; const int dil = 1 << (2 * p);
          bt[i] = (m <= 128) ? F.in[I_RELB][t5_bucket(m * dil) * 8 + h] : 0.f; } }
    LAS float* scr = (LAS float*)(F.lds + RING_OFF + F.wave * 16384);
    constexpr int IT_WIN = 16 * 96, IT_L1 = 256, IT_WO = 512, IT_G = 512, IT_PP = 128;
    constexpr int NIT = IT_WIN + IT_L1 + IT_WO + IT_G + IT_PP;
    bf16_t* WinT = (bf16_t*)(F.ws + WS_WINT);
    for (int it = gw; it < NIT; it += NGW) {
        int r = it;
        if (r < IT_WIN) { const int kb = r / 96, nb = r % 96; tr_item(F.in[I_WIN], NPROJ, kb * 64, nb * 32, WinT + (size_t)(nb * 32) * DM, DM, nullptr, 0, scr, F.lane); continue; } r -= IT_WIN;
        if (r < IT_L1) {
            int piece, sub;
            if (r < 128) { piece = r / 32; sub = r % 32; } else { piece = 4 + (r - 128) / 64; sub = (r - 128) % 64; }
            const int which = piece >> 1, isprev = piece & 1;
            const int ncols = (which == 2) ? 128 : 64, nblk = ncols / 32;
            const int kb = sub / nblk, nb = sub % nblk;
            const float* src = (which == 0) ? F.in[I_WL1] : (which == 1) ? F.in[I_AL1] : F.in[I_GL1];
            const int rowbase = (which == 0) ? 3072 + 64 * isprev : (which == 1) ? 3200 + 64 * isprev : 3328 + 128 * isprev;
            tr_item(src, ncols, kb * 64, nb * 32, WinT + (size_t)(rowbase + nb * 32) * DM, DM, F.in[I_MULORA] + which * DM, isprev ? 2 : 1, scr, F.lane); continue; } r -= IT_L1;
        if (r < IT_WO) { const int kb = r / 32, nb = r % 32; tr_item(F.in[I_WO], DM, kb * 64, nb * 32, (bf16_t*)(F.ws + WS_WOT) + (size_t)(nb * 32) * DM, DM, nullptr, 0, scr, F.lane); continue; } r -= IT_WO;
        if (r < IT_G) { const int kb = r / 32, nb = r % 32; tr_item(F.in[I_PG], DM, kb * 64, nb * 32, (bf16_t*)(F.ws + WS_GT) + (size_t)(nb * 32) * DM, DM, nullptr, 0, scr, F.lane); continue; } r -= IT_G;
        { const int kb = r / 32, nb = r % 32; tr_item(F.in[I_PP], DM, kb * 64, nb * 32, (bf16_t*)(F.ws + WS_PT) + (size_t)(nb * 32) * 256, 256, nullptr, 0, scr, F.lane); }
    }
}
__device__ __forceinline__ void ph_moe_weights(Frame& F) {
    const int gw = F.vcu * NWAVES + F.wave, NGW = F.G * NWAVES;
    LAS float* scr = (LAS float*)(F.lds + RING_OFF + F.wave * 16384);
    constexpr int IT_GU = 64 * 256, IT_D = 32 * 256;
    for (int it = gw; it < IT_GU + IT_D; it += NGW) {
        if (it < IT_GU) { const int mat = it / 256, sub = it % 256, e = mat >> 1, up = mat & 1, kb = sub / 16, nb = sub % 16, n0 = nb * 32;
            const float* src = (up ? F.in[I_WU] : F.in[I_WG]) + (size_t)e * DM * DEXP;
            bf16_t* dst = (bf16_t*)(F.ws + WS_WGUT) + ((size_t)e * 1024 + (n0 >> 7) * 256 + up * 128 + (n0 & 127)) * DM;
            tr_item(src, DEXP, kb * 64, n0, dst, DM, nullptr, 0, scr, F.lane); }
        else { const int r = it - IT_GU, e = r / 256, sub = r % 256, kb = sub / 32, nb = sub % 32;
            const float* src = F.in[I_WD] + (size_t)e * DEXP * DM;
            bf16_t* dst = (bf16_t*)(F.ws + WS_WDT) + ((size_t)e * 1024 + nb * 32) * DEXP;
            tr_item(src, DM, kb * 64, nb * 32, dst, DEXP, nullptr, 0, scr, F.lane); }
    }
}

using pg8::Unit; using pg8::cvt_pk_bf16;
struct EpiProj {
    static constexpr bool PERM = true;
    bf16_t* proj; float* lora1;
    __device__ __forceinline__ void operator()(const f32x4 (&acc)[2][2][4][2], const Unit& u, int wr, int wc, int fr, int fq) const {
        const int row0 = u.pm * 256 + wr * 64 + fr;
        if (u.pn < 12) {
            const int col0 = u.pn * 256 + wc * 32 + 8 * fq;
#pragma unroll
            for (int ai = 0; ai < 2; ++ai)
#pragma unroll
                for (int m = 0; m < 4; ++m) { bf16_t* rowp = proj + (size_t)(row0 + ai * 128 + m * 16) * NPROJ + col0;
#pragma unroll
                    for (int bj = 0; bj < 2; ++bj) { const f32x4 v0 = acc[ai][bj][m][0], v1 = acc[ai][bj][m][1]; u32x4 w;
                        w.x = cvt_pk_bf16(v0[0], v0[1]); w.y = cvt_pk_bf16(v0[2], v0[3]); w.z = cvt_pk_bf16(v1[0], v1[1]); w.w = cvt_pk_bf16(v1[2], v1[3]);
                        *(u32x4*)(rowp + bj * 128) = w; } }
        } else {
            const int col0 = (u.pn - 12) * 256 + wc * 32 + 8 * fq;
#pragma unroll
            for (int ai = 0; ai < 2; ++ai)
#pragma unroll
                for (int m = 0; m < 4; ++m) { float* rowp = lora1 + (size_t)(row0 + ai * 128 + m * 16) * NL1 + col0;
#pragma unroll
                    for (int bj = 0; bj < 2; ++bj) { *(f32x4*)(rowp + bj * 128) = acc[ai][bj][m][0]; *(f32x4*)(rowp + bj * 128 + 4) = acc[ai][bj][m][1]; } }
        }
    }
};
struct EpiDag {
    static constexpr bool PERM = true;
    float* lw; bf16_t* ag; const float* w0; const float* a0;
    __device__ __forceinline__ void operator()(const f32x4 (&acc)[2][2][4][2], const Unit& u, int wr, int wc, int fr, int fq) const {
        const int row0 = u.pm * 256 + wr * 64 + fr;
        const int colt = u.pn * 256 + wc * 32 + 8 * fq;
        if (u.pn < 2) {
#pragma unroll
            for (int bj = 0; bj < 2; ++bj) {
                const f32x4 b0 = *(const f32x4*)(w0 + colt + bj * 128), b1 = *(const f32x4*)(w0 + colt + bj * 128 + 4);
#pragma unroll
                for (int ai = 0; ai < 2; ++ai)
#pragma unroll
                    for (int m = 0; m < 4; ++m) { float* rowp = lw + (size_t)(row0 + ai * 128 + m * 16) * 512 + colt + bj * 128;
                        const f32x4 z0 = acc[ai][bj][m][0] + b0, z1 = acc[ai][bj][m][1] + b1; f32x4 o0, o1;
#pragma unroll
                        for (int j = 0; j < 4; ++j) { o0[j] = -0.6065306597126334f * sigmoidf_(z0[j]); o1[j] = -0.6065306597126334f * sigmoidf_(z1[j]); }
                        *(f32x4*)(rowp) = o0; *(f32x4*)(rowp + 4) = o1; }
                asm volatile("" ::: "memory");
            }
        } else {
            const bool isa = (u.pn < 4);
#pragma unroll
            for (int bj = 0; bj < 2; ++bj) {
                f32x4 b0 = (f32x4){0.f, 0.f, 0.f, 0.f}, b1 = (f32x4){0.f, 0.f, 0.f, 0.f};
                if (isa) { b0 = *(const f32x4*)(a0 + (colt - 512) + bj * 128); b1 = *(const f32x4*)(a0 + (colt - 512) + bj * 128 + 4); }
#pragma unroll
                for (int ai = 0; ai < 2; ++ai)
#pragma unroll
                    for (int m = 0; m < 4; ++m) { bf16_t* rowp = ag + (size_t)(row0 + ai * 128 + m * 16) * 1024 + (colt - 512) + bj * 128;
                        f32x4 v0 = acc[ai][bj][m][0] + b0, v1 = acc[ai][bj][m][1] + b1;
                        if (isa) {
#pragma unroll
                            for (int j = 0; j < 4; ++j) { v0[j] = sigmoidf_(v0[j]); v1[j] = sigmoidf_(v1[j]); } }
                        u32x4 w; w.x = cvt_pk_bf16(v0[0], v0[1]); w.y = cvt_pk_bf16(v0[2], v0[3]); w.z = cvt_pk_bf16(v1[0], v1[1]); w.w = cvt_pk_bf16(v1[2], v1[3]);
                        *(u32x4*)(rowp) = w; }
                asm volatile("" ::: "memory");
            }
        }
    }
};
struct EpiWo {
    static constexpr bool PERM = false;
    const float* x; float* pre1;
    __device__ __forceinline__ void operator()(const f32x4 (&acc)[2][2][4][2], const Unit& u, int wr, int wc, int fr, int fq) const {
        const int row0 = u.pm * 256 + wr * 64 + fr, col0 = u.pn * 256 + wc * 32 + 4 * fq;
#pragma unroll
        for (int ai = 0; ai < 2; ++ai)
#pragma unroll
            for (int m = 0; m < 4; ++m) { const size_t off = (size_t)(row0 + ai * 128 + m * 16) * DM + col0;
#pragma unroll
                for (int bj = 0; bj < 2; ++bj)
#pragma unroll
                    for (int n = 0; n < 2; ++n) { const f32x4 xv = *(const f32x4*)(x + off + bj * 128 + n * 16); *(f32x4*)(pre1 + off + bj * 128 + n * 16) = xv * ALPHA + acc[ai][bj][m][n]; }
                asm volatile("" ::: "memory"); }
    }
};
struct EpiF32 {
    static constexpr bool PERM = false;
    float* C; int ldc;
    __device__ __forceinline__ void operator()(const f32x4 (&acc)[2][2][4][2], const Unit& u, int wr, int wc, int fr, int fq) const {
        const int row0 = u.pm * 256 + wr * 64 + fr, col0 = u.pn * 256 + wc * 32 + 4 * fq;
#pragma unroll
        for (int ai = 0; ai < 2; ++ai)
#pragma unroll
            for (int m = 0; m < 4; ++m) { float* rowp = C + (size_t)(row0 + ai * 128 + m * 16) * ldc + col0;
#pragma unroll
                for (int bj = 0; bj < 2; ++bj)
#pragma unroll
                    for (int n = 0; n < 2; ++n) *(f32x4*)(rowp + bj * 128 + n * 16) = acc[ai][bj][m][n]; }
    }
};
struct EpiPle {
    static constexpr bool PERM = false;
    float* C; int ldc;
    __device__ __forceinline__ void operator()(const f32x4 (&acc)[2][2][4][2], const Unit& u, int wr, int wc, int fr, int fq) const {
        const int row0 = u.pm * 256 + wr * 64 + fr, col0 = u.pn * 256 + wc * 32 + 4 * fq;
#pragma unroll
        for (int ai = 0; ai < 2; ++ai)
#pragma unroll
            for (int m = 0; m < 4; ++m) { float* rowp = C + (size_t)(row0 + ai * 128 + m * 16) * ldc + col0;
#pragma unroll
                for (int bj = 0; bj < 2; ++bj)
#pragma unroll
                    for (int n = 0; n < 2; ++n) { const f32x4 pv = *(const f32x4*)(rowp + bj * 128 + n * 16); const f32x4 a = acc[ai][bj][m][n]; f32x4 o;
#pragma unroll
                        for (int j = 0; j < 4; ++j) o[j] = sigmoidf_(a[j]) * pv[j];
                        *(f32x4*)(rowp + bj * 128 + n * 16) = o; }
                asm volatile("" ::: "memory"); }
    }
};
struct EpiGU {
    static constexpr bool PERM = true;
    bf16_t* hdn;
    __device__ __forceinline__ void operator()(const f32x4 (&acc)[2][2][4][2], const Unit& u, int wr, int wc, int fr, int fq) const {
        const int row0 = u.pm * 256 + wr * 64 + fr, col0 = u.pn * 128 + wc * 32 + 8 * fq;
#pragma unroll
        for (int ai = 0; ai < 2; ++ai)
#pragma unroll
            for (int m = 0; m < 4; ++m) { bf16_t* rowp = hdn + (size_t)(row0 + ai * 128 + m * 16) * DEXP + col0; float h[8];
#pragma unroll
                for (int n = 0; n < 2; ++n)
#pragma unroll
                    for (int j = 0; j < 4; ++j) { const float gt = acc[ai][0][m][n][j], up = acc[ai][1][m][n][j]; h[4 * n + j] = gt * sigmoidf_(gt) * up; }
                u32x4 w; w.x = cvt_pk_bf16(h[0], h[1]); w.y = cvt_pk_bf16(h[2], h[3]); w.z = cvt_pk_bf16(h[4], h[5]); w.w = cvt_pk_bf16(h[6], h[7]);
                *(u32x4*)rowp = w; }
    }
};
struct EpiDown {
    static constexpr bool PERM = true;
    bf16_t* lo; bf16_t* hi; const int* row_asg; const float* row_w;
    __device__ __forceinline__ void operator()(const f32x4 (&acc)[2][2][4][2], const Unit& u, int wr, int wc, int fr, int fq) const {
        const int row0 = u.pm * 256 + wr * 64 + fr, col0 = u.pn * 256 + wc * 32 + 8 * fq;
#pragma unroll
        for (int ai = 0; ai < 2; ++ai)
#pragma unroll
            for (int m = 0; m < 4; ++m) { const int prow = row0 + ai * 128 + m * 16; const int asg = row_asg[prow]; const float w = row_w[prow];
                if (asg >= 0) { bf16_t* rowp = (asg < 32768 ? lo + (size_t)asg * DM : hi + (size_t)(asg - 32768) * DM) + col0;
#pragma unroll
                    for (int bj = 0; bj < 2; ++bj) { const f32x4 v0 = acc[ai][bj][m][0] * w, v1 = acc[ai][bj][m][1] * w; u32x4 o;
                        o.x = cvt_pk_bf16(v0[0], v0[1]); o.y = cvt_pk_bf16(v0[2], v0[3]); o.z = cvt_pk_bf16(v1[0], v1[1]); o.w = cvt_pk_bf16(v1[2], v1[3]);
                        *(u32x4*)(rowp + bj * 128) = o; } } }
    }
};

__device__ __forceinline__ void ph_lora_act(Frame& F) {
    const int gt = F.vcu * 512 + F.tid, NGT = F.G * 512;
    const float* l1 = (const float*)(F.ws + WS_LORA1); bf16_t* act = (bf16_t*)(F.ws + WS_Y);
    for (int i = gt; i < NTOK * 64; i += NGT) {
        const int t = i >> 6, c4 = (i & 63) * 4; const bool first = (t % SEQ) == 0;
        int ca, cb, mode;
        if (c4 < 64) { ca = c4; cb = 64 + c4; mode = 0; } else if (c4 < 128) { ca = 128 + (c4 - 64); cb = 192 + (c4 - 64); mode = 1; } else { ca = 256 + (c4 - 128); cb = 384 + (c4 - 128); mode = 2; }
        f32x4 a = *(const f32x4*)(l1 + (size_t)t * NL1 + ca);
        if (!first) a += *(const f32x4*)(l1 + (size_t)(t - 1) * NL1 + cb);
        float o[4];
#pragma unroll
        for (int j = 0; j < 4; ++j) o[j] = (mode == 0) ? tanhf(a[j]) : (mode == 1) ? a[j] : sigmoidf_(a[j]);
        u32x2 w; w.x = pk2(o[0], o[1]); w.y = pk2(o[2], o[3]);
        *(u32x2*)(act + (size_t)t * KL2 + c4) = w;
    }
}

__device__ __forceinline__ void ph_scan_simple(Frame& F) {
    if (F.vcu >= 128 || F.wave != 0) return;
    const int bh = F.vcu, b = bh >> 3, h = bh & 7, lane = F.lane, c = h * 64 + lane;
    LAS float* vec = (LAS float*)(F.lds + RING_OFF);
    const bf16_t* proj = (const bf16_t*)(F.ws + WS_P); const float* lwb = (const float*)(F.ws + WS_LW); const bf16_t* ag = (const bf16_t*)(F.ws + WS_AG);
    bf16_t* ycat = (bf16_t*)(F.ws + WS_Y);
    const float mu_r = F.in[I_MURKV][c], mu_k = F.in[I_MURKV][512 + c], mu_v = F.in[I_MURKV][1024 + c];
    const float k_k = F.in[I_KK][c], k_a = F.in[I_KA][c], r_k = F.in[I_RK][c], lg = F.in[I_LNXG][c], lb = F.in[I_LNXB][c];
    float S[64];
#pragma unroll
    for (int k = 0; k < 64; ++k) S[k] = 0.f;
    float rp = 0.f, kp = 0.f, vp = 0.f;
    for (int s = 0; s < SEQ; ++s) {
        const size_t t = (size_t)b * SEQ + s;
        const float r_in = bf2f(proj[t * NPROJ + c]), k_in = bf2f(proj[t * NPROJ + 512 + c]), v_in = bf2f(proj[t * NPROJ + 1024 + c]);
        const float r = r_in + (rp - r_in) * mu_r, k = k_in + (kp - k_in) * mu_k, v = v_in + (vp - v_in) * mu_v;
        rp = r_in; kp = k_in; vp = v_in;
        const float w = __expf(lwb[t * 512 + c]);
        const float a = bf2f(ag[t * 1024 + c]), g = bf2f(ag[t * 1024 + 512 + c]);
        float kk = k * k_k; const float ss = wave_sum(kk * kk); kk *= rsqrtf(fmaxf(ss, 1e-24f));
        const float kq = k * (1.0f + (a - 1.0f) * k_a);
        const float bonus = wave_sum(r * kq * r_k);
        vec[lane] = -kk; vec[64 + lane] = w; vec[128 + lane] = kk * a; vec[192 + lane] = kq; vec[256 + lane] = r;
        LDS_WAIT();
        float sa = 0.f;
#pragma unroll
        for (int q = 0; q < 16; ++q) { const f32x4 a4 = *(const LAS f32x4*)(vec + 4 * q); sa += S[4 * q] * a4[0]; sa += S[4 * q + 1] * a4[1]; sa += S[4 * q + 2] * a4[2]; sa += S[4 * q + 3] * a4[3]; if ((q & 3) == 3) __builtin_amdgcn_sched_barrier(0); }
        float y = 0.f;
#pragma unroll
        for (int q = 0; q < 16; ++q) { const f32x4 w4 = *(const LAS f32x4*)(vec + 64 + 4 * q), b4 = *(const LAS f32x4*)(vec + 128 + 4 * q), k4 = *(const LAS f32x4*)(vec + 192 + 4 * q), r4 = *(const LAS f32x4*)(vec + 256 + 4 * q);
#pragma unroll
            for (int j = 0; j < 4; ++j) { const float sn = S[4 * q + j] * w4[j] + sa * b4[j] + v * k4[j]; S[4 * q + j] = sn; y += sn * r4[j]; }
            __builtin_amdgcn_sched_barrier(0); }
        LDS_WAIT();
        const float mean = wave_sum(y) * (1.0f / 64.0f); const float d = y - mean; const float var = wave_sum(d * d) * (1.0f / 64.0f);
        const float yn = d * rsqrtf(var + LNX_EPS) * lg + lb;
        ycat[t * DM + c] = (bf16_t)f2bf((yn + bonus * v) * g);
    }
}

constexpr int SC_SL = 18432;
constexpr int SC_AP = 0, SC_RP = 2048, SC_BKT = 4096, SC_VT = 8192, SC_BR = 10240, SC_KR = 12288, SC_Y = 10240, SC_LF = 10240, SC_LKA = 14336, SC_TA = 15360, SC_LRA = 16384, SC_GC = 17408, SC_BON = 17664;
static_assert(8 * SC_SL <= LDSCTL_OFF, "scan slots fit below the LDS control words");
__device__ __forceinline__ int sigma64(int i) { return (i & ~31) | (((i >> 2) & 3) << 3) | (((i >> 4) & 1) << 2) | (i & 3); }
__device__ __forceinline__ bf16x8 mk8(unsigned a, unsigned b, unsigned c, unsigned d) { u32x4 v; v.x = a; v.y = b; v.z = c; v.w = d; return __builtin_bit_cast(bf16x8, v); }
#define MFMA16(A, B, C) __builtin_amdgcn_mfma_f32_16x16x32_bf16((A), (B), (C), 0, 0, 0)

__device__ __forceinline__ void ph_scan_chunk(Frame& F) {
    if (F.vcu >= 128) return;
    const int bh = F.vcu, b = bh >> 3, h = bh & 7, lane = F.lane, wave = F.wave;
    const int g = lane >> 4, cc = lane & 15;
    const bf16_t* proj = (const bf16_t*)(F.ws + WS_P); const float* lwb = (const float*)(F.ws + WS_LW); const bf16_t* ag = (const bf16_t*)(F.ws + WS_AG);
    bf16_t* ycat = (bf16_t*)(F.ws + WS_Y);
    LAS unsigned char* myslot = F.lds + wave * SC_SL;
    const int ch = h * 64 + lane, si = sigma64(lane);
    const float mu_r = F.in[I_MURKV][ch], mu_k = F.in[I_MURKV][512 + ch], mu_v = F.in[I_MURKV][1024 + ch];
    const float k_k = F.in[I_KK][ch], k_a = F.in[I_KA][ch], r_k = F.in[I_RK][ch];
    const int es = lane >> 2, jq = lane & 3;
    float lnxg[16], lnxb[16];
#pragma unroll
    for (int j = 0; j < 16; ++j) { lnxg[j] = F.in[I_LNXG][h * 64 + 16 * jq + j]; lnxb[j] = F.in[I_LNXB][h * 64 + 16 * jq + j]; }
    f32x4 St[4];
#pragma unroll
    for (int m = 0; m < 4; ++m) St[m] = (f32x4){0.f, 0.f, 0.f, 0.f};
    bf16x8 Sb0 = mk8(0u, 0u, 0u, 0u), Sb1 = mk8(0u, 0u, 0u, 0u);
    const int jb = 16 * (wave & 3);

    for (int r = 0; r < SEQ / 128; ++r) {
        {
            const int cidx = 8 * r + wave; const size_t t0 = (size_t)b * SEQ + 16 * cidx;
            float rp = 0.f, kp = 0.f, vp = 0.f;
            if (cidx > 0) { rp = bf2f(proj[(t0 - 1) * NPROJ + ch]); kp = bf2f(proj[(t0 - 1) * NPROJ + 512 + ch]); vp = bf2f(proj[(t0 - 1) * NPROJ + 1024 + ch]); }
            float cl = 0.f, eprev = 1.f, ecur = 1.f;
            unsigned vpk[8];
#pragma unroll
            for (int sg = 0; sg < 4; ++sg) {
                float bt4[4], kt4[4], v4[4];
#pragma unroll
                for (int e4 = 0; e4 < 4; ++e4) {
                    const int s = 4 * sg + e4; const size_t t = t0 + s;
                    const float r_in = bf2f(proj[t * NPROJ + ch]), k_in = bf2f(proj[t * NPROJ + 512 + ch]), v_in = bf2f(proj[t * NPROJ + 1024 + ch]);
                    const float rr = r_in + (rp - r_in) * mu_r, kx = k_in + (kp - k_in) * mu_k, vv = v_in + (vp - v_in) * mu_v;
                    rp = r_in; kp = k_in; vp = v_in;
                    const float lw = lwb[t * 512 + ch]; const float a = bf2f(ag[t * 1024 + ch]);
                    float kk = kx * k_k; const float ss = wave_sum(kk * kk); kk *= rsqrtf(fmaxf(ss, 1e-24f));
                    const float kq = kx * (1.0f + (a - 1.0f) * k_a);
                    const float bonus = wave_sum(rr * kq * r_k);
                    cl += lw; ecur = __expf(cl); const float einv = __expf(-cl);
                    const float Ah = -kk * eprev, Rh = rr * ecur, Bv = kk * a * einv, Kv = kq * einv;
                    eprev = ecur;
                    *(LAS bf16_t*)(myslot + SC_AP + s * 128 + si * 2) = (bf16_t)f2bf(Ah);
                    *(LAS bf16_t*)(myslot + SC_RP + s * 128 + si * 2) = (bf16_t)f2bf(Rh);
                    *(LAS bf16_t*)(myslot + SC_BR + s * 128 + si * 2) = (bf16_t)f2bf(Bv);
                    *(LAS bf16_t*)(myslot + SC_KR + s * 128 + si * 2) = (bf16_t)f2bf(Kv);
                    bt4[e4] = Bv; kt4[e4] = Kv; v4[e4] = vv;
                    if (lane == 0) *(LAS float*)(myslot + SC_BON + s * 4) = bonus;
                }
                u32x4 w; w.x = pk2(bt4[0], bt4[1]); w.y = pk2(bt4[2], bt4[3]); w.z = pk2(kt4[0], kt4[1]); w.w = pk2(kt4[2], kt4[3]);
                *(LAS u32x4*)(myslot + SC_BKT + lane * 64 + sg * 16) = w;
                vpk[2 * sg] = pk2(v4[0], v4[1]); vpk[2 * sg + 1] = pk2(v4[2], v4[3]);
            }
            { u32x4 w0, w1; w0.x = vpk[0]; w0.y = vpk[1]; w0.z = vpk[2]; w0.w = vpk[3]; w1.x = vpk[4]; w1.y = vpk[5]; w1.z = vpk[6]; w1.w = vpk[7];
              *(LAS u32x4*)(myslot + SC_VT + lane * 32) = w0; *(LAS u32x4*)(myslot + SC_VT + lane * 32 + 16) = w1; }
            *(LAS float*)(myslot + SC_GC + lane * 4) = ecur;
            LDS_WAIT();
            f32x4 d1 = (f32x4){0.f, 0.f, 0.f, 0.f}, d2 = d1, d3 = d1, d4 = d1;
#pragma unroll
            for (int ks = 0; ks < 2; ++ks) {
                const int off = cc * 128 + (32 * ks + 8 * g) * 2;
                const bf16x8 fa = *(const LAS bf16x8*)(myslot + SC_AP + off), fr = *(const LAS bf16x8*)(myslot + SC_RP + off);
                const bf16x8 fb = *(const LAS bf16x8*)(myslot + SC_BR + off), fk = *(const LAS bf16x8*)(myslot + SC_KR + off);
                d1 = MFMA16(fa, fb, d1); d2 = MFMA16(fa, fk, d2); d3 = MFMA16(fr, fb, d3); d4 = MFMA16(fr, fk, d4);
            }
            asm volatile("" ::: "memory");
#pragma unroll
            for (int reg = 0; reg < 4; ++reg) {
                const int t = 4 * g + reg, s = cc; const bool lo = s < t, le = s <= t;
                *(LAS float*)(myslot + SC_LF + (t * 16 + s) * 4) = lo ? d1[reg] : 0.f;
                const int colA = 8 * (cc >> 2) + (cc & 3);
                *(LAS bf16_t*)(myslot + SC_LKA + t * 64 + (colA + 4) * 2) = (bf16_t)f2bf(lo ? d2[reg] : 0.f);
                *(LAS bf16_t*)(myslot + SC_LKA + t * 64 + colA * 2) = (bf16_t)0;
                *(LAS bf16_t*)(myslot + SC_LRA + t * 64 + colA * 2) = (bf16_t)f2bf(le ? d3[reg] : 0.f);
                *(LAS bf16_t*)(myslot + SC_LRA + t * 64 + (colA + 4) * 2) = (bf16_t)f2bf(le ? d4[reg] : 0.f);
            }
            LDS_WAIT();
            float Tc[16];
#pragma unroll
            for (int t = 0; t < 16; ++t) {
                float acc = (cc == t) ? 1.f : 0.f;
#pragma unroll
                for (int s4 = 0; s4 < (t + 3) / 4; ++s4) { const f32x4 l4 = *(const LAS f32x4*)(myslot + SC_LF + (t * 16 + 4 * s4) * 4);
#pragma unroll
                    for (int j = 0; j < 4; ++j) if (4 * s4 + j < t) acc += l4[j] * Tc[4 * s4 + j]; }
                Tc[t] = acc;
            }
            if (g == 0) {
                const int colA = 8 * (cc >> 2) + (cc & 3);
#pragma unroll
                for (int t = 0; t < 16; ++t) { *(LAS bf16_t*)(myslot + SC_TA + t * 64 + colA * 2) = (bf16_t)f2bf(Tc[t]); *(LAS bf16_t*)(myslot + SC_TA + t * 64 + (colA + 4) * 2) = (bf16_t)0; }
            }
        }
        __syncthreads();
        if (wave < 4) {
#pragma unroll 1
            for (int slot = 0; slot < 8; ++slot) {
                const LAS unsigned char* sl = F.lds + slot * SC_SL;
                const bf16x8 a0 = *(const LAS bf16x8*)(sl + SC_AP + cc * 128 + (8 * g) * 2), a1 = *(const LAS bf16x8*)(sl + SC_AP + cc * 128 + (32 + 8 * g) * 2);
                const bf16x8 r0 = *(const LAS bf16x8*)(sl + SC_RP + cc * 128 + (8 * g) * 2), r1 = *(const LAS bf16x8*)(sl + SC_RP + cc * 128 + (32 + 8 * g) * 2);
                const u32x2 vd = *(const LAS u32x2*)(sl + SC_VT + (jb + cc) * 32 + 8 * g);
                const bf16x8 lka = *(const LAS bf16x8*)(sl + SC_LKA + cc * 64 + 16 * g), ta = *(const LAS bf16x8*)(sl + SC_TA + cc * 64 + 16 * g), lra = *(const LAS bf16x8*)(sl + SC_LRA + cc * 64 + 16 * g);
                const f32x4 z4 = (f32x4){0.f, 0.f, 0.f, 0.f};
                f32x4 X = MFMA16(a0, Sb0, z4); X = MFMA16(a1, Sb1, X); X = MFMA16(lka, mk8(0u, 0u, vd.x, vd.y), X);
                const f32x4 U = MFMA16(ta, mk8(pk2(X[0], X[1]), pk2(X[2], X[3]), 0u, 0u), z4);
                const bf16x8 Bu = mk8(pk2(U[0], U[1]), pk2(U[2], U[3]), vd.x, vd.y);
                f32x4 Y = MFMA16(r0, Sb0, z4); Y = MFMA16(r1, Sb1, Y); Y = MFMA16(lra, Bu, Y);
#pragma unroll
                for (int m = 0; m < 4; ++m) {
                    const bf16x8 bkt = *(const LAS bf16x8*)(sl + SC_BKT + (16 * m + cc) * 64 + 16 * g);
                    const f32x4 gc = *(const LAS f32x4*)(sl + SC_GC + (16 * m + 4 * g) * 4);
                    St[m] = MFMA16(bkt, Bu, St[m]) * gc;
                }
#pragma unroll
                for (int reg = 0; reg < 4; ++reg) *(LAS float*)((LAS unsigned char*)sl + SC_Y + ((4 * g + reg) * 64 + jb + cc) * 4) = Y[reg];
                Sb0 = mk8(pk2(St[0][0], St[0][1]), pk2(St[0][2], St[0][3]), pk2(St[1][0], St[1][1]), pk2(St[1][2], St[1][3]));
                Sb1 = mk8(pk2(St[2][0], St[2][1]), pk2(St[2][2], St[2][3]), pk2(St[3][0], St[3][1]), pk2(St[3][2], St[3][3]));
            }
        }
        __syncthreads();
        {
            const int cidx = 8 * r + wave; const size_t t = (size_t)b * SEQ + 16 * cidx + es;
            f32x4 y[4]; float s1 = 0.f;
#pragma unroll
            for (int k = 0; k < 4; ++k) { y[k] = *(const LAS f32x4*)(myslot + SC_Y + (es * 64 + 16 * jq + 4 * k) * 4); s1 += (y[k][0] + y[k][1]) + (y[k][2] + y[k][3]); }
            s1 += __shfl_xor(s1, 1); s1 += __shfl_xor(s1, 2);
            const float mean = s1 * (1.0f / 64.0f); float s2 = 0.f;
#pragma unroll
            for (int k = 0; k < 4; ++k) { y[k] = y[k] - mean; s2 += (y[k][0] * y[k][0] + y[k][1] * y[k][1]) + (y[k][2] * y[k][2] + y[k][3] * y[k][3]); }
            s2 += __shfl_xor(s2, 1); s2 += __shfl_xor(s2, 2);
            const float rstd = rsqrtf(s2 * (1.0f / 64.0f) + LNX_EPS);
            const float bon = *(const LAS float*)(myslot + SC_BON + es * 4);
            const u32x4 g0 = *(const u32x4*)(ag + t * 1024 + 512 + h * 64 + 16 * jq), g1 = *(const u32x4*)(ag + t * 1024 + 512 + h * 64 + 16 * jq + 8);
            float gg[16];
            gg[0] = bf_lo(g0.x); gg[1] = bf_hi(g0.x); gg[2] = bf_lo(g0.y); gg[3] = bf_hi(g0.y); gg[4] = bf_lo(g0.z); gg[5] = bf_hi(g0.z); gg[6] = bf_lo(g0.w); gg[7] = bf_hi(g0.w);
            gg[8] = bf_lo(g1.x); gg[9] = bf_hi(g1.x); gg[10] = bf_lo(g1.y); gg[11] = bf_hi(g1.y); gg[12] = bf_lo(g1.z); gg[13] = bf_hi(g1.z); gg[14] = bf_lo(g1.w); gg[15] = bf_hi(g1.w);
            float o[16];
#pragma unroll
            for (int j = 0; j < 16; ++j) { const float vv = bf2f(*(const LAS bf16_t*)(myslot + SC_VT + (16 * jq + j) * 32 + es * 2));
                o[j] = (y[j >> 2][j & 3] * rstd * lnxg[j] + lnxb[j] + bon * vv) * gg[j]; }
            u32x4 w0, w1; w0.x = pk2(o[0], o[1]); w0.y = pk2(o[2], o[3]); w0.z = pk2(o[4], o[5]); w0.w = pk2(o[6], o[7]);
            w1.x = pk2(o[8], o[9]); w1.y = pk2(o[10], o[11]); w1.z = pk2(o[12], o[13]); w1.w = pk2(o[14], o[15]);
            *(u32x4*)(ycat + t * DM + h * 64 + 16 * jq) = w0; *(u32x4*)(ycat + t * DM + h * 64 + 16 * jq + 8) = w1;
        }
    }
    __syncthreads();
}

__device__ __forceinline__ void ph_attn_simple(Frame& F) {
    const int gw = F.vcu * NWAVES + F.wave, NGW = F.G * NWAVES;
    const bf16_t* proj = (const bf16_t*)(F.ws + WS_P); bf16_t* ycat = (bf16_t*)(F.ws + WS_Y); const float* bt = (const float*)(F.ws + WS_BIAS);
    for (int it = gw; it < NB * 8 * (SEQ / 64); it += NGW) {
        const int sblk = it % (SEQ / 64), h = (it / (SEQ / 64)) % 8, b = it / (8 * (SEQ / 64));
        const int s = sblk * 64 + F.lane; const size_t t = (size_t)b * SEQ + s;
        float q[64], o[64];
        { const u32x4* qp = (const u32x4*)(proj + t * NPROJ + 1536 + h * 64);
#pragma unroll
          for (int i = 0; i < 8; ++i) { const u32x4 w = qp[i]; q[8 * i] = bf_lo(w.x) * 0.125f; q[8 * i + 1] = bf_hi(w.x) * 0.125f; q[8 * i + 2] = bf_lo(w.y) * 0.125f; q[8 * i + 3] = bf_hi(w.y) * 0.125f;
              q[8 * i + 4] = bf_lo(w.z) * 0.125f; q[8 * i + 5] = bf_hi(w.z) * 0.125f; q[8 * i + 6] = bf_lo(w.w) * 0.125f; q[8 * i + 7] = bf_hi(w.w) * 0.125f; } }
#pragma unroll
        for (int d = 0; d < 64; ++d) o[d] = 0.f;
        float mx = -1e30f, l = 0.f;
        for (int p = 0; p < 3; ++p) {
            const int dil = 1 << (2 * p); const float* bp = bt + (p * 8 + h) * BIAS_LD;
            for (int m = 0; m <= 128; ++m) {
                const int sp = s - m * dil;
                if (sp >= 0) {
                    const size_t tk = t - (size_t)(m * dil);
                    const u32x4* kp = (const u32x4*)(proj + tk * NPROJ + 2048 + h * 64);
                    float dot = 0.f;
#pragma unroll
                    for (int i = 0; i < 8; ++i) { const u32x4 w = kp[i];
                        dot += q[8 * i] * bf_lo(w.x) + q[8 * i + 1] * bf_hi(w.x) + q[8 * i + 2] * bf_lo(w.y) + q[8 * i + 3] * bf_hi(w.y)
                             + q[8 * i + 4] * bf_lo(w.z) + q[8 * i + 5] * bf_hi(w.z) + q[8 * i + 6] * bf_lo(w.w) + q[8 * i + 7] * bf_hi(w.w); }
                    const float logit = dot + bp[m];
                    const float nm = fmaxf(mx, logit); const float alpha = __expf(mx - nm), pe = __expf(logit - nm);
                    l = l * alpha + pe; mx = nm;
                    const u32x4* vp = (const u32x4*)(proj + tk * NPROJ + 2560 + h * 64);
#pragma unroll
                    for (int i = 0; i < 8; ++i) { const u32x4 w = vp[i];
                        o[8 * i] = o[8 * i] * alpha + pe * bf_lo(w.x); o[8 * i + 1] = o[8 * i + 1] * alpha + pe * bf_hi(w.x);
                        o[8 * i + 2] = o[8 * i + 2] * alpha + pe * bf_lo(w.y); o[8 * i + 3] = o[8 * i + 3] * alpha + pe * bf_hi(w.y);
                        o[8 * i + 4] = o[8 * i + 4] * alpha + pe * bf_lo(w.z); o[8 * i + 5] = o[8 * i + 5] * alpha + pe * bf_hi(w.z);
                        o[8 * i + 6] = o[8 * i + 6] * alpha + pe * bf_lo(w.w); o[8 * i + 7] = o[8 * i + 7] * alpha + pe * bf_hi(w.w); }
                }
            }
        }
        const float inv = 1.0f / l;
        u32x4* op = (u32x4*)(ycat + t * DM + 512 + h * 64);
#pragma unroll
        for (int i = 0; i < 8; ++i) { u32x4 w; w.x = pk2(o[8 * i] * inv, o[8 * i + 1] * inv); w.y = pk2(o[8 * i + 2] * inv, o[8 * i + 3] * inv);
            w.z = pk2(o[8 * i + 4] * inv, o[8 * i + 5] * inv); w.w = pk2(o[8 * i + 6] * inv, o[8 * i + 7] * inv); op[i] = w; }
    }
}

__device__ __forceinline__ void ph_ln1_router(Frame& F) {
    const int gw = F.vcu * NWAVES + F.wave, NGW = F.G * NWAVES, lane = F.lane;
    LAS float* wrt = (LAS float*)(F.lds);
    for (int idx = F.tid; idx < 36 * 1024; idx += 512) { const int cc = idx >> 10, k = idx & 1023;
        wrt[idx] = (cc < 4) ? F.in[I_RG][k * 4 + cc] : F.in[I_RE][k * 32 + (cc - 4)]; }
    if (F.tid < 32) F.MISC[MW_HIST + F.tid] = 0u;
    __syncthreads();
    float* x1 = (float*)(F.ws + WS_X1); bf16_t* x1b = (bf16_t*)(F.ws + WS_Y);
    int* toke = (int*)(F.ws + WS_TOKE); float* tokw = (float*)(F.ws + WS_TOKW);
    f32x4 gv[4], bv[4];
#pragma unroll
    for (int j = 0; j < 4; ++j) { gv[j] = *(const f32x4*)(F.in[I_LN1G] + 4 * lane + 256 * j); bv[j] = *(const f32x4*)(F.in[I_LN1B] + 4 * lane + 256 * j); }
    for (int row = gw; row < NTOK; row += NGW) {
        f32x4 v[4]; float s = 0.f;
        float* xr = x1 + (size_t)row * DM + 4 * lane;
#pragma unroll
        for (int j = 0; j < 4; ++j) { v[j] = *(const f32x4*)(xr + 256 * j); s += (v[j][0] + v[j][1]) + (v[j][2] + v[j][3]); }
        const float mean = wave_sum(s) * (1.0f / DM); float s2 = 0.f;
#pragma unroll
        for (int j = 0; j < 4; ++j) { v[j] = v[j] - mean; s2 += (v[j][0] * v[j][0] + v[j][1] * v[j][1]) + (v[j][2] * v[j][2] + v[j][3] * v[j][3]); }
        const float rstd = rsqrtf(wave_sum(s2) * (1.0f / DM) + LN_EPS);
#pragma unroll
        for (int j = 0; j < 4; ++j) { v[j] = v[j] * rstd * gv[j] + bv[j]; *(f32x4*)(xr + 256 * j) = v[j];
            u32x2 w; w.x = pk2(v[j][0], v[j][1]); w.y = pk2(v[j][2], v[j][3]); *(u32x2*)(x1b + (size_t)row * DM + 4 * lane + 256 * j) = w; }
        float lg[36];
#pragma unroll
        for (int cc = 0; cc < 36; ++cc) { float a = 0.f;
#pragma unroll
            for (int j = 0; j < 4; ++j) { const f32x4 w4 = *(const LAS f32x4*)(wrt + cc * 1024 + 4 * lane + 256 * j); a += v[j][0] * w4[0] + v[j][1] * w4[1] + v[j][2] * w4[2] + v[j][3] * w4[3]; }
            lg[cc] = wave_sum(a); }
        float gl[4];
#pragma unroll
        for (int i = 0; i < 4; ++i) gl[i] = lg[i] + F.in[I_RGB][i];
        int grp = 0; float gm = gl[0];
#pragma unroll
        for (int i = 1; i < 4; ++i) if (gl[i] > gm) { gm = gl[i]; grp = i; }
        float se = 0.f;
#pragma unroll
        for (int i = 0; i < 4; ++i) se += __expf(gl[i] - gm);
        const float wg = 1.0f / se;
        float le[8];
#pragma unroll
        for (int i = 0; i < 8; ++i) { float vsel = lg[4 + i];
#pragma unroll
            for (int gq = 1; gq < 4; ++gq) vsel = (grp == gq) ? lg[4 + gq * 8 + i] : vsel;
            le[i] = vsel + F.in[I_REB][grp * 8 + i]; }
        int i0 = 0; float v0 = le[0];
#pragma unroll
        for (int i = 1; i < 8; ++i) if (le[i] > v0) { v0 = le[i]; i0 = i; }
        int i1 = -1; float v1 = -3.0e38f;
#pragma unroll
        for (int i = 0; i < 8; ++i) if (i != i0 && le[i] > v1) { v1 = le[i]; i1 = i; }
        const float e1 = __expf(v1 - v0); const float w0 = wg / (1.0f + e1), w1 = wg * e1 / (1.0f + e1);
        const int ex0 = grp * 8 + i0, ex1 = grp * 8 + i1;
        if (lane == 0) { toke[2 * row] = ex0; toke[2 * row + 1] = ex1; tokw[2 * row] = w0; tokw[2 * row + 1] = w1;
            atomicAdd((unsigned*)&F.MISC[MW_HIST + ex0], 1u); atomicAdd((unsigned*)&F.MISC[MW_HIST + ex1], 1u); }
    }
    __syncthreads();
    if (F.tid < 32) { const unsigned hc = F.MISC[MW_HIST + F.tid]; if (hc) atomicAdd(F.ctl + CW_CNT + F.tid, hc); }
}

__device__ __forceinline__ void ph_positions(Frame& F) {
    int* toke = (int*)(F.ws + WS_TOKE); float* tokw = (float*)(F.ws + WS_TOKW);
    int* row_tok = (int*)(F.ws + WS_ROWTOK); int* row_asg = (int*)(F.ws + WS_ROWASG); float* row_w = (float*)(F.ws + WS_ROWW);
    if (F.tid < 32) { F.MISC[MW_CNT + F.tid] = __hip_atomic_load(F.ctl + CW_CNT + F.tid, RLX_AGENT); F.MISC[MW_HIST + F.tid] = 0u; F.MISC[MW_LFILL + F.tid] = 0u; }
    __syncthreads();
    if (F.tid == 0) {
        unsigned rs = 0;
        for (int e = 0; e < 32; ++e) { F.MISC[MW_RS + e] = rs; const unsigned nt = (F.MISC[MW_CNT + e] + 255u) >> 8;
            if (blockIdx.x == 0) { for (unsigned q = 0; q < nt; ++q) F.ctl[CW_TILEE + (rs >> 8) + q] = (unsigned)e; }
            rs += nt << 8; }
        if (blockIdx.x == 0) F.ctl[CW_NTILES] = rs >> 8;
    }
    __syncthreads();
    const int per = (NTOK + F.G - 1) / F.G;
    const int base = F.vcu * per;
    for (int a0 = 0; a0 < 2 * per; a0 += 512) {
        const int a = a0 + F.tid; const int tok = base + (a >> 1), j = a & 1; const bool ok = (a < 2 * per) && (tok < NTOK);
        int e = 0; if (ok) { e = toke[2 * tok + j]; atomicAdd((unsigned*)&F.MISC[MW_HIST + e], 1u); }
        __syncthreads();
        if (F.tid < 32) { const unsigned hc = F.MISC[MW_HIST + F.tid]; F.MISC[MW_LBASE + F.tid] = hc ? atomicAdd(F.ctl + CW_FILL + F.tid, hc) : 0u; }
        __syncthreads();
        if (ok) { const unsigned pos = F.MISC[MW_RS + e] + F.MISC[MW_LBASE + e] + atomicAdd((unsigned*)&F.MISC[MW_LFILL + e], 1u);
            row_tok[pos] = tok; row_asg[pos] = 2 * tok + j; row_w[pos] = tokw[2 * tok + j]; }
        __syncthreads();
        if (F.tid < 32) { F.MISC[MW_HIST + F.tid] = 0u; F.MISC[MW_LFILL + F.tid] = 0u; }
        __syncthreads();
    }
    if (F.vcu < 32) { const int e = F.vcu; const unsigned cnt = F.MISC[MW_CNT + e], rs = F.MISC[MW_RS + e], end = ((cnt + 255u) >> 8) << 8;
        for (unsigned r = cnt + F.tid; r < end; r += 512) { row_tok[rs + r] = 0; row_asg[rs + r] = -1; row_w[rs + r] = 0.f; } }
}

__device__ __forceinline__ void ph_final(Frame& F) {
    const int gw = F.vcu * NWAVES + F.wave, NGW = F.G * NWAVES, lane = F.lane;
    const float* x1 = (const float*)(F.ws + WS_X1); const bf16_t* lo = (const bf16_t*)(F.ws + WS_Y); const bf16_t* hi = (const bf16_t*)(F.ws + WS_MOEHI);
    f32x4 gv[4], bv[4];
#pragma unroll
    for (int j = 0; j < 4; ++j) { gv[j] = *(const f32x4*)(F.in[I_LN2G] + 4 * lane + 256 * j); bv[j] = *(const f32x4*)(F.in[I_LN2B] + 4 * lane + 256 * j); }
    for (int row = gw; row < NTOK; row += NGW) {
        const bf16_t* m0 = (row < 16384) ? lo + (size_t)(2 * row) * DM : hi + (size_t)(2 * row - 32768) * DM;
        f32x4 v[4]; float s = 0.f;
#pragma unroll
        for (int j = 0; j < 4; ++j) { const int cix = 4 * lane + 256 * j;
            const f32x4 xv = *(const f32x4*)(x1 + (size_t)row * DM + cix), pv = *(const f32x4*)(F.out + (size_t)row * DM + cix);
            const u32x2 a = *(const u32x2*)(m0 + cix), b = *(const u32x2*)(m0 + DM + cix);
            f32x4 mv; mv[0] = bf_lo(a.x) + bf_lo(b.x); mv[1] = bf_hi(a.x) + bf_hi(b.x); mv[2] = bf_lo(a.y) + bf_lo(b.y); mv[3] = bf_hi(a.y) + bf_hi(b.y);
            v[j] = xv * ALPHA + mv + pv; s += (v[j][0] + v[j][1]) + (v[j][2] + v[j][3]); }
        const float mean = wave_sum(s) * (1.0f / DM); float s2 = 0.f;
#pragma unroll
        for (int j = 0; j < 4; ++j) { v[j] = v[j] - mean; s2 += (v[j][0] * v[j][0] + v[j][1] * v[j][1]) + (v[j][2] * v[j][2] + v[j][3] * v[j][3]); }
        const float rstd = rsqrtf(wave_sum(s2) * (1.0f / DM) + LN_EPS);
#pragma unroll
        for (int j = 0; j < 4; ++j) *(f32x4*)(F.out + (size_t)row * DM + 4 * lane + 256 * j) = v[j] * rstd * gv[j] + bv[j];
    }
}

constexpr int NPHASE = 12;
struct Args { const float* in[33]; float* out; unsigned char* ws; int ph_lo, ph_hi; };
#ifndef PH_MASK
#define PH_MASK 0xfff
#endif
__global__ void __launch_bounds__(NWAVES * 64, 2) hymba_fwd(const Args args) {
    extern __shared__ __attribute__((aligned(16))) unsigned char lds[];
    Frame F;
    F.lds = (LAS unsigned char*)lds;
    F.MISC = (volatile LAS unsigned*)(F.lds + MISC_OFF);
    F.tid = threadIdx.x; F.lane = F.tid & 63; F.wave = __builtin_amdgcn_readfirstlane(F.tid >> 6);
    F.G = gridDim.x; { const int bx = blockIdx.x; F.vcu = (F.G % 8 == 0) ? (bx % 8) * (F.G / 8) + bx / 8 : bx; }
    F.ws = args.ws; F.ctl = (unsigned*)(args.ws + WS_CTL); F.out = args.out;
    F.in = args.in;
    for (int u = F.tid; u < (LDS_BYTES - LDSCTL_OFF) / 4; u += NWAVES * 64) ((LAS unsigned*)(F.lds + LDSCTL_OFF))[u] = 0u;
    __syncthreads();
    const int lo = args.ph_lo, hi = args.ph_hi;
    XcdBarrier bar; bar.bar = F.ctl + CW_BAR; bar.x = 0; bar.st = nullptr;
    if (hi - lo > 1) bar = xcd_barrier_post(F.ctl + CW_BAR, F.MISC + MW_BAR);
#define IN(k) (((PH_MASK >> (k)) & 1) && lo <= (k) && (k) < hi)
#define SEAM(k) do { if (IN(k) && IN((k) + 1)) xcd_barrier(bar); } while (0)
    LAS unsigned char* ring = F.lds + RING_OFF;

    if (IN(0)) { ph_prologue(F); } SEAM(0);
    if (IN(1)) {
        pg8::Gemm g{(const bf16_t*)(F.ws + WS_XB), (const bf16_t*)(F.ws + WS_WINT), DM}; pg8::StaticOrder S; S.init(NTOK, NEXT, F.G, (int)blockIdx.x);
        EpiProj E{(bf16_t*)(F.ws + WS_P), (float*)(F.ws + WS_LORA1)};
        pg8::gemm_phase<EpiProj, pg8::StaticOrder>(ring, g, S, E);
    } SEAM(1);
    if (IN(2)) { ph_lora_act(F); } SEAM(2);
    if (IN(3)) {
        pg8::Gemm g{(const bf16_t*)(F.ws + WS_Y), (const bf16_t*)(F.ws + WS_W2T), KL2}; pg8::StaticOrder S; S.init(NTOK, NL2, F.G, (int)blockIdx.x);
        EpiDag E{(float*)(F.ws + WS_LW), (bf16_t*)(F.ws + WS_AG), F.in[I_W0], F.in[I_A0]};
        pg8::gemm_phase<EpiDag, pg8::StaticOrder>(ring, g, S, E);
    } SEAM(3);
    #ifdef SCAN_SIMPLE
    if (IN(4)) { ph_scan_simple(F); ph_attn_simple(F); } SEAM(4);
#else
    if (IN(4)) { ph_scan_chunk(F); ph_attn_simple(F); } SEAM(4);
#endif
    if (IN(5)) {
        pg8::Gemm g{(const bf16_t*)(F.ws + WS_Y), (const bf16_t*)(F.ws + WS_WOT), DM}; pg8::StaticOrder S; S.init(NTOK, DM, F.G, (int)blockIdx.x);
        EpiWo E{F.in[I_X], (float*)(F.ws + WS_X1)};
        pg8::gemm_phase<EpiWo, pg8::StaticOrder>(ring, g, S, E);
    } SEAM(5);
    if (IN(6)) { ph_moe_weights(F); __syncthreads(); ph_ln1_router(F); } SEAM(6);
    if (IN(7)) { ph_positions(F); } SEAM(7);
    if (IN(8)) {
        {
            pg8::MoeOrder<true> S{(const int*)(F.ctl + CW_TILEE), (const int*)(F.ws + WS_ROWTOK), (int)__hip_atomic_load(F.ctl + CW_NTILES, RLX_AGENT), F.G, F.vcu};
            pg8::Gemm g{(const bf16_t*)(F.ws + WS_Y), (const bf16_t*)(F.ws + WS_WGUT), DM};
            EpiGU E{(bf16_t*)(F.ws + WS_HDN)};
            pg8::gemm_phase<EpiGU, pg8::MoeOrder<true>>(ring, g, S, E);
        }
    } SEAM(8);
    if (IN(9)) {
        {
            pg8::Gemm g{(const bf16_t*)(F.ws + WS_PB), (const bf16_t*)(F.ws + WS_PT), 256}; pg8::StaticOrder S; S.init(NTOK, DM, F.G, (int)blockIdx.x);
            EpiF32 E{F.out, DM};
            pg8::gemm_phase<EpiF32, pg8::StaticOrder>(ring, g, S, E);
        }
        {
            pg8::Gemm g{(const bf16_t*)(F.ws + WS_Y), (const bf16_t*)(F.ws + WS_GT), DM}; pg8::StaticOrder S; S.init(NTOK, DM, F.G, (int)blockIdx.x);
            EpiPle E{F.out, DM};
            pg8::gemm_phase<EpiPle, pg8::StaticOrder>(ring, g, S, E);
        }
    } SEAM(9);
    if (IN(10)) {
        pg8::MoeOrder<false> S{(const int*)(F.ctl + CW_TILEE), (const int*)(F.ws + WS_ROWTOK), (int)__hip_atomic_load(F.ctl + CW_NTILES, RLX_AGENT), F.G, F.vcu};
        pg8::Gemm g{(const bf16_t*)(F.ws + WS_HDN), (const bf16_t*)(F.ws + WS_WDT), DEXP};
        EpiDown E{(bf16_t*)(F.ws + WS_Y), (bf16_t*)(F.ws + WS_MOEHI), (const int*)(F.ws + WS_ROWASG), (const float*)(F.ws + WS_ROWW)};
        pg8::gemm_phase<EpiDown, pg8::MoeOrder<false>>(ring, g, S, E);
    } SEAM(10);
    if (IN(11)) { ph_final(F); }
#undef IN
#undef SEAM
}

extern "C" void kernel_launch(void* const* d_in, const int* in_sizes, int n_in, void* d_out, int out_size, void* d_ws, size_t ws_size, hipStream_t stream) {
    static int grid = 0;
    if (grid == 0) {
        if (n_in != 33 || in_sizes[0] != NTOK * DM || out_size != NTOK * DM || ws_size < WS_END) { fprintf(stderr, "kernel_launch: unexpected problem (n_in %d, in0 %d, out %d, ws %zu)\n", n_in, n_in > 0 ? in_sizes[0] : -1, out_size, ws_size); grid = -1; return; }
        int dev = 0, cus = 0;
        if (hipGetDevice(&dev) != hipSuccess || hipDeviceGetAttribute(&cus, hipDeviceAttributeMultiprocessorCount, dev) != hipSuccess) { grid = -1; return; }
        if (hipFuncSetAttribute((const void*)hymba_fwd, hipFuncAttributeMaxDynamicSharedMemorySize, LDS_BYTES) != hipSuccess) { fprintf(stderr, "kernel_launch: hipFuncSetAttribute failed\n"); grid = -1; return; }
        int per_cu = 0;
        if (hipOccupancyMaxActiveBlocksPerMultiprocessor(&per_cu, (const void*)hymba_fwd, NWAVES * 64, LDS_BYTES) != hipSuccess || per_cu < 1) fprintf(stderr, "kernel_launch: occupancy query reports %d\n", per_cu);
        (void)hipGetLastError();
        grid = cus;
    }
    if (grid < 0) return;
    if (hipMemsetAsync((char*)d_ws + WS_CTL, 0, CTL_ZERO_BYTES, stream) != hipSuccess) return;
    Args a{};
    for (int i = 0; i < 33; ++i) a.in[i] = (const float*)d_in[i];
    a.out = (float*)d_out; a.ws = (unsigned char*)d_ws;
#if MK_ONE_LAUNCH
    a.ph_lo = 0; a.ph_hi = NPHASE;
    hipLaunchKernelGGL(hymba_fwd, dim3(grid), dim3(NWAVES * 64), LDS_BYTES, stream, a);
#else
    for (int ph = 0; ph < NPHASE; ++ph) { a.ph_lo = ph; a.ph_hi = ph + 1; hipLaunchKernelGGL(hymba_fwd, dim3(grid), dim3(NWAVES * 64), LDS_BYTES, stream, a); }
#endif
}
```

```cpp
#include <hip/hip_runtime.h>
#include <cstdio>
#include <cstdint>

#ifndef MK_ONE_LAUNCH
#define MK_ONE_LAUNCH 1
#endif

#define GAS __attribute__((address_space(1)))
#define LAS __attribute__((address_space(3)))
typedef unsigned short bf16_t;
typedef short bf16x8 __attribute__((ext_vector_type(8)));
typedef float f32x4 __attribute__((ext_vector_type(4)));
typedef float f32x2 __attribute__((ext_vector_type(2)));
typedef unsigned u32x4 __attribute__((ext_vector_type(4)));
typedef unsigned u32x2 __attribute__((ext_vector_type(2)));
#define RLX_AGENT __ATOMIC_RELAXED, __HIP_MEMORY_SCOPE_AGENT
#define LDS_WAIT() asm volatile("s_waitcnt lgkmcnt(0)" ::: "memory")
#define VM_WAIT() asm volatile("s_waitcnt vmcnt(0)" ::: "memory")

__device__ __forceinline__ unsigned f2bf(float f) { unsigned u = __builtin_bit_cast(unsigned, f); return (u + 0x7fffu + ((u >> 16) & 1u)) >> 16; }
__device__ __forceinline__ unsigned pk2(float lo, float hi) { return f2bf(lo) | (f2bf(hi) << 16); }
__device__ __forceinline__ float bf_lo(unsigned w) { return __builtin_bit_cast(float, w << 16); }
__device__ __forceinline__ float bf_hi(unsigned w) { return __builtin_bit_cast(float, w & 0xffff0000u); }
__device__ __forceinline__ float bf2f(bf16_t b) { return __builtin_bit_cast(float, ((unsigned)b) << 16); }
__device__ __forceinline__ float sigmoidf_(float z) { return __builtin_amdgcn_rcpf(1.0f + __builtin_amdgcn_exp2f(-1.4426950408889634f * z)); }
__device__ __forceinline__ float wave_sum(float v) {
#pragma unroll
    for (int o = 1; o < 64; o <<= 1) v += __shfl_xor(v, o);
    return v;
}

namespace pg8 {
constexpr int BM = 256, BK = 64, HALF = 128, HTB = HALF * BK * 2, STAGE_BYTES = 8 * HTB, NXCD = 8, WGM = 8;
__host__ __device__ __forceinline__ int lds_byte(int r, int c) { const int st = (r >> 4) * 2 + (c >> 5), rr = r & 15, cc = c & 31, ob = rr * 64 + cc * 2; return st * 1024 + (ob ^ (((ob >> 9) & 1) << 5)); }
__host__ __device__ __forceinline__ void stage_rc(int b, int& R, int& C) { const int st = b / 1024, sb = b % 1024, swz = sb ^ (((sb >> 9) & 1) << 5); R = (st >> 1) * 16 + swz / 64; C = (st & 1) * 32 + (swz % 64) / 2; }
__host__ __device__ __forceinline__ int perm32(int rho) { const int n = rho >> 4, i = rho & 15; return 8 * (i >> 2) + 4 * n + (i & 3); }

struct Unit { int pm, pn, pb; };
struct Gemm { const bf16_t* A; const bf16_t* Bt; int K; };

struct StaticOrder {
    static constexpr bool GATHER = false;
    int nM, nN, nwg, G, c;
    __device__ void init(int M, int N, int G_, int c_) { nM = M / BM; nN = N / BM; nwg = nM * nN; G = G_; c = c_; }
    __device__ bool next(int i, Unit& u) const {
        const long L = (long)i * G + c; if (L >= nwg) return false;
        int wgid = (int)L; { const int q = nwg / NXCD, r = nwg % NXCD, xcd = wgid % NXCD, off = wgid / NXCD; wgid = (xcd < r ? xcd * (q + 1) : r * (q + 1) + (xcd - r) * q) + off; }
        const int nig = WGM * nN, gid = wgid / nig, fm = gid * WGM, gsz = (nM - fm) < WGM ? (nM - fm) : WGM;
        u.pm = fm + ((wgid % nig) % gsz); u.pn = (wgid % nig) / gsz; u.pb = u.pn; return true;
    }
    __device__ __forceinline__ unsigned a_row_off(const Unit&, int, unsigned) const { return 0u; }
};
template <bool GATHER_> struct MoeOrder {
    static constexpr bool GATHER = GATHER_;
    const int* tile_e; const int* row_tok; int ntiles, G, c;
    __device__ bool next(int i, Unit& u) const {
        const long L = (long)i * G + c; if (L >= (long)ntiles * 4) return false;
        const int tile = (int)(L >> 2), pn = (int)(L & 3);
        u.pm = tile; u.pn = pn; u.pb = tile_e[tile] * 4 + pn; return true;
    }
    __device__ __forceinline__ unsigned a_row_off(const Unit& u, int r, unsigned rowbytes) const { return (unsigned)row_tok[u.pm * 256 + r] * rowbytes; }
};

__device__ __forceinline__ unsigned cvt_pk_bf16(float lo, float hi) { unsigned r; asm volatile("v_cvt_pk_bf16_f32 %0, %1, %2" : "=v"(r) : "v"(lo), "v"(hi)); return r; }

template <class Epi, class Sched>
__device__ __forceinline__ void gemm_phase(LAS unsigned char* lds, const Gemm g, const Sched& S, const Epi& E) {
    const int tid = threadIdx.x, wid = __builtin_amdgcn_readfirstlane(tid >> 6), lane = tid & 63, wr = wid >> 2, wc = wid & 3, fr = lane & 15, fq = lane >> 4;
    const int K = g.K, nt = K / BK;
    int Rr[2], Cc[2];
    unsigned voffB[2];
#pragma unroll
    for (int i = 0; i < 2; ++i) { int R, C; stage_rc(tid * 16 + i * 8192, R, C); const int Rb = Epi::PERM ? ((R & ~31) + perm32(R & 31)) : R;
        Rr[i] = R; Cc[i] = C; voffB[i] = (unsigned)(Rb * K + C) * 2u; }
    const unsigned rowbytes = (unsigned)K * 2u;
    const size_t kstep = (size_t)(BK * 2);
    const size_t hstep = (size_t)HALF * K * 2;
    const size_t tstep = 2 * hstep;
    const unsigned ldsw = (unsigned)wid * 1024u;
    const int aoff = lds_byte(wr * 64 + fr, fq * 8), boff = lds_byte(wc * 32 + fr, fq * 8);
#define PG8_SA(b, h) (((b) * 2 + (h)) * HTB)
#define PG8_SB(b, h) ((4 + (b) * 2 + (h)) * HTB)
#define PG8_STAGE(bufoff, gbase, voff) do { _Pragma("unroll") for (int _i = 0; _i < 2; ++_i) \
        __builtin_amdgcn_global_load_lds((const unsigned*)((const char*)(gbase) + (voff)[_i]), (LAS unsigned*)(lds + (bufoff) + ldsw + _i * 8192), 16, 0, 0); } while (0)
#define PG8_STAGE_A(bufoff, gbase, vv, h) do { _Pragma("unroll") for (int _i = 0; _i < 2; ++_i) \
        __builtin_amdgcn_global_load_lds((const unsigned*)((const char*)(gbase) + (vv)[h][_i]), (LAS unsigned*)(lds + (bufoff) + ldsw + _i * 8192), 16, 0, 0); } while (0)
#define PG8_LDA(dst, b, h) do { _Pragma("unroll") for (int m = 0; m < 4; ++m) _Pragma("unroll") for (int k = 0; k < 2; ++k) dst[m][k] = *(const LAS bf16x8*)(lds + PG8_SA(b, h) + aoff + m * 2048 + k * 1024); } while (0)
#define PG8_LDB(dst, b, h) do { _Pragma("unroll") for (int n = 0; n < 2; ++n) _Pragma("unroll") for (int k = 0; k < 2; ++k) dst[n][k] = *(const LAS bf16x8*)(lds + PG8_SB(b, h) + boff + n * 2048 + k * 1024); } while (0)
#define PG8_MMA(ai, bj, At, Bt) do { __builtin_amdgcn_s_setprio(1); _Pragma("unroll") for (int m = 0; m < 4; ++m) _Pragma("unroll") for (int n = 0; n < 2; ++n) _Pragma("unroll") for (int k = 0; k < 2; ++k) \
        acc[ai][bj][m][n] = __builtin_amdgcn_mfma_f32_16x16x32_bf16(Bt[n][k], At[m][k], acc[ai][bj][m][n], 0, 0, 0); __builtin_amdgcn_s_setprio(0); } while (0)
#define PG8_WAIT_V(n) asm volatile("s_waitcnt vmcnt(" #n ")" ::: "memory")
#define PG8_WAIT_L(n) asm volatile("s_waitcnt lgkmcnt(" #n ")" ::: "memory")
#define PG8_BAR __builtin_amdgcn_s_barrier()
#define PG8_SCHED __builtin_amdgcn_sched_barrier(0)
#define PG8_SETOFF(vv, uu) do { _Pragma("unroll") for (int _h = 0; _h < 2; ++_h) _Pragma("unroll") for (int _i = 0; _i < 2; ++_i) { \
        if constexpr (Sched::GATHER) (vv)[_h][_i] = S.a_row_off((uu), _h * HALF + Rr[_i], rowbytes) + (unsigned)Cc[_i] * 2u; \
        else (vv)[_h][_i] = (unsigned)((_h * HALF + Rr[_i]) * K + Cc[_i]) * 2u; } } while (0)
    Unit cur, nxt; int ui = 0;
    if (!S.next(0, cur)) return;
    f32x4 acc[2][2][4][2];
#pragma unroll
    for (int a = 0; a < 2; ++a)
#pragma unroll
        for (int b = 0; b < 2; ++b)
#pragma unroll
            for (int m = 0; m < 4; ++m)
#pragma unroll
                for (int n = 0; n < 2; ++n) acc[a][b][m][n] = (f32x4){0.f, 0.f, 0.f, 0.f};
    bf16x8 At[4][2], B0[2][2], B1[2][2];
    unsigned vAc[2][2], vAn[2][2];
    PG8_SETOFF(vAc, cur);
    const char* cA = Sched::GATHER ? (const char*)g.A : (const char*)g.A + (size_t)cur.pm * tstep;
    const char* cB = (const char*)g.Bt + (size_t)cur.pb * tstep;
    PG8_STAGE(PG8_SB(0, 0), cB, voffB); PG8_STAGE(PG8_SB(0, 1), cB + hstep, voffB); PG8_STAGE_A(PG8_SA(0, 0), cA, vAc, 0); PG8_STAGE_A(PG8_SA(0, 1), cA, vAc, 1);
    if (wr == 1) PG8_BAR;
    PG8_WAIT_V(2); PG8_BAR;
    PG8_STAGE(PG8_SB(1, 0), cB + kstep, voffB); PG8_STAGE_A(PG8_SA(1, 0), cA + kstep, vAc, 0); PG8_STAGE(PG8_SB(1, 1), cB + hstep + kstep, voffB);
    PG8_WAIT_V(6); PG8_BAR;
    for (;;) {
        const bool has_next = S.next(ui + 1, nxt);
        const char* nA = cA; const char* nB = cB;
        if (has_next) { nA = Sched::GATHER ? (const char*)g.A : (const char*)g.A + (size_t)nxt.pm * tstep; nB = (const char*)g.Bt + (size_t)nxt.pb * tstep; }
        if constexpr (Sched::GATHER) {
            if (has_next) { PG8_SETOFF(vAn, nxt); }
            else {
#pragma unroll
                for (int h = 0; h < 2; ++h)
#pragma unroll
                    for (int i = 0; i < 2; ++i) vAn[h][i] = vAc[h][i];
            }
        }
#pragma unroll 1
        for (int t = 0; t < nt; t += 2) {
            const bool last = (t == nt - 2);
            const char* a1 = cA + (size_t)(t + 1) * kstep;
            const char* a2 = last ? nA : cA + (size_t)(t + 2) * kstep; const char* b2 = last ? nB : cB + (size_t)(t + 2) * kstep;
            const char* a3 = a2 + kstep; const char* b3 = b2 + kstep;
            unsigned vs[2][2];
#pragma unroll
            for (int h = 0; h < 2; ++h)
#pragma unroll
                for (int i = 0; i < 2; ++i) { if constexpr (Sched::GATHER) vs[h][i] = last ? vAn[h][i] : vAc[h][i]; else vs[h][i] = vAc[h][i]; }
            PG8_LDB(B0, 0, 0); PG8_LDB(B1, 0, 1); PG8_SCHED; PG8_LDA(At, 0, 0); PG8_STAGE_A(PG8_SA(1, 1), a1, vAc, 1);
            PG8_WAIT_V(8); PG8_WAIT_L(0); PG8_BAR; PG8_MMA(0, 0, At, B0); PG8_MMA(0, 1, At, B1); PG8_BAR; PG8_SCHED;
            PG8_LDA(At, 0, 1); PG8_STAGE(PG8_SB(0, 0), b2, voffB); PG8_STAGE(PG8_SB(0, 1), b2 + hstep, voffB); PG8_STAGE_A(PG8_SA(0, 0), a2, vs, 0);
            PG8_WAIT_V(8); PG8_WAIT_L(0); PG8_BAR; PG8_MMA(1, 0, At, B0); PG8_MMA(1, 1, At, B1); PG8_BAR; PG8_SCHED;
            PG8_LDB(B0, 1, 0); PG8_LDB(B1, 1, 1); PG8_SCHED; PG8_LDA(At, 1, 0); PG8_STAGE_A(PG8_SA(0, 1), a2, vs, 1);
            PG8_WAIT_V(8); PG8_WAIT_L(0); PG8_BAR; PG8_MMA(0, 0, At, B0); PG8_MMA(0, 1, At, B1); PG8_BAR; PG8_SCHED;
            PG8_LDA(At, 1, 1); PG8_STAGE(PG8_SB(1, 0), b3, voffB); PG8_STAGE(PG8_SB(1, 1), b3 + hstep, voffB); PG8_STAGE_A(PG8_SA(1, 0), a3, vs, 0);
            PG8_WAIT_V(8); PG8_WAIT_L(0); PG8_BAR; PG8_MMA(1, 0, At, B0); PG8_MMA(1, 1, At, B1); PG8_BAR; PG8_SCHED;
        }
        if (wr == 0) PG8_BAR;
        E(acc, cur, wr, wc, fr, fq);
        if (!has_next) break;
#pragma unroll
        for (int a = 0; a < 2; ++a)
#pragma unroll
            for (int b = 0; b < 2; ++b)
#pragma unroll
                for (int m = 0; m < 4; ++m)
#pragma unroll
                    for (int n = 0; n < 2; ++n) acc[a][b][m][n] = (f32x4){0.f, 0.f, 0.f, 0.f};
        cur = nxt; cA = nA; cB = nB; ++ui;
        if constexpr (Sched::GATHER) {
#pragma unroll
            for (int h = 0; h < 2; ++h)
#pragma unroll
                for (int i = 0; i < 2; ++i) vAc[h][i] = vAn[h][i];
        }
        if (wr == 1) PG8_BAR;
    }
    PG8_WAIT_V(0);
    PG8_BAR;
#undef PG8_SA
#undef PG8_SB
#undef PG8_STAGE
#undef PG8_STAGE_A
#undef PG8_LDA
#undef PG8_LDB
#undef PG8_MMA
#undef PG8_WAIT_V
#undef PG8_WAIT_L
#undef PG8_BAR
#undef PG8_SCHED
#undef PG8_SETOFF
}
}

#define XB_TMO      128
#define XB_XCNT(j)  (256  + 64 * (j))
#define XB_XSUB(j)  (1280 + 64 * (j))
#define XB_XGEN(j)  (2304 + 64 * (j))
#define XB_TOP      3328
#define XB_TOPGEN   3392
#define XCD_BAR_WORDS 3456
#define XB_SPIN_CAP (1u << 18)
__device__ __forceinline__ unsigned xb_ld(unsigned* p)              { return __hip_atomic_load(p, __ATOMIC_RELAXED, __HIP_MEMORY_SCOPE_AGENT); }
__device__ __forceinline__ unsigned xb_add(unsigned* p, unsigned v) { return __hip_atomic_fetch_add(p, v, __ATOMIC_RELAXED, __HIP_MEMORY_SCOPE_AGENT); }
__device__ __forceinline__ unsigned xb_xcc_id() { return (unsigned)__builtin_amdgcn_s_getreg((3 << 11) | 20) & 0xFu; }
#define XB_SPIN(cond, bar) do { unsigned _sp = 0; while (cond) { __builtin_amdgcn_s_sleep(1); \
    if ((++_sp & 255u) == 0u) { if (xb_ld(&(bar)[XB_TMO])) break; if (_sp > XB_SPIN_CAP) { atomicAdd(&(bar)[XB_TMO], 1u); break; } } } } while (0)
struct XcdBarrier { unsigned* bar; unsigned x; volatile LAS unsigned* st; };
__device__ __forceinline__ XcdBarrier xcd_barrier_post(unsigned* bar, volatile LAS unsigned* st) {
    XcdBarrier b; b.bar = bar; b.x = xb_xcc_id(); b.st = st;
    if (threadIdx.x == 0) (void)xb_add(&bar[XB_XCNT(b.x)], 1u);
    return b;
}
__device__ __forceinline__ void xcd_barrier_complete(unsigned* bar, unsigned x, unsigned& nloc, unsigned& nx) {
    const unsigned G = gridDim.x * gridDim.y * gridDim.z;
    unsigned sum, cnt, mine, sp = 0u;
    for (;;) {
        sum = 0u; cnt = 0u; mine = 0u;
#pragma unroll
        for (unsigned j = 0; j < 16; ++j) { const unsigned c = xb_ld(&bar[XB_XCNT(j)]); sum += c; cnt += (c > 0u) ? 1u : 0u; mine = (j == x) ? c : mine; }
        if (sum == G) break;
        __builtin_amdgcn_s_sleep(1);
        if ((++sp & 255u) == 0u) { if (xb_ld(&bar[XB_TMO])) break; if (sp > XB_SPIN_CAP) { atomicAdd(&bar[XB_TMO], 1u); break; } }
    }
    nloc = mine > 0u ? mine : 1u; nx = cnt > 0u ? cnt : 1u;
}
__device__ __forceinline__ void xcd_barrier(const XcdBarrier& b) {
    asm volatile("s_waitcnt vmcnt(0)" ::: "memory");
    __syncthreads();
    if (threadIdx.x == 0) {
        unsigned* bar = b.bar;
        __builtin_amdgcn_s_waitcnt(0);
        unsigned nloc = b.st[0], nx = b.st[1];
        if (nloc == 0u) { xcd_barrier_complete(bar, b.x, nloc, nx); b.st[0] = nloc; b.st[1] = nx; }
        const unsigned old = xb_add(&bar[XB_XSUB(b.x)], 1u);
        const unsigned gen = old / nloc;
        if (old + 1u == (gen + 1u) * nloc) {
            __builtin_amdgcn_fence(__ATOMIC_RELEASE, "agent");
            asm volatile("s_waitcnt vmcnt(0)" ::: "memory");
            const unsigned og = xb_add(&bar[XB_TOP], 1u);
            const unsigned tg = og / nx;
            if (og + 1u == (tg + 1u) * nx) xb_add(&bar[XB_TOPGEN], 1u);
            else XB_SPIN(xb_ld(&bar[XB_TOPGEN]) == tg, bar);
            __builtin_amdgcn_fence(__ATOMIC_ACQUIRE, "agent");
            xb_add(&bar[XB_XGEN(b.x)], 1u);
            asm volatile("s_waitcnt vmcnt(0)" ::: "memory");
        } else {
            XB_SPIN(xb_ld(&bar[XB_XGEN(b.x)]) == gen, bar);
            __builtin_amdgcn_fence(__ATOMIC_ACQUIRE, "agent");
            asm volatile("s_waitcnt vmcnt(0)" ::: "memory");
        }
    }
    __syncthreads();
}

constexpr int NWAVES = 8;
constexpr int SEQ = 2048, NB = 16, DM = 1024, NTOK = NB * SEQ;
constexpr int DRW = 512, HD = 64;
constexpr int NPROJ = 3072, NEXT = 3584, NL1 = 512, KL2 = 256, NL2 = 1536;
constexpr int NEXP = 32, DEXP = 512;
constexpr int PROWS_MAX = 65536 + 32 * 256, MAXTILES = PROWS_MAX / 256;
constexpr float LN_EPS = 1e-5f, LNX_EPS = 64e-5f, ALPHA = 1.189207115002721f;

constexpr size_t MiB = 1u << 20;
constexpr size_t WS_CTL = 0, CTL_ZERO_BYTES = 1 * MiB;
constexpr size_t WS_WINT = 1 * MiB;
constexpr size_t WS_W2T = 8 * MiB;
constexpr size_t WS_WOT = 9 * MiB;
constexpr size_t WS_GT = 11 * MiB;
constexpr size_t WS_PT = 13 * MiB;
constexpr size_t WS_BIAS = 13 * MiB + 512 * 1024;
constexpr size_t WS_TOKE = 14 * MiB;
constexpr size_t WS_TOKW = 14 * MiB + 256 * 1024;
constexpr size_t WS_ROWTOK = 14 * MiB + 512 * 1024;
constexpr size_t WS_ROWASG = 15 * MiB;
constexpr size_t WS_ROWW = 15 * MiB + 512 * 1024;
constexpr size_t WS_PB = 16 * MiB;
constexpr size_t WS_X1 = 33 * MiB;
constexpr size_t WS_XB = WS_X1, WS_LORA1 = WS_X1 + 64 * MiB;
constexpr size_t WS_LW = WS_X1, WS_AG = WS_X1 + 64 * MiB;
constexpr size_t WS_P = 161 * MiB;
constexpr size_t WS_WGUT = WS_P, WS_WDT = WS_P + 64 * MiB, WS_HDN = WS_P + 96 * MiB, WS_MOEHI = WS_P;
constexpr size_t WS_Y = 353 * MiB;
constexpr size_t WS_END = 417 * MiB;
constexpr int BIAS_LD = 132;
constexpr int CW_BAR = 4096;
constexpr int CW_CNT = 8192, CW_FILL = 8192 + 64, CW_NTILES = 8192 + 128, CW_TILEE = 8192 + 256;

constexpr int RING_OFF = 0, RING_BYTES = 131072;
constexpr int WRT_BYTES = 36 * 1024 * 4;
constexpr int LDSCTL_OFF = WRT_BYTES, MISC_OFF = LDSCTL_OFF;
constexpr int LDS_BYTES = LDSCTL_OFF + 1024;
constexpr int MW_HIST = 0, MW_CNT = 32, MW_RS = 64, MW_LBASE = 96, MW_LFILL = 128, MW_BAR = 160;

struct Frame {
    LAS unsigned char* lds;
    volatile LAS unsigned* MISC;
    unsigned* ctl;
    int tid, lane, wave, vcu, G;
    unsigned char* ws;
    const float* const* in;
    float* out;
};
enum InIdx { I_X = 0, I_P, I_WIN, I_MURKV, I_MULORA, I_W0, I_WL1, I_WL2, I_A0, I_AL1, I_AL2, I_GL1, I_GL2, I_KK, I_KA, I_RK, I_LNXG, I_LNXB, I_RELB, I_WO,
             I_LN1G, I_LN1B, I_RG, I_RGB, I_RE, I_REB, I_WG, I_WU, I_WD, I_PG, I_PP, I_LN2G, I_LN2B };

__device__ __forceinline__ void tr_item(const float* W, int ldw, int k0, int n0, bf16_t* dst, int ldt, const float* mu, int smode, LAS float* scr, int lane) {
#pragma unroll 8
    for (int i = 0; i < 32; ++i) { const int kk = 2 * i + (lane >> 5); float v = W[(size_t)(k0 + kk) * ldw + n0 + (lane & 31)];
        if (smode == 1) v *= (1.0f - mu[k0 + kk]); else if (smode == 2) v *= mu[k0 + kk];
        scr[kk * 33 + (lane & 31)] = v; }
    LDS_WAIT(); asm volatile("" ::: "memory");
    const int c = lane & 7;
#pragma unroll
    for (int j = 0; j < 4; ++j) { const int n = (lane >> 3) + 8 * j; const LAS float* s = scr + (8 * c) * 33 + n;
        u32x4 o; o.x = pk2(s[0 * 33], s[1 * 33]); o.y = pk2(s[2 * 33], s[3 * 33]); o.z = pk2(s[4 * 33], s[5 * 33]); o.w = pk2(s[6 * 33], s[7 * 33]);
        *(u32x4*)(dst + (size_t)n * ldt + k0 + 8 * c) = o; }
    LDS_WAIT(); asm volatile("" ::: "memory");
}
__device__ __forceinline__ int t5_bucket(int n) {
    if (n < 16) return n;
    int b = 16;
    b += (n >= 22); b += (n >= 30); b += (n >= 40); b += (n >= 54); b += (n >= 73); b += (n >= 99); b += (n >= 134); b += (n >= 182);
    b += (n >= 246); b += (n >= 332); b += (n >= 450); b += (n >= 609); b += (n >= 825); b += (n >= 1117); b += (n >= 1513);
    return b;
}

__device__ __forceinline__ void ph_prologue(Frame& F) {
    const int gt = F.vcu * 512 + F.tid, NGT = F.G * 512;
    const int gw = F.vcu * NWAVES + F.wave, NGW = F.G * NWAVES;
    { const f32x4* x4 = (const f32x4*)F.in[I_X]; u32x4* o = (u32x4*)(F.ws + WS_XB);
      for (int i = gt; i < NTOK * DM / 8; i += NGT) { const f32x4 a = x4[2 * i], b = x4[2 * i + 1]; u32x4 w; w.x = pk2(a.x, a.y); w.y = pk2(a.z, a.w); w.z = pk2(b.x, b.y); w.w = pk2(b.z, b.w); o[i] = w; } }
    { const f32x4* x4 = (const f32x4*)F.in[I_P]; u32x4* o = (u32x4*)(F.ws + WS_PB);
      for (int i = gt; i < NTOK * 256 / 8; i += NGT) { const f32x4 a = x4[2 * i], b = x4[2 * i + 1]; u32x4 w; w.x = pk2(a.x, a.y); w.y = pk2(a.z, a.w); w.z = pk2(b.x, b.y); w.w = pk2(b.z, b.w); o[i] = w; } }
    { bf16_t* w2t = (bf16_t*)(F.ws + WS_W2T);
      for (int i = gt; i < NL2 * KL2; i += NGT) { const int n = i / KL2, k = i % KL2; float v = 0.f;
          if (n < 512) { if (k < 64) v = F.in[I_WL2][k * 512 + n]; }
          else if (n < 1024) { if (k >= 64 && k < 128) v = F.in[I_AL2][(k - 64) * 512 + (n - 512)]; }
          else { if (k >= 128) v = F.in[I_GL2][(k - 128) * 512 + (n - 1024)]; }
          w2t[i] = (bf16_t)f2bf(v); } }
    { float* bt = (float*)(F.ws + WS_BIAS);
      for (int i = gt; i < 3 * 8 * BIAS_LD; i += NGT) { const int p = i / (8 * BIAS_LD), h = (i / BIAS_LD) % 8, m = i % BIAS_LD; const int dil = 1 << (2 * p);
          bt[i] = (m <= 128) ? F.in[I_RELB][t5_bucket(m * dil) * 8 + h] : 0.f; } }
    LAS float* scr = (LAS float*)(F.lds + RING_OFF + F.wave * 16384);
    constexpr int IT_WIN = 16 * 96, IT_L1 = 256, IT_WO = 512, IT_G = 512, IT_PP = 128;
    constexpr int NIT = IT_WIN + IT_L1 + IT_WO + IT_G + IT_PP;
    bf16_t* WinT = (bf16_t*)(F.ws + WS_WINT);
    for (int it = gw; it < NIT; it += NGW) {
        int r = it;
        if (r < IT_WIN) { const int kb = r / 96, nb = r % 96; tr_item(F.in[I_WIN], NPROJ, kb * 64, nb * 32, WinT + (size_t)(nb * 32) * DM, DM, nullptr, 0, scr, F.lane); continue; } r -= IT_WIN;
        if (r < IT_L1) {
            int piece, sub;
            if (r < 128) { piece = r / 32; sub = r % 32; } else { piece = 4 + (r - 128) / 64; sub = (r - 128) % 64; }
            const int which = piece >> 1, isprev = piece & 1;
            const int ncols = (which == 2) ? 128 : 64, nblk = ncols / 32;
            const int kb = sub / nblk, nb = sub % nblk;
            const float* src = (which == 0) ? F.in[I_WL1] : (which == 1) ? F.in[I_AL1] : F.in[I_GL1];
            const int rowbase = (which == 0) ? 3072 + 64 * isprev : (which == 1) ? 3200 + 64 * isprev : 3328 + 128 * isprev;
            tr_item(src, ncols, kb * 64, nb * 32, WinT + (size_t)(rowbase + nb * 32) * DM, DM, F.in[I_MULORA] + which * DM, isprev ? 2 : 1, scr, F.lane); continue; } r -= IT_L1;
        if (r < IT_WO) { const int kb = r / 32, nb = r % 32; tr_item(F.in[I_WO], DM, kb * 64, nb * 32, (bf16_t*)(F.ws + WS_WOT) + (size_t)(nb * 32) * DM, DM, nullptr, 0, scr, F.lane); continue; } r -= IT_WO;
        if (r < IT_G) { const int kb = r / 32, nb = r % 32; tr_item(F.in[I_PG], DM, kb * 64, nb * 32, (bf16_t*)(F.ws + WS_GT) + (size_t)(nb * 32) * DM, DM, nullptr, 0, scr, F.lane); continue; } r -= IT_G;
        { const int kb = r / 32, nb = r % 32; tr_item(F.in[I_PP], DM, kb * 64, nb * 32, (bf16_t*)(F.ws + WS_PT) + (size_t)(nb * 32) * 256, 256, nullptr, 0, scr, F.lane); }
    }
}
__device__ __forceinline__ void ph_moe_weights(Frame& F) {
    const int gw = F.vcu * NWAVES + F.wave, NGW = F.G * NWAVES;
    LAS float* scr = (LAS float*)(F.lds + RING_OFF + F.wave * 16384);
    constexpr int IT_GU = 64 * 256, IT_D = 32 * 256;
    for (int it = gw; it < IT_GU + IT_D; it += NGW) {
        if (it < IT_GU) { const int mat = it / 256, sub = it % 256, e = mat >> 1, up = mat & 1, kb = sub / 16, nb = sub % 16, n0 = nb * 32;
            const float* src = (up ? F.in[I_WU] : F.in[I_WG]) + (size_t)e * DM * DEXP;
            bf16_t* dst = (bf16_t*)(F.ws + WS_WGUT) + ((size_t)e * 1024 + (n0 >> 7) * 256 + up * 128 + (n0 & 127)) * DM;
            tr_item(src, DEXP, kb * 64, n0, dst, DM, nullptr, 0, scr, F.lane); }
        else { const int r = it - IT_GU, e = r / 256, sub = r % 256, kb = sub / 32, nb = sub % 32;
            const float* src = F.in[I_WD] + (size_t)e * DEXP * DM;
            bf16_t* dst = (bf16_t*)(F.ws + WS_WDT) + ((size_t)e * 1024 + nb * 32) * DEXP;
            tr_item(src, DM, kb * 64, nb * 32, dst, DEXP, nullptr, 0, scr, F.lane); }
    }
}

using pg8::Unit; using pg8::cvt_pk_bf16;
struct EpiProj {
    static constexpr bool PERM = true;
    bf16_t* proj; float* lora1;
    __device__ __forceinline__ void operator()(const f32x4 (&acc)[2][2][4][2], const Unit& u, int wr, int wc, int fr, int fq) const {
        const int row0 = u.pm * 256 + wr * 64 + fr;
        if (u.pn < 12) {
            const int col0 = u.pn * 256 + wc * 32 + 8 * fq;
#pragma unroll
            for (int ai = 0; ai < 2; ++ai)
#pragma unroll
                for (int m = 0; m < 4; ++m) { bf16_t* rowp = proj + (size_t)(row0 + ai * 128 + m * 16) * NPROJ + col0;
#pragma unroll
                    for (int bj = 0; bj < 2; ++bj) { const f32x4 v0 = acc[ai][bj][m][0], v1 = acc[ai][bj][m][1]; u32x4 w;
                        w.x = cvt_pk_bf16(v0[0], v0[1]); w.y = cvt_pk_bf16(v0[2], v0[3]); w.z = cvt_pk_bf16(v1[0], v1[1]); w.w = cvt_pk_bf16(v1[2], v1[3]);
                        *(u32x4*)(rowp + bj * 128) = w; } }
        } else {
            const int col0 = (u.pn - 12) * 256 + wc * 32 + 8 * fq;
#pragma unroll
            for (int ai = 0; ai < 2; ++ai)
#pragma unroll
                for (int m = 0; m < 4; ++m) { float* rowp = lora1 + (size_t)(row0 + ai * 128 + m * 16) * NL1 + col0;
#pragma unroll
                    for (int bj = 0; bj < 2; ++bj) { *(f32x4*)(rowp + bj * 128) = acc[ai][bj][m][0]; *(f32x4*)(rowp + bj * 128 + 4) = acc[ai][bj][m][1]; } }
        }
    }
};
struct EpiDag {
    static constexpr bool PERM = true;
    float* lw; bf16_t* ag; const float* w0; const float* a0;
    __device__ __forceinline__ void operator()(const f32x4 (&acc)[2][2][4][2], const Unit& u, int wr, int wc, int fr, int fq) const {
        const int row0 = u.pm * 256 + wr * 64 + fr;
        const int colt = u.pn * 256 + wc * 32 + 8 * fq;
        if (u.pn < 2) {
#pragma unroll
            for (int bj = 0; bj < 2; ++bj) {
                const f32x4 b0 = *(const f32x4*)(w0 + colt + bj * 128), b1 = *(const f32x4*)(w0 + colt + bj * 128 + 4);
#pragma unroll
                for (int ai = 0; ai < 2; ++ai)
#pragma unroll
                    for (int m = 0; m < 4; ++m) { float* rowp = lw + (size_t)(row0 + ai * 128 + m * 16) * 512 + colt + bj * 128;
                        const f32x4 z0 = acc[ai][bj][m][0] + b0, z1 = acc[ai][bj][m][1] + b1; f32x4 o0, o1;
#pragma unroll
                        for (int j = 0; j < 4; ++j) { o0[j] = -0.6065306597126334f * sigmoidf_(z0[j]); o1[j] = -0.6065306597126334f * sigmoidf_(z1[j]); }
                        *(f32x4*)(rowp) = o0; *(f32x4*)(rowp + 4) = o1; }
                asm volatile("" ::: "memory");
            }
        } else {
            const bool isa = (u.pn < 4);
#pragma unroll
            for (int bj = 0; bj < 2; ++bj) {
                f32x4 b0 = (f32x4){0.f, 0.f, 0.f, 0.f}, b1 = (f32x4){0.f, 0.f, 0.f, 0.f};
                if (isa) { b0 = *(const f32x4*)(a0 + (colt - 512) + bj * 128); b1 = *(const f32x4*)(a0 + (colt - 512) + bj * 128 + 4); }
#pragma unroll
                for (int ai = 0; ai < 2; ++ai)
#pragma unroll
                    for (int m = 0; m < 4; ++m) { bf16_t* rowp = ag + (size_t)(row0 + ai * 128 + m * 16) * 1024 + (colt - 512) + bj * 128;
                        f32x4 v0 = acc[ai][bj][m][0] + b0, v1 = acc[ai][bj][m][1] + b1;
                        if (isa) {
#pragma unroll
                            for (int j = 0; j < 4; ++j) { v0[j] = sigmoidf_(v0[j]); v1[j] = sigmoidf_(v1[j]); } }
                        u32x4 w; w.x = cvt_pk_bf16(v0[0], v0[1]); w.y = cvt_pk_bf16(v0[2], v0[3]); w.z = cvt_pk_bf16(v1[0], v1[1]); w.w = cvt_pk_bf16(v1[2], v1[3]);
                        *(u32x4*)(rowp) = w; }
                asm volatile("" ::: "memory");
            }
        }
    }
};
struct EpiWo {
    static constexpr bool PERM = false;
    const float* x; float* pre1;
    __device__ __forceinline__ void operator()(const f32x4 (&acc)[2][2][4][2], const Unit& u, int wr, int wc, int fr, int fq) const {
        const int row0 = u.pm * 256 + wr * 64 + fr, col0 = u.pn * 256 + wc * 32 + 4 * fq;
#pragma unroll
        for (int ai = 0; ai < 2; ++ai)
#pragma unroll
            for (int m = 0; m < 4; ++m) { const size_t off = (size_t)(row0 + ai * 128 + m * 16) * DM + col0;
#pragma unroll
                for (int bj = 0; bj < 2; ++bj)
#pragma unroll
                    for (int n = 0; n < 2; ++n) { const f32x4 xv = *(const f32x4*)(x + off + bj * 128 + n * 16); *(f32x4*)(pre1 + off + bj * 128 + n * 16) = xv * ALPHA + acc[ai][bj][m][n]; }
                asm volatile("" ::: "memory"); }
    }
};
struct EpiF32 {
    static constexpr bool PERM = false;
    float* C; int ldc;
    __device__ __forceinline__ void operator()(const f32x4 (&acc)[2][2][4][2], const Unit& u, int wr, int wc, int fr, int fq) const {
        const int row0 = u.pm * 256 + wr * 64 + fr, col0 = u.pn * 256 + wc * 32 + 4 * fq;
#pragma unroll
        for (int ai = 0; ai < 2; ++ai)
#pragma unroll
            for (int m = 0; m < 4; ++m) { float* rowp = C + (size_t)(row0 + ai * 128 + m * 16) * ldc + col0;
#pragma unroll
                for (int bj = 0; bj < 2; ++bj)
#pragma unroll
                    for (int n = 0; n < 2; ++n) *(f32x4*)(rowp + bj * 128 + n * 16) = acc[ai][bj][m][n]; }
    }
};
struct EpiPle {
    static constexpr bool PERM = false;
    float* C; int ldc;
    __device__ __forceinline__ void operator()(const f32x4 (&acc)[2][2][4][2], const Unit& u, int wr, int wc, int fr, int fq) const {
        const int row0 = u.pm * 256 + wr * 64 + fr, col0 = u.pn * 256 + wc * 32 + 4 * fq;
#pragma unroll
        for (int ai = 0; ai < 2; ++ai)
#pragma unroll
            for (int m = 0; m < 4; ++m) { float* rowp = C + (size_t)(row0 + ai * 128 + m * 16) * ldc + col0;
#pragma unroll
                for (int bj = 0; bj < 2; ++bj)
#pragma unroll
                    for (int n = 0; n < 2; ++n) { const f32x4 pv = *(const f32x4*)(rowp + bj * 128 + n * 16); const f32x4 a = acc[ai][bj][m][n]; f32x4 o;
#pragma unroll
                        for (int j = 0; j < 4; ++j) o[j] = sigmoidf_(a[j]) * pv[j];
                        *(f32x4*)(rowp + bj * 128 + n * 16) = o; }
                asm volatile("" ::: "memory"); }
    }
};
struct EpiGU {
    static constexpr bool PERM = true;
    bf16_t* hdn;
    __device__ __forceinline__ void operator()(const f32x4 (&acc)[2][2][4][2], const Unit& u, int wr, int wc, int fr, int fq) const {
        const int row0 = u.pm * 256 + wr * 64 + fr, col0 = u.pn * 128 + wc * 32 + 8 * fq;
#pragma unroll
        for (int ai = 0; ai < 2; ++ai)
#pragma unroll
            for (int m = 0; m < 4; ++m) { bf16_t* rowp = hdn + (size_t)(row0 + ai * 128 + m * 16) * DEXP + col0; float h[8];
#pragma unroll
                for (int n = 0; n < 2; ++n)
#pragma unroll
                    for (int j = 0; j < 4; ++j) { const float gt = acc[ai][0][m][n][j], up = acc[ai][1][m][n][j]; h[4 * n + j] = gt * sigmoidf_(gt) * up; }
                u32x4 w; w.x = cvt_pk_bf16(h[0], h[1]); w.y = cvt_pk_bf16(h[2], h[3]); w.z = cvt_pk_bf16(h[4], h[5]); w.w = cvt_pk_bf16(h[6], h[7]);
                *(u32x4*)rowp = w; }
    }
};
struct EpiDown {
    static constexpr bool PERM = true;
    bf16_t* lo; bf16_t* hi; const int* row_asg; const float* row_w;
    __device__ __forceinline__ void operator()(const f32x4 (&acc)[2][2][4][2], const Unit& u, int wr, int wc, int fr, int fq) const {
        const int row0 = u.pm * 256 + wr * 64 + fr, col0 = u.pn * 256 + wc * 32 + 8 * fq;
#pragma unroll
        for (int ai = 0; ai < 2; ++ai)
#pragma unroll
            for (int m = 0; m < 4; ++m) { const int prow = row0 + ai * 128 + m * 16; const int asg = row_asg[prow]; const float w = row_w[prow];
                if (asg >= 0) { bf16_t* rowp = (asg < 32768 ? lo + (size_t)asg * DM : hi + (size_t)(asg - 32768) * DM) + col0;
#pragma unroll
                    for (int bj = 0; bj < 2; ++bj) { const f32x4 v0 = acc[ai][bj][m][0] * w, v1 = acc[ai][bj][m][1] * w; u32x4 o;
                        o.x = cvt_pk_bf16(v0[0], v0[1]); o.y = cvt_pk_bf16(v0[2], v0[3]); o.z = cvt_pk_bf16(v1[0], v1[1]); o.w = cvt_pk_bf16(v1[2], v1[3]);
                        *(u32x4*)(rowp + bj * 128) = o; } } }
    }
};

__device__ __forceinline__ void ph_lora_act(Frame& F) {
    const int gt = F.vcu * 512 + F.tid, NGT = F.G * 512;
    const float* l1 = (const float*)(F.ws + WS_LORA1); bf16_t* act = (bf16_t*)(F.ws + WS_Y);
    for (int i = gt; i < NTOK * 64; i += NGT) {
        const int t = i >> 6, c4 = (i & 63) * 4; const bool first = (t % SEQ) == 0;
        int ca, cb, mode;
        if (c4 < 64) { ca = c4; cb = 64 + c4; mode = 0; } else if (c4 < 128) { ca = 128 + (c4 - 64); cb = 192 + (c4 - 64); mode = 1; } else { ca = 256 + (c4 - 128); cb = 384 + (c4 - 128); mode = 2; }
        f32x4 a = *(const f32x4*)(l1 + (size_t)t * NL1 + ca);
        if (!first) a += *(const f32x4*)(l1 + (size_t)(t - 1) * NL1 + cb);
        float o[4];
#pragma unroll
        for (int j = 0; j < 4; ++j) o[j] = (mode == 0) ? tanhf(a[j]) : (mode == 1) ? a[j] : sigmoidf_(a[j]);
        u32x2 w; w.x = pk2(o[0], o[1]); w.y = pk2(o[2], o[3]);
        *(u32x2*)(act + (size_t)t * KL2 + c4) = w;
    }
}

__device__ __forceinline__ void ph_scan_simple(Frame& F) {
    if (F.vcu >= 128 || F.wave != 0) return;
    const int bh = F.vcu, b = bh >> 3, h = bh & 7, lane = F.lane, c = h * 64 + lane;
    LAS float* vec = (LAS float*)(F.lds + RING_OFF);
    const bf16_t* proj = (const bf16_t*)(F.ws + WS_P); const float* lwb = (const float*)(F.ws + WS_LW); const bf16_t* ag = (const bf16_t*)(F.ws + WS_AG);
    bf16_t* ycat = (bf16_t*)(F.ws + WS_Y);
    const float mu_r = F.in[I_MURKV][c], mu_k = F.in[I_MURKV][512 + c], mu_v = F.in[I_MURKV][1024 + c];
    const float k_k = F.in[I_KK][c], k_a = F.in[I_KA][c], r_k = F.in[I_RK][c], lg = F.in[I_LNXG][c], lb = F.in[I_LNXB][c];
    float S[64];
#pragma unroll
    for (int k = 0; k < 64; ++k) S[k] = 0.f;
    float rp = 0.f, kp = 0.f, vp = 0.f;
    for (int s = 0; s < SEQ; ++s) {
        const size_t t = (size_t)b * SEQ + s;
        const float r_in = bf2f(proj[t * NPROJ + c]), k_in = bf2f(proj[t * NPROJ + 512 + c]), v_in = bf2f(proj[t * NPROJ + 1024 + c]);
        const float r = r_in + (rp - r_in) * mu_r, k = k_in + (kp - k_in) * mu_k, v = v_in + (vp - v_in) * mu_v;
        rp = r_in; kp = k_in; vp = v_in;
        const float w = __expf(lwb[t * 512 + c]);
        const float a = bf2f(ag[t * 1024 + c]), g = bf2f(ag[t * 1024 + 512 + c]);
        float kk = k * k_k; const float ss = wave_sum(kk * kk); kk *= rsqrtf(fmaxf(ss, 1e-24f));
        const float kq = k * (1.0f + (a - 1.0f) * k_a);
        const float bonus = wave_sum(r * kq * r_k);
        vec[lane] = -kk; vec[64 + lane] = w; vec[128 + lane] = kk * a; vec[192 + lane] = kq; vec[256 + lane] = r;
        LDS_WAIT();
        float sa = 0.f;
#pragma unroll
        for (int q = 0; q < 16; ++q) { const f32x4 a4 = *(const LAS f32x4*)(vec + 4 * q); sa += S[4 * q] * a4[0]; sa += S[4 * q + 1] * a4[1]; sa += S[4 * q + 2] * a4[2]; sa += S[4 * q + 3] * a4[3]; if ((q & 3) == 3) __builtin_amdgcn_sched_barrier(0); }
        float y = 0.f;
#pragma unroll
        for (int q = 0; q < 16; ++q) { const f32x4 w4 = *(const LAS f32x4*)(vec + 64 + 4 * q), b4 = *(const LAS f32x4*)(vec + 128 + 4 * q), k4 = *(const LAS f32x4*)(vec + 192 + 4 * q), r4 = *(const LAS f32x4*)(vec + 256 + 4 * q);
#pragma unroll
            for (int j = 0; j < 4; ++j) { const float sn = S[4 * q + j] * w4[j] + sa * b4[j] + v * k4[j]; S[4 * q + j] = sn; y += sn * r4[j]; }
            __builtin_amdgcn_sched_barrier(0); }
        LDS_WAIT();
        const float mean = wave_sum(y) * (1.0f / 64.0f); const float d = y - mean; const float var = wave_sum(d * d) * (1.0f / 64.0f);
        const float yn = d * rsqrtf(var + LNX_EPS) * lg + lb;
        ycat[t * DM + c] = (bf16_t)f2bf((yn + bonus * v) * g);
    }
}

constexpr int SC_SL = 18432;
constexpr int SC_AP = 0, SC_RP = 2048, SC_BKT = 4096, SC_VT = 8192, SC_BR = 10240, SC_KR = 12288, SC_Y = 10240, SC_LF = 10240, SC_LKA = 14336, SC_TA = 15360, SC_LRA = 16384, SC_GC = 17408, SC_BON = 17664;
static_assert(8 * SC_SL <= LDSCTL_OFF, "scan slots fit below the LDS control words");
__device__ __forceinline__ int sigma64(int i) { return (i & ~31) | (((i >> 2) & 3) << 3) | (((i >> 4) & 1) << 2) | (i & 3); }
__device__ __forceinline__ bf16x8 mk8(unsigned a, unsigned b, unsigned c, unsigned d) { u32x4 v; v.x = a; v.y = b; v.z = c; v.w = d; return __builtin_bit_cast(bf16x8, v); }
#define MFMA16(A, B, C) __builtin_amdgcn_mfma_f32_16x16x32_bf16((A), (B), (C), 0, 0, 0)

__device__ __forceinline__ void ph_scan_chunk(Frame& F) {
    if (F.vcu >= 128) return;
    const int bh = F.vcu, b = bh >> 3, h = bh & 7, lane = F.lane, wave = F.wave;
    const int g = lane >> 4, cc = lane & 15;
    const bf16_t* proj = (const bf16_t*)(F.ws + WS_P); const float* lwb = (const float*)(F.ws + WS_LW); const bf16_t* ag = (const bf16_t*)(F.ws + WS_AG);
    bf16_t* ycat = (bf16_t*)(F.ws + WS_Y);
    LAS unsigned char* myslot = F.lds + wave * SC_SL;
    const int ch = h * 64 + lane, si = sigma64(lane);
    const float mu_r = F.in[I_MURKV][ch], mu_k = F.in[I_MURKV][512 + ch], mu_v = F.in[I_MURKV][1024 + ch];
    const float k_k = F.in[I_KK][ch], k_a = F.in[I_KA][ch], r_k = F.in[I_RK][ch];
    const int es = lane >> 2, jq = lane & 3;
    float lnxg[16], lnxb[16];
#pragma unroll
    for (int j = 0; j < 16; ++j) { lnxg[j] = F.in[I_LNXG][h * 64 + 16 * jq + j]; lnxb[j] = F.in[I_LNXB][h * 64 + 16 * jq + j]; }
    f32x4 St[4];
#pragma unroll
    for (int m = 0; m < 4; ++m) St[m] = (f32x4){0.f, 0.f, 0.f, 0.f};
    bf16x8 Sb0 = mk8(0u, 0u, 0u, 0u), Sb1 = mk8(0u, 0u, 0u, 0u);
    const int jb = 16 * (wave & 3);

    for (int r = 0; r < SEQ / 128; ++r) {
        {
            const int cidx = 8 * r + wave; const size_t t0 = (size_t)b * SEQ + 16 * cidx;
            float rp = 0.f, kp = 0.f, vp = 0.f;
            if (cidx > 0) { rp = bf2f(proj[(t0 - 1) * NPROJ + ch]); kp = bf2f(proj[(t0 - 1) * NPROJ + 512 + ch]); vp = bf2f(proj[(t0 - 1) * NPROJ + 1024 + ch]); }
            float cl = 0.f, eprev = 1.f, ecur = 1.f;
            unsigned vpk[8];
#pragma unroll
            for (int sg = 0; sg < 4; ++sg) {
                float bt4[4], kt4[4], v4[4];
#pragma unroll
                for (int e4 = 0; e4 < 4; ++e4) {
                    const int s = 4 * sg + e4; const size_t t = t0 + s;
                    const float r_in = bf2f(proj[t * NPROJ + ch]), k_in = bf2f(proj[t * NPROJ + 512 + ch]), v_in = bf2f(proj[t * NPROJ + 1024 + ch]);
                    const float rr = r_in + (rp - r_in) * mu_r, kx = k_in + (kp - k_in) * mu_k, vv = v_in + (vp - v_in) * mu_v;
                    rp = r_in; kp = k_in; vp = v_in;
                    const float lw = lwb[t * 512 + ch]; const float a = bf2f(ag[t * 1024 + ch]);
                    float kk = kx * k_k; const float ss = wave_sum(kk * kk); kk *= rsqrtf(fmaxf(ss, 1e-24f));
                    const float kq = kx * (1.0f + (a - 1.0f) * k_a);
                    const float bonus = wave_sum(rr * kq * r_k);
                    cl += lw; ecur = __expf(cl); const float einv = __expf(-cl);
                    const float Ah = -kk * eprev, Rh = rr * ecur, Bv = kk * a * einv, Kv = kq * einv;
                    eprev = ecur;
                    *(LAS bf16_t*)(myslot + SC_AP + s * 128 + si * 2) = (bf16_t)f2bf(Ah);
                    *(LAS bf16_t*)(myslot + SC_RP + s * 128 + si * 2) = (bf16_t)f2bf(Rh);
                    *(LAS bf16_t*)(myslot + SC_BR + s * 128 + si * 2) = (bf16_t)f2bf(Bv);
                    *(LAS bf16_t*)(myslot + SC_KR + s * 128 + si * 2) = (bf16_t)f2bf(Kv);
                    bt4[e4] = Bv; kt4[e4] = Kv; v4[e4] = vv;
                    if (lane == 0) *(LAS float*)(myslot + SC_BON + s * 4) = bonus;
                }
                u32x4 w; w.x = pk2(bt4[0], bt4[1]); w.y = pk2(bt4[2], bt4[3]); w.z = pk2(kt4[0], kt4[1]); w.w = pk2(kt4[2], kt4[3]);
                *(LAS u32x4*)(myslot + SC_BKT + lane * 64 + sg * 16) = w;
                vpk[2 * sg] = pk2(v4[0], v4[1]); vpk[2 * sg + 1] = pk2(v4[2], v4[3]);
            }
            { u32x4 w0, w1; w0.x = vpk[0]; w0.y = vpk[1]; w0.z = vpk[2]; w0.w = vpk[3]; w1.x = vpk[4]; w1.y = vpk[5]; w1.z = vpk[6]; w1.w = vpk[7];
              *(LAS u32x4*)(myslot + SC_VT + lane * 32) = w0; *(LAS u32x4*)(myslot + SC_VT + lane * 32 + 16) = w1; }
            *(LAS float*)(myslot + SC_GC + lane * 4) = ecur;
            LDS_WAIT();
            f32x4 d1 = (f32x4){0.f, 0.f, 0.f, 0.f}, d2 = d1, d3 = d1, d4 = d1;
#pragma unroll
            for (int ks = 0; ks < 2; ++ks) {
                const int off = cc * 128 + (32 * ks + 8 * g) * 2;
                const bf16x8 fa = *(const LAS bf16x8*)(myslot + SC_AP + off), fr = *(const LAS bf16x8*)(myslot + SC_RP + off);
                const bf16x8 fb = *(const LAS bf16x8*)(myslot + SC_BR + off), fk = *(const LAS bf16x8*)(myslot + SC_KR + off);
                d1 = MFMA16(fa, fb, d1); d2 = MFMA16(fa, fk, d2); d3 = MFMA16(fr, fb, d3); d4 = MFMA16(fr, fk, d4);
            }
            asm volatile("" ::: "memory");
#pragma unroll
            for (int reg = 0; reg < 4; ++reg) {
                const int t = 4 * g + reg, s = cc; const bool lo = s < t, le = s <= t;
                *(LAS float*)(myslot + SC_LF + (t * 16 + s) * 4) = lo ? d1[reg] : 0.f;
                const int colA = 8 * (cc >> 2) + (cc & 3);
                *(LAS bf16_t*)(myslot + SC_LKA + t * 64 + (colA + 4) * 2) = (bf16_t)f2bf(lo ? d2[reg] : 0.f);
                *(LAS bf16_t*)(myslot + SC_LKA + t * 64 + colA * 2) = (bf16_t)0;
                *(LAS bf16_t*)(myslot + SC_LRA + t * 64 + colA * 2) = (bf16_t)f2bf(le ? d3[reg] : 0.f);
                *(LAS bf16_t*)(myslot + SC_LRA + t * 64 + (colA + 4) * 2) = (bf16_t)f2bf(le ? d4[reg] : 0.f);
            }
            LDS_WAIT();
            float Tc[16];
#pragma unroll
            for (int t = 0; t < 16; ++t) {
                float acc = (cc == t) ? 1.f : 0.f;
#pragma unroll
                for (int s4 = 0; s4 < (t + 3) / 4; ++s4) { const f32x4 l4 = *(const LAS f32x4*)(myslot + SC_LF + (t * 16 + 4 * s4) * 4);
#pragma unroll
                    for (int j = 0; j < 4; ++j) if (4 * s4 + j < t) acc += l4[j] * Tc[4 * s4 + j]; }
                Tc[t] = acc;
            }
            if (g == 0) {
                const int colA = 8 * (cc >> 2) + (cc & 3);
#pragma unroll
                for (int t = 0; t < 16; ++t) { *(LAS bf16_t*)(myslot + SC_TA + t * 64 + colA * 2) = (bf16_t)f2bf(Tc[t]); *(LAS bf16_t*)(myslot + SC_TA + t * 64 + (colA + 4) * 2) = (bf16_t)0; }
            }
        }
        __syncthreads();
        if (wave < 4) {
#pragma unroll 1
            for (int slot = 0; slot < 8; ++slot) {
                const LAS unsigned char* sl = F.lds + slot * SC_SL;
                const bf16x8 a0 = *(const LAS bf16x8*)(sl + SC_AP + cc * 128 + (8 * g) * 2), a1 = *(const LAS bf16x8*)(sl + SC_AP + cc * 128 + (32 + 8 * g) * 2);
                const bf16x8 r0 = *(const LAS bf16x8*)(sl + SC_RP + cc * 128 + (8 * g) * 2), r1 = *(const LAS bf16x8*)(sl + SC_RP + cc * 128 + (32 + 8 * g) * 2);
                const u32x2 vd = *(const LAS u32x2*)(sl + SC_VT + (jb + cc) * 32 + 8 * g);
                const bf16x8 lka = *(const LAS bf16x8*)(sl + SC_LKA + cc * 64 + 16 * g), ta = *(const LAS bf16x8*)(sl + SC_TA + cc * 64 + 16 * g), lra = *(const LAS bf16x8*)(sl + SC_LRA + cc * 64 + 16 * g);
                const f32x4 z4 = (f32x4){0.f, 0.f, 0.f, 0.f};
                f32x4 X = MFMA16(a0, Sb0, z4); X = MFMA16(a1, Sb1, X); X = MFMA16(lka, mk8(0u, 0u, vd.x, vd.y), X);
                const f32x4 U = MFMA16(ta, mk8(pk2(X[0], X[1]), pk2(X[2], X[3]), 0u, 0u), z4);
                const bf16x8 Bu = mk8(pk2(U[0], U[1]), pk2(U[2], U[3]), vd.x, vd.y);
                f32x4 Y = MFMA16(r0, Sb0, z4); Y = MFMA16(r1, Sb1, Y); Y = MFMA16(lra, Bu, Y);
#pragma unroll
                for (int m = 0; m < 4; ++m) {
                    const bf16x8 bkt = *(const LAS bf16x8*)(sl + SC_BKT + (16 * m + cc) * 64 + 16 * g);
                    const f32x4 gc = *(const LAS f32x4*)(sl + SC_GC + (16 * m + 4 * g) * 4);
                    St[m] = MFMA16(bkt, Bu, St[m]) * gc;
                }
#pragma unroll
                for (int reg = 0; reg < 4; ++reg) *(LAS float*)((LAS unsigned char*)sl + SC_Y + ((4 * g + reg) * 64 + jb + cc) * 4) = Y[reg];
                Sb0 = mk8(pk2(St[0][0], St[0][1]), pk2(St[0][2], St[0][3]), pk2(St[1][0], St[1][1]), pk2(St[1][2], St[1][3]));
                Sb1 = mk8(pk2(St[2][0], St[2][1]), pk2(St[2][2], St[2][3]), pk2(St[3][0], St[3][1]), pk2(St[3][2], St[3][3]));
            }
        }
        __syncthreads();
        {
            const int cidx = 8 * r + wave; const size_t t = (size_t)b * SEQ + 16 * cidx + es;
            f32x4 y[4]; float s1 = 0.f;
#pragma unroll
            for (int k = 0; k < 4; ++k) { y[k] = *(const LAS f32x4*)(myslot + SC_Y + (es * 64 + 16 * jq + 4 * k) * 4); s1 += (y[k][0] + y[k][1]) + (y[k][2] + y[k][3]); }
            s1 += __shfl_xor(s1, 1); s1 += __shfl_xor(s1, 2);
            const float mean = s1 * (1.0f / 64.0f); float s2 = 0.f;
#pragma unroll
            for (int k = 0; k < 4; ++k) { y[k] = y[k] - mean; s2 += (y[k][0] * y[k][0] + y[k][1] * y[k][1]) + (y[k][2] * y[k][2] + y[k][3] * y[k][3]); }
            s2 += __shfl_xor(s2, 1); s2 += __shfl_xor(s2, 2);
            const float rstd = rsqrtf(s2 * (1.0f / 64.0f) + LNX_EPS);
            const float bon = *(const LAS float*)(myslot + SC_BON + es * 4);
            const u32x4 g0 = *(const u32x4*)(ag + t * 1024 + 512 + h * 64 + 16 * jq), g1 = *(const u32x4*)(ag + t * 1024 + 512 + h * 64 + 16 * jq + 8);
            float gg[16];
            gg[0] = bf_lo(g0.x); gg[1] = bf_hi(g0.x); gg[2] = bf_lo(g0.y); gg[3] = bf_hi(g0.y); gg[4] = bf_lo(g0.z); gg[5] = bf_hi(g0.z); gg[6] = bf_lo(g0.w); gg[7] = bf_hi(g0.w);
            gg[8] = bf_lo(g1.x); gg[9] = bf_hi(g1.x); gg[10] = bf_lo(g1.y); gg[11] = bf_hi(g1.y); gg[12] = bf_lo(g1.z); gg[13] = bf_hi(g1.z); gg[14] = bf_lo(g1.w); gg[15] = bf_hi(g1.w);
            float o[16];
#pragma unroll
            for (int j = 0; j < 16; ++j) { const float vv = bf2f(*(const LAS bf16_t*)(myslot + SC_VT + (16 * jq + j) * 32 + es * 2));
                o[j] = (y[j >> 2][j & 3] * rstd * lnxg[j] + lnxb[j] + bon * vv) * gg[j]; }
            u32x4 w0, w1; w0.x = pk2(o[0], o[1]); w0.y = pk2(o[2], o[3]); w0.z = pk2(o[4], o[5]); w0.w = pk2(o[6], o[7]);
            w1.x = pk2(o[8], o[9]); w1.y = pk2(o[10], o[11]); w1.z = pk2(o[12], o[13]); w1.w = pk2(o[14], o[15]);
            *(u32x4*)(ycat + t * DM + h * 64 + 16 * jq) = w0; *(u32x4*)(ycat + t * DM + h * 64 + 16 * jq + 8) = w1;
        }
    }
    __syncthreads();
}

__device__ __forceinline__ void ph_attn_simple(Frame& F) {
    const int gw = F.vcu * NWAVES + F.wave, NGW = F.G * NWAVES;
    const bf16_t* proj = (const bf16_t*)(F.ws + WS_P); bf16_t* ycat = (bf16_t*)(F.ws + WS_Y); const float* bt = (const float*)(F.ws + WS_BIAS);
    for (int it = gw; it < NB * 8 * (SEQ / 64); it += NGW) {
        const int sblk = it % (SEQ / 64), h = (it / (SEQ / 64)) % 8, b = it / (8 * (SEQ / 64));
        const int s = sblk * 64 + F.lane; const size_t t = (size_t)b * SEQ + s;
        float q[64], o[64];
        { const u32x4* qp = (const u32x4*)(proj + t * NPROJ + 1536 + h * 64);
#pragma unroll
          for (int i = 0; i < 8; ++i) { const u32x4 w = qp[i]; q[8 * i] = bf_lo(w.x) * 0.125f; q[8 * i + 1] = bf_hi(w.x) * 0.125f; q[8 * i + 2] = bf_lo(w.y) * 0.125f; q[8 * i + 3] = bf_hi(w.y) * 0.125f;
              q[8 * i + 4] = bf_lo(w.z) * 0.125f; q[8 * i + 5] = bf_hi(w.z) * 0.125f; q[8 * i + 6] = bf_lo(w.w) * 0.125f; q[8 * i + 7] = bf_hi(w.w) * 0.125f; } }
#pragma unroll
        for (int d = 0; d < 64; ++d) o[d] = 0.f;
        float mx = -1e30f, l = 0.f;
        for (int p = 0; p < 3; ++p) {
            const int dil = 1 << (2 * p); const float* bp = bt + (p * 8 + h) * BIAS_LD;
            for (int m = 0; m <= 128; ++m) {
                const int sp = s - m * dil;
                if (sp >= 0) {
                    const size_t tk = t - (size_t)(m * dil);
                    const u32x4* kp = (const u32x4*)(proj + tk * NPROJ + 2048 + h * 64);
                    float dot = 0.f;
#pragma unroll
                    for (int i = 0; i < 8; ++i) { const u32x4 w = kp[i];
                        dot += q[8 * i] * bf_lo(w.x) + q[8 * i + 1] * bf_hi(w.x) + q[8 * i + 2] * bf_lo(w.y) + q[8 * i + 3] * bf_hi(w.y)
                             + q[8 * i + 4] * bf_lo(w.z) + q[8 * i + 5] * bf_hi(w.z) + q[8 * i + 6] * bf_lo(w.w) + q[8 * i + 7] * bf_hi(w.w); }
                    const float logit = dot + bp[m];
                    const float nm = fmaxf(mx, logit); const float alpha = __expf(mx - nm), pe = __expf(logit - nm);
                    l = l * alpha + pe; mx = nm;
                    const u32x4* vp = (const u32x4*)(proj + tk * NPROJ + 2560 + h * 64);
#pragma unroll
                    for (int i = 0; i < 8; ++i) { const u32x4 w = vp[i];
                        o[8 * i] = o[8 * i] * alpha + pe * bf_lo(w.x); o[8 * i + 1] = o[8 * i + 1] * alpha + pe * bf_hi(w.x);
                        o[8 * i + 2] = o[8 * i + 2] * alpha + pe * bf_lo(w.y); o[8 * i + 3] = o[8 * i + 3] * alpha + pe * bf_hi(w.y);
                        o[8 * i + 4] = o[8 * i + 4] * alpha + pe * bf_lo(w.z); o[8 * i + 5] = o[8 * i + 5] * alpha + pe * bf_hi(w.z);
                        o[8 * i + 6] = o[8 * i + 6] * alpha + pe * bf_lo(w.w); o[8 * i + 7] = o[8 * i + 7] * alpha + pe * bf_hi(w.w); }
                }
            }
        }
        const float inv = 1.0f / l;
        u32x4* op = (u32x4*)(ycat + t * DM + 512 + h * 64);
#pragma unroll
        for (int i = 0; i < 8; ++i) { u32x4 w; w.x = pk2(o[8 * i] * inv, o[8 * i + 1] * inv); w.y = pk2(o[8 * i + 2] * inv, o[8 * i + 3] * inv);
            w.z = pk2(o[8 * i + 4] * inv, o[8 * i + 5] * inv); w.w = pk2(o[8 * i + 6] * inv, o[8 * i + 7] * inv); op[i] = w; }
    }
}

constexpr int AT_OST = 0, AT_OST_CH = 4352, AT_ML = 69632, AT_BIAS = 71680, AT_V = 73728, AT_VW = 5120, AT_VRS = 160;
static_assert(AT_V + 8 * AT_VW <= LDSCTL_OFF, "attention LDS map");
constexpr int MW_UNIT = 164;
constexpr int CW_ATTQ = 8192 + 192;
__device__ __forceinline__ bf16x8 tr_read2(unsigned a1, unsigned a2) {
    u32x2 r1, r2;
    asm volatile("ds_read_b64_tr_b16 %0, %2\n\tds_read_b64_tr_b16 %1, %3\n\ts_waitcnt lgkmcnt(0)" : "=&v"(r1), "=&v"(r2) : "v"(a1), "v"(a2) : "memory");
    return mk8(r1.x, r1.y, r2.x, r2.y);
}
__device__ __forceinline__ void attn_qtile(const bf16_t* projb, int h, int qpos, int lq, int lk_start, int ntiles, int dil, int resid,
                                           const LAS float* biasp, LAS unsigned char* vbuf, int lane, float& m, float& l, f32x4 (&o)[4]) {
    const int g = lane >> 4, c = lane & 15;
    bf16x8 qf[2];
#pragma unroll
    for (int ks = 0; ks < 2; ++ks) qf[ks] = *(const bf16x8*)(projb + (size_t)qpos * NPROJ + 1536 + h * 64 + 32 * ks + 8 * g);
    const int kt0 = (lk_start < 0) ? ((-lk_start) >> 5) : 0;
    bf16x8 kf[2][2]; u32x4 vr[4];
#define AT_LOADKV(kt) do { \
        _Pragma("unroll") for (int st = 0; st < 2; ++st) { int lk_ = lk_start + 32 * (kt) + 16 * st + c; lk_ = lk_ < 0 ? 0 : lk_; const bf16_t* kp_ = projb + (size_t)(lk_ * dil + resid) * NPROJ + 2048 + h * 64 + 8 * g; \
            kf[st][0] = *(const bf16x8*)(kp_); kf[st][1] = *(const bf16x8*)(kp_ + 32); } \
        _Pragma("unroll") for (int k_ = 0; k_ < 4; ++k_) { const int id_ = lane + 64 * k_; int lk_ = lk_start + 32 * (kt) + (id_ >> 3); lk_ = lk_ < 0 ? 0 : lk_; \
            vr[k_] = *(const u32x4*)(projb + (size_t)(lk_ * dil + resid) * NPROJ + 2560 + h * 64 + 8 * (id_ & 7)); } } while (0)
    if (kt0 < ntiles) AT_LOADKV(kt0);
    const unsigned vb = (unsigned)(__UINTPTR_TYPE__)vbuf;
    const unsigned tra = vb + (unsigned)((4 * g + ((lane & 15) >> 2)) * AT_VRS + (lane & 3) * 8);
    for (int kt = kt0; kt < ntiles; ++kt) {
#pragma unroll
        for (int k = 0; k < 4; ++k) { const int id = lane + 64 * k; *(LAS u32x4*)(vbuf + (id >> 3) * AT_VRS + (id & 7) * 16) = vr[k]; }
        bf16x8 kc[2][2];
#pragma unroll
        for (int st = 0; st < 2; ++st)
#pragma unroll
            for (int ks = 0; ks < 2; ++ks) kc[st][ks] = kf[st][ks];
        if (kt + 1 < ntiles) AT_LOADKV(kt + 1);
        const f32x4 z4 = (f32x4){0.f, 0.f, 0.f, 0.f};
        f32x4 s[2];
        s[0] = MFMA16(kc[0][0], qf[0], z4); s[0] = MFMA16(kc[0][1], qf[1], s[0]);
        s[1] = MFMA16(kc[1][0], qf[0], z4); s[1] = MFMA16(kc[1][1], qf[1], s[1]);
        float lg[2][4]; bool ok[2][4]; float tmax = -1e30f;
#pragma unroll
        for (int st = 0; st < 2; ++st)
#pragma unroll
            for (int reg = 0; reg < 4; ++reg) { const int lk = lk_start + 32 * kt + 16 * st + 4 * g + reg; const int rel = lq - lk;
                ok[st][reg] = (rel >= 0) && (rel <= 128) && (lk >= 0);
                const float bia = biasp[ok[st][reg] ? rel : 0];
                lg[st][reg] = ok[st][reg] ? s[st][reg] * 0.125f + bia : -1e30f; tmax = fmaxf(tmax, lg[st][reg]); }
        tmax = fmaxf(tmax, __shfl_xor(tmax, 16)); tmax = fmaxf(tmax, __shfl_xor(tmax, 32));
        const float mn = fmaxf(m, tmax); const float alpha = __expf(m - mn); m = mn;
        float p[2][4]; float ps = 0.f;
#pragma unroll
        for (int st = 0; st < 2; ++st)
#pragma unroll
            for (int reg = 0; reg < 4; ++reg) { p[st][reg] = ok[st][reg] ? __expf(lg[st][reg] - mn) : 0.f; ps += p[st][reg]; }
        l = l * alpha + ps;
#pragma unroll
        for (int mm = 0; mm < 4; ++mm) o[mm] = o[mm] * alpha;
        const bf16x8 Pb = mk8(pk2(p[0][0], p[0][1]), pk2(p[0][2], p[0][3]), pk2(p[1][0], p[1][1]), pk2(p[1][2], p[1][3]));
        asm volatile("s_waitcnt lgkmcnt(0)" ::: "memory");
#pragma unroll
        for (int mm = 0; mm < 4; ++mm) { const bf16x8 vt = tr_read2(tra + 32 * mm, tra + 32 * mm + 16 * AT_VRS); o[mm] = MFMA16(vt, Pb, o[mm]); }
    }
#undef AT_LOADKV
}

__device__ __forceinline__ void ph_attn_mfma(Frame& F) {
    const bf16_t* proj = (const bf16_t*)(F.ws + WS_P); bf16_t* ycat = (bf16_t*)(F.ws + WS_Y); const float* bt = (const float*)(F.ws + WS_BIAS);
    const int lane = F.lane, wave = F.wave, g = lane >> 4, c = lane & 15;
    LAS unsigned char* vbuf = F.lds + AT_V + wave * AT_VW;
    LAS float* biasl = (LAS float*)(F.lds + AT_BIAS);
    for (;;) {
        if (F.tid == 0) F.MISC[MW_UNIT] = atomicAdd(F.ctl + CW_ATTQ, 1u);
        __syncthreads();
        const int unit = (int)F.MISC[MW_UNIT];
        if (unit >= NB * 8 * 8) break;
        const int u = unit & 7, h = (unit >> 3) & 7, b = unit >> 6;
        for (int i = F.tid; i < 3 * BIAS_LD; i += 512) biasl[i] = bt[((i / BIAS_LD) * 8 + h) * BIAS_LD + (i % BIAS_LD)];
        __syncthreads();
        const bf16_t* projb = proj + (size_t)b * SEQ * NPROJ;
#pragma unroll 1
        for (int qi = 0; qi < 2; ++qi) {
            const int tau = 2 * wave + qi; const int qpos = 256 * u + 16 * tau + c;
            float m = -1e30f, l = 0.f; f32x4 o[4];
#pragma unroll
            for (int mm = 0; mm < 4; ++mm) o[mm] = (f32x4){0.f, 0.f, 0.f, 0.f};
            attn_qtile(projb, h, qpos, qpos, 256 * u + 16 * tau - 144, 5, 1, 0, biasl, vbuf, lane, m, l, o);
            l += __shfl_xor(l, 16); l += __shfl_xor(l, 32);
            const int ql = 16 * tau + c, qp = ql + (ql >> 4);
#pragma unroll
            for (int mm = 0; mm < 4; ++mm) *(LAS f32x4*)(F.lds + AT_OST + (mm * 4 + g) * AT_OST_CH + qp * 16) = o[mm];
            if (g == 0) { *(LAS float*)(F.lds + AT_ML + ql * 4) = m; *(LAS float*)(F.lds + AT_ML + 1024 + ql * 4) = l; }
        }
        __syncthreads();
#pragma unroll 1
        for (int qi = 0; qi < 2; ++qi) {
            const int d = 2 * wave + qi; const int qpos = 256 * u + 16 * c + d;
            const int ql = 16 * c + d, qp = ql + (ql >> 4);
            float m = *(const LAS float*)(F.lds + AT_ML + ql * 4), l = (g == 0) ? *(const LAS float*)(F.lds + AT_ML + 1024 + ql * 4) : 0.f; f32x4 o[4];
#pragma unroll
            for (int mm = 0; mm < 4; ++mm) o[mm] = *(const LAS f32x4*)(F.lds + AT_OST + (mm * 4 + g) * AT_OST_CH + qp * 16);
            attn_qtile(projb, h, qpos, 64 * u + 4 * c + (d >> 2), 64 * u + 60 + (d >> 2) - 191, 6, 4, d & 3, biasl + BIAS_LD, vbuf, lane, m, l, o);
            attn_qtile(projb, h, qpos, 16 * u + c, 16 * u - 144, 5, 16, d, biasl + 2 * BIAS_LD, vbuf, lane, m, l, o);
            l += __shfl_xor(l, 16); l += __shfl_xor(l, 32);
            const float inv = 1.0f / l;
            bf16_t* op = ycat + ((size_t)b * SEQ + qpos) * DM + 512 + h * 64 + 4 * g;
#pragma unroll
            for (int mm = 0; mm < 4; ++mm) { u32x2 w; w.x = pk2(o[mm][0] * inv, o[mm][1] * inv); w.y = pk2(o[mm][2] * inv, o[mm][3] * inv); *(u32x2*)(op + 16 * mm) = w; }
        }
        __syncthreads();
    }
}

__device__ __forceinline__ void ph_ln1_router(Frame& F) {
    const int gw = F.vcu * NWAVES + F.wave, NGW = F.G * NWAVES, lane = F.lane;
    LAS float* wrt = (LAS float*)(F.lds);
    for (int idx = F.tid; idx < 36 * 1024; idx += 512) { const int cc = idx >> 10, k = idx & 1023;
        wrt[idx] = (cc < 4) ? F.in[I_RG][k * 4 + cc] : F.in[I_RE][k * 32 + (cc - 4)]; }
    if (F.tid < 32) F.MISC[MW_HIST + F.tid] = 0u;
    __syncthreads();
    float* x1 = (float*)(F.ws + WS_X1); bf16_t* x1b = (bf16_t*)(F.ws + WS_Y);
    int* toke = (int*)(F.ws + WS_TOKE); float* tokw = (float*)(F.ws + WS_TOKW);
    f32x4 gv[4], bv[4];
#pragma unroll
    for (int j = 0; j < 4; ++j) { gv[j] = *(const f32x4*)(F.in[I_LN1G] + 4 * lane + 256 * j); bv[j] = *(const f32x4*)(F.in[I_LN1B] + 4 * lane + 256 * j); }
    for (int row = gw; row < NTOK; row += NGW) {
        f32x4 v[4]; float s = 0.f;
        float* xr = x1 + (size_t)row * DM + 4 * lane;
#pragma unroll
        for (int j = 0; j < 4; ++j) { v[j] = *(const f32x4*)(xr + 256 * j); s += (v[j][0] + v[j][1]) + (v[j][2] + v[j][3]); }
        const float mean = wave_sum(s) * (1.0f / DM); float s2 = 0.f;
#pragma unroll
        for (int j = 0; j < 4; ++j) { v[j] = v[j] - mean; s2 += (v[j][0] * v[j][0] + v[j][1] * v[j][1]) + (v[j][2] * v[j][2] + v[j][3] * v[j][3]); }
        const float rstd = rsqrtf(wave_sum(s2) * (1.0f / DM) + LN_EPS);
#pragma unroll
        for (int j = 0; j < 4; ++j) { v[j] = v[j] * rstd * gv[j] + bv[j]; *(f32x4*)(xr + 256 * j) = v[j];
            u32x2 w; w.x = pk2(v[j][0], v[j][1]); w.y = pk2(v[j][2], v[j][3]); *(u32x2*)(x1b + (size_t)row * DM + 4 * lane + 256 * j) = w; }
        float lg[36];
#pragma unroll
        for (int cc = 0; cc < 36; ++cc) { float a = 0.f;
#pragma unroll
            for (int j = 0; j < 4; ++j) { const f32x4 w4 = *(const LAS f32x4*)(wrt + cc * 1024 + 4 * lane + 256 * j); a += v[j][0] * w4[0] + v[j][1] * w4[1] + v[j][2] * w4[2] + v[j][3] * w4[3]; }
            lg[cc] = wave_sum(a); }
        float gl[4];
#pragma unroll
        for (int i = 0; i < 4; ++i) gl[i] = lg[i] + F.in[I_RGB][i];
        int grp = 0; float gm = gl[0];
#pragma unroll
        for (int i = 1; i < 4; ++i) if (gl[i] > gm) { gm = gl[i]; grp = i; }
        float se = 0.f;
#pragma unroll
        for (int i = 0; i < 4; ++i) se += __expf(gl[i] - gm);
        const float wg = 1.0f / se;
        float le[8];
#pragma unroll
        for (int i = 0; i < 8; ++i) { float vsel = lg[4 + i];
#pragma unroll
            for (int gq = 1; gq < 4; ++gq) vsel = (grp == gq) ? lg[4 + gq * 8 + i] : vsel;
            le[i] = vsel + F.in[I_REB][grp * 8 + i]; }
        int i0 = 0; float v0 = le[0];
#pragma unroll
        for (int i = 1; i < 8; ++i) if (le[i] > v0) { v0 = le[i]; i0 = i; }
        int i1 = -1; float v1 = -3.0e38f;
#pragma unroll
        for (int i = 0; i < 8; ++i) if (i != i0 && le[i] > v1) { v1 = le[i]; i1 = i; }
        const float e1 = __expf(v1 - v0); const float w0 = wg / (1.0f + e1), w1 = wg * e1 / (1.0f + e1);
        const int ex0 = grp * 8 + i0, ex1 = grp * 8 + i1;
        if (lane == 0) { toke[2 * row] = ex0; toke[2 * row + 1] = ex1; tokw[2 * row] = w0; tokw[2 * row + 1] = w1;
            atomicAdd((unsigned*)&F.MISC[MW_HIST + ex0], 1u); atomicAdd((unsigned*)&F.MISC[MW_HIST + ex1], 1u); }
    }
    __syncthreads();
    if (F.tid < 32) { const unsigned hc = F.MISC[MW_HIST + F.tid]; if (hc) atomicAdd(F.ctl + CW_CNT + F.tid, hc); }
}

__device__ __forceinline__ void ph_positions(Frame& F) {
    int* toke = (int*)(F.ws + WS_TOKE); float* tokw = (float*)(F.ws + WS_TOKW);
    int* row_tok = (int*)(F.ws + WS_ROWTOK); int* row_asg = (int*)(F.ws + WS_ROWASG); float* row_w = (float*)(F.ws + WS_ROWW);
    if (F.tid < 32) { F.MISC[MW_CNT + F.tid] = __hip_atomic_load(F.ctl + CW_CNT + F.tid, RLX_AGENT); F.MISC[MW_HIST + F.tid] = 0u; F.MISC[MW_LFILL + F.tid] = 0u; }
    __syncthreads();
    if (F.tid == 0) {
        unsigned rs = 0;
        for (int e = 0; e < 32; ++e) { F.MISC[MW_RS + e] = rs; const unsigned nt = (F.MISC[MW_CNT + e] + 255u) >> 8;
            if (blockIdx.x == 0) { for (unsigned q = 0; q < nt; ++q) F.ctl[CW_TILEE + (rs >> 8) + q] = (unsigned)e; }
            rs += nt << 8; }
        if (blockIdx.x == 0) F.ctl[CW_NTILES] = rs >> 8;
    }
    __syncthreads();
    const int per = (NTOK + F.G - 1) / F.G;
    const int base = F.vcu * per;
    for (int a0 = 0; a0 < 2 * per; a0 += 512) {
        const int a = a0 + F.tid; const int tok = base + (a >> 1), j = a & 1; const bool ok = (a < 2 * per) && (tok < NTOK);
        int e = 0; if (ok) { e = toke[2 * tok + j]; atomicAdd((unsigned*)&F.MISC[MW_HIST + e], 1u); }
        __syncthreads();
        if (F.tid < 32) { const unsigned hc = F.MISC[MW_HIST + F.tid]; F.MISC[MW_LBASE + F.tid] = hc ? atomicAdd(F.ctl + CW_FILL + F.tid, hc) : 0u; }
        __syncthreads();
        if (ok) { const unsigned pos = F.MISC[MW_RS + e] + F.MISC[MW_LBASE + e] + atomicAdd((unsigned*)&F.MISC[MW_LFILL + e], 1u);
            row_tok[pos] = tok; row_asg[pos] = 2 * tok + j; row_w[pos] = tokw[2 * tok + j]; }
        __syncthreads();
        if (F.tid < 32) { F.MISC[MW_HIST + F.tid] = 0u; F.MISC[MW_LFILL + F.tid] = 0u; }
        __syncthreads();
    }
    if (F.vcu < 32) { const int e = F.vcu; const unsigned cnt = F.MISC[MW_CNT + e], rs = F.MISC[MW_RS + e], end = ((cnt + 255u) >> 8) << 8;
        for (unsigned r = cnt + F.tid; r < end; r += 512) { row_tok[rs + r] = 0; row_asg[rs + r] = -1; row_w[rs + r] = 0.f; } }
}

__device__ __forceinline__ void ph_final(Frame& F) {
    const int gw = F.vcu * NWAVES + F.wave, NGW = F.G * NWAVES, lane = F.lane;
    const float* x1 = (const float*)(F.ws + WS_X1); const bf16_t* lo = (const bf16_t*)(F.ws + WS_Y); const bf16_t* hi = (const bf16_t*)(F.ws + WS_MOEHI);
    f32x4 gv[4], bv[4];
#pragma unroll
    for (int j = 0; j < 4; ++j) { gv[j] = *(const f32x4*)(F.in[I_LN2G] + 4 * lane + 256 * j); bv[j] = *(const f32x4*)(F.in[I_LN2B] + 4 * lane + 256 * j); }
    for (int row = gw; row < NTOK; row += NGW) {
        const bf16_t* m0 = (row < 16384) ? lo + (size_t)(2 * row) * DM : hi + (size_t)(2 * row - 32768) * DM;
        f32x4 v[4]; float s = 0.f;
#pragma unroll
        for (int j = 0; j < 4; ++j) { const int cix = 4 * lane + 256 * j;
            const f32x4 xv = *(const f32x4*)(x1 + (size_t)row * DM + cix), pv = *(const f32x4*)(F.out + (size_t)row * DM + cix);
            const u32x2 a = *(const u32x2*)(m0 + cix), b = *(const u32x2*)(m0 + DM + cix);
            f32x4 mv; mv[0] = bf_lo(a.x) + bf_lo(b.x); mv[1] = bf_hi(a.x) + bf_hi(b.x); mv[2] = bf_lo(a.y) + bf_lo(b.y); mv[3] = bf_hi(a.y) + bf_hi(b.y);
            v[j] = xv * ALPHA + mv + pv; s += (v[j][0] + v[j][1]) + (v[j][2] + v[j][3]); }
        const float mean = wave_sum(s) * (1.0f / DM); float s2 = 0.f;
#pragma unroll
        for (int j = 0; j < 4; ++j) { v[j] = v[j] - mean; s2 += (v[j][0] * v[j][0] + v[j][1] * v[j][1]) + (v[j][2] * v[j][2] + v[j][3] * v[j][3]); }
        const float rstd = rsqrtf(wave_sum(s2) * (1.0f / DM) + LN_EPS);
#pragma unroll
        for (int j = 0; j < 4; ++j) *(f32x4*)(F.out + (size_t)row * DM + 4 * lane + 256 * j) = v[j] * rstd * gv[j] + bv[j];
    }
}

constexpr int NPHASE = 12;
struct Args { const float* in[33]; float* out; unsigned char* ws; int ph_lo, ph_hi; };
#ifndef PH_MASK
#define PH_MASK 0xfff
#endif
__global__ void __launch_bounds__(NWAVES * 64, 2) hymba_fwd(const Args args) {
    extern __shared__ __attribute__((aligned(16))) unsigned char lds[];
    Frame F;
    F.lds = (LAS unsigned char*)lds;
    F.MISC = (volatile LAS unsigned*)(F.lds + MISC_OFF);
    F.tid = threadIdx.x; F.lane = F.tid & 63; F.wave = __builtin_amdgcn_readfirstlane(F.tid >> 6);
    F.G = gridDim.x; { const int bx = blockIdx.x; F.vcu = (F.G % 8 == 0) ? (bx % 8) * (F.G / 8) + bx / 8 : bx; }
    F.ws = args.ws; F.ctl = (unsigned*)(args.ws + WS_CTL); F.out = args.out;
    F.in = args.in;
    for (int u = F.tid; u < (LDS_BYTES - LDSCTL_OFF) / 4; u += NWAVES * 64) ((LAS unsigned*)(F.lds + LDSCTL_OFF))[u] = 0u;
    __syncthreads();
    const int lo = args.ph_lo, hi = args.ph_hi;
    XcdBarrier bar; bar.bar = F.ctl + CW_BAR; bar.x = 0; bar.st = nullptr;
    if (hi - lo > 1) bar = xcd_barrier_post(F.ctl + CW_BAR, F.MISC + MW_BAR);
#define IN(k) (((PH_MASK >> (k)) & 1) && lo <= (k) && (k) < hi)
#define SEAM(k) do { if (IN(k) && IN((k) + 1)) xcd_barrier(bar); } while (0)
    LAS unsigned char* ring = F.lds + RING_OFF;

    if (IN(0)) { ph_prologue(F); } SEAM(0);
    if (IN(1)) {
        pg8::Gemm g{(const bf16_t*)(F.ws + WS_XB), (const bf16_t*)(F.ws + WS_WINT), DM}; pg8::StaticOrder S; S.init(NTOK, NEXT, F.G, (int)blockIdx.x);
        EpiProj E{(bf16_t*)(F.ws + WS_P), (float*)(F.ws + WS_LORA1)};
        pg8::gemm_phase<EpiProj, pg8::StaticOrder>(ring, g, S, E);
    } SEAM(1);
    if (IN(2)) { ph_lora_act(F); } SEAM(2);
    if (IN(3)) {
        pg8::Gemm g{(const bf16_t*)(F.ws + WS_Y), (const bf16_t*)(F.ws + WS_W2T), KL2}; pg8::StaticOrder S; S.init(NTOK, NL2, F.G, (int)blockIdx.x);
        EpiDag E{(float*)(F.ws + WS_LW), (bf16_t*)(F.ws + WS_AG), F.in[I_W0], F.in[I_A0]};
        pg8::gemm_phase<EpiDag, pg8::StaticOrder>(ring, g, S, E);
    } SEAM(3);
    #ifdef SCAN_SIMPLE
    if (IN(4)) { ph_scan_simple(F); ph_attn_simple(F); } SEAM(4);
#else
#ifdef ATTN_SIMPLE
    if (IN(4)) { ph_scan_chunk(F); ph_attn_simple(F); } SEAM(4);
#else
    if (IN(4)) { ph_scan_chunk(F); ph_attn_mfma(F); } SEAM(4);
#endif
#endif
    if (IN(5)) {
        pg8::Gemm g{(const bf16_t*)(F.ws + WS_Y), (const bf16_t*)(F.ws + WS_WOT), DM}; pg8::StaticOrder S; S.init(NTOK, DM, F.G, (int)blockIdx.x);
        EpiWo E{F.in[I_X], (float*)(F.ws + WS_X1)};
        pg8::gemm_phase<EpiWo, pg8::StaticOrder>(ring, g, S, E);
    } SEAM(5);
    if (IN(6)) { ph_moe_weights(F); __syncthreads(); ph_ln1_router(F); } SEAM(6);
    if (IN(7)) { ph_positions(F); } SEAM(7);
    if (IN(8)) {
        {
            pg8::MoeOrder<true> S{(const int*)(F.ctl + CW_TILEE), (const int*)(F.ws + WS_ROWTOK), (int)__hip_atomic_load(F.ctl + CW_NTILES, RLX_AGENT), F.G, F.vcu};
            pg8::Gemm g{(const bf16_t*)(F.ws + WS_Y), (const bf16_t*)(F.ws + WS_WGUT), DM};
            EpiGU E{(bf16_t*)(F.ws + WS_HDN)};
            pg8::gemm_phase<EpiGU, pg8::MoeOrder<true>>(ring, g, S, E);
        }
    } SEAM(8);
    if (IN(9)) {
        {
            pg8::Gemm g{(const bf16_t*)(F.ws + WS_PB), (const bf16_t*)(F.ws + WS_PT), 256}; pg8::StaticOrder S; S.init(NTOK, DM, F.G, (int)blockIdx.x);
            EpiF32 E{F.out, DM};
            pg8::gemm_phase<EpiF32, pg8::StaticOrder>(ring, g, S, E);
        }
        {
            pg8::Gemm g{(const bf16_t*)(F.ws + WS_Y), (const bf16_t*)(F.ws + WS_GT), DM}; pg8::StaticOrder S; S.init(NTOK, DM, F.G, (int)blockIdx.x);
            EpiPle E{F.out, DM};
            pg8::gemm_phase<EpiPle, pg8::StaticOrder>(ring, g, S, E);
        }
    } SEAM(9);
    if (IN(10)) {
        pg8::MoeOrder<false> S{(const int*)(F.ctl + CW_TILEE), (const int*)(F.ws + WS_ROWTOK), (int)__hip_atomic_load(F.ctl + CW_NTILES, RLX_AGENT), F.G, F.vcu};
        pg8::Gemm g{(const bf16_t*)(F.ws + WS_HDN), (const bf16_t*)(F.ws + WS_WDT), DEXP};
        EpiDown E{(bf16_t*)(F.ws + WS_Y), (bf16_t*)(F.ws + WS_MOEHI), (const int*)(F.ws + WS_ROWASG), (const float*)(F.ws + WS_ROWW)};
        pg8::gemm_phase<EpiDown, pg8::MoeOrder<false>>(ring, g, S, E);
    } SEAM(10);
    if (IN(11)) { ph_final(F); }
#undef IN
#undef SEAM
}

extern "C" void kernel_launch(void* const* d_in, const int* in_sizes, int n_in, void* d_out, int out_size, void* d_ws, size_t ws_size, hipStream_t stream) {
    static int grid = 0;
    if (grid == 0) {
        if (n_in != 33 || in_sizes[0] != NTOK * DM || out_size != NTOK * DM || ws_size < WS_END) { fprintf(stderr, "kernel_launch: unexpected problem (n_in %d, in0 %d, out %d, ws %zu)\n", n_in, n_in > 0 ? in_sizes[0] : -1, out_size, ws_size); grid = -1; return; }
        int dev = 0, cus = 0;
        if (hipGetDevice(&dev) != hipSuccess || hipDeviceGetAttribute(&cus, hipDeviceAttributeMultiprocessorCount, dev) != hipSuccess) { grid = -1; return; }
        if (hipFuncSetAttribute((const void*)hymba_fwd, hipFuncAttributeMaxDynamicSharedMemorySize, LDS_BYTES) != hipSuccess) { fprintf(stderr, "kernel_launch: hipFuncSetAttribute failed\n"); grid = -1; return; }
        int per_cu = 0;
        if (hipOccupancyMaxActiveBlocksPerMultiprocessor(&per_cu, (const void*)hymba_fwd, NWAVES * 64, LDS_BYTES) != hipSuccess || per_cu < 1) fprintf(stderr, "kernel_launch: occupancy query reports %d\n", per_cu);
        (void)hipGetLastError();
        grid = cus;
    }
    if (grid < 0) return;
    if (hipMemsetAsync((char*)d_ws + WS_CTL, 0, CTL_ZERO_BYTES, stream) != hipSuccess) return;
    Args a{};
    for (int i = 0; i < 33; ++i) a.in[i] = (const float*)d_in[i];
    a.out = (float*)d_out; a.ws = (unsigned char*)d_ws;
#if MK_ONE_LAUNCH
    a.ph_lo = 0; a.ph_hi = NPHASE;
    hipLaunchKernelGGL(hymba_fwd, dim3(grid), dim3(NWAVES * 64), LDS_BYTES, stream, a);
#else
    for (int ph = 0; ph < NPHASE; ++ph) { a.ph_lo = ph; a.ph_hi = ph + 1; hipLaunchKernelGGL(hymba_fwd, dim3(grid), dim3(NWAVES * 64), LDS_BYTES, stream, a); }
#endif
}
```

```cpp
#include <hip/hip_runtime.h>
#include <cstdio>
#include <cstdint>

#ifndef MK_ONE_LAUNCH
#define MK_ONE_LAUNCH 1
#endif

#define GAS __attribute__((address_space(1)))
#define LAS __attribute__((address_space(3)))
typedef unsigned short bf16_t;
typedef short bf16x8 __attribute__((ext_vector_type(8)));
typedef float f32x4 __attribute__((ext_vector_type(4)));
typedef float f32x2 __attribute__((ext_vector_type(2)));
typedef unsigned u32x4 __attribute__((ext_vector_type(4)));
typedef unsigned u32x2 __attribute__((ext_vector_type(2)));
#define RLX_AGENT __ATOMIC_RELAXED, __HIP_MEMORY_SCOPE_AGENT
#define LDS_WAIT() asm volatile("s_waitcnt lgkmcnt(0)" ::: "memory")
#define VM_WAIT() asm volatile("s_waitcnt vmcnt(0)" ::: "memory")

__device__ __forceinline__ unsigned f2bf(float f) { unsigned u = __builtin_bit_cast(unsigned, f); return (u + 0x7fffu + ((u >> 16) & 1u)) >> 16; }
__device__ __forceinline__ unsigned pk2(float lo, float hi) { return f2bf(lo) | (f2bf(hi) << 16); }
typedef __bf16 bf16v2_t __attribute__((ext_vector_type(2)));
__device__ __forceinline__ unsigned cvt2(float lo, float hi) { bf16v2_t v; v.x = (__bf16)lo; v.y = (__bf16)hi; return __builtin_bit_cast(unsigned, v); }
__device__ __forceinline__ float bf_lo(unsigned w) { return __builtin_bit_cast(float, w << 16); }
__device__ __forceinline__ float bf_hi(unsigned w) { return __builtin_bit_cast(float, w & 0xffff0000u); }
__device__ __forceinline__ float bf2f(bf16_t b) { return __builtin_bit_cast(float, ((unsigned)b) << 16); }
__device__ __forceinline__ float sigmoidf_(float z) { return __builtin_amdgcn_rcpf(1.0f + __builtin_amdgcn_exp2f(-1.4426950408889634f * z)); }
__device__ __forceinline__ float wave_sum(float v) {
#pragma unroll
    for (int o = 1; o < 64; o <<= 1) v += __shfl_xor(v, o);
    return v;
}

namespace pg8 {
constexpr int BM = 256, BK = 64, HALF = 128, HTB = HALF * BK * 2, STAGE_BYTES = 8 * HTB, NXCD = 8, WGM = 8;
__host__ __device__ __forceinline__ int lds_byte(int r, int c) { const int st = (r >> 4) * 2 + (c >> 5), rr = r & 15, cc = c & 31, ob = rr * 64 + cc * 2; return st * 1024 + (ob ^ (((ob >> 9) & 1) << 5)); }
__host__ __device__ __forceinline__ void stage_rc(int b, int& R, int& C) { const int st = b / 1024, sb = b % 1024, swz = sb ^ (((sb >> 9) & 1) << 5); R = (st >> 1) * 16 + swz / 64; C = (st & 1) * 32 + (swz % 64) / 2; }
__host__ __device__ __forceinline__ int perm32(int rho) { const int n = rho >> 4, i = rho & 15; return 8 * (i >> 2) + 4 * n + (i & 3); }

struct Unit { int pm, pn, pb; };
struct Gemm { const bf16_t* A; const bf16_t* Bt; int K; };

struct StaticOrder {
    static constexpr bool GATHER = false;
    int nM, nN, nwg, G, c;
    __device__ void init(int M, int N, int G_, int c_) { nM = M / BM; nN = N / BM; nwg = nM * nN; G = G_; c = c_; }
    __device__ bool next(int i, Unit& u) const {
        const long L = (long)i * G + c; if (L >= nwg) return false;
        int wgid = (int)L; { const int q = nwg / NXCD, r = nwg % NXCD, xcd = wgid % NXCD, off = wgid / NXCD; wgid = (xcd < r ? xcd * (q + 1) : r * (q + 1) + (xcd - r) * q) + off; }
        const int nig = WGM * nN, gid = wgid / nig, fm = gid * WGM, gsz = (nM - fm) < WGM ? (nM - fm) : WGM;
        u.pm = fm + ((wgid % nig) % gsz); u.pn = (wgid % nig) / gsz; u.pb = u.pn; return true;
    }
    __device__ __forceinline__ unsigned a_row_off(const Unit&, int, unsigned) const { return 0u; }
    __device__ __forceinline__ int koff(const Unit&) const { return 0; }
    __device__ __forceinline__ int ntk(const Unit&, int nt_full) const { return nt_full; }
};
struct LoraOrder : StaticOrder {
    __device__ __forceinline__ int koff(const Unit& u) const { return u.pn >= 4 ? 128 : 0; }
    __device__ __forceinline__ int ntk(const Unit& u, int) const { return 2 + ((u.pn >> 6) << 1); }
};
template <bool GATHER_> struct MoeOrder {
    static constexpr bool GATHER = GATHER_;
    const int* tile_e; const int* row_tok; int ntiles, G, c;
    __device__ bool next(int i, Unit& u) const {
        const long L = (long)i * G + c; if (L >= (long)ntiles * 4) return false;
        const int tile = (int)(L >> 2), pn = (int)(L & 3);
        u.pm = tile; u.pn = pn; u.pb = tile_e[tile] * 4 + pn; return true;
    }
    __device__ __forceinline__ unsigned a_row_off(const Unit& u, int r, unsigned rowbytes) const { return (unsigned)row_tok[u.pm * 256 + r] * rowbytes; }
    __device__ __forceinline__ int koff(const Unit&) const { return 0; }
    __device__ __forceinline__ int ntk(const Unit&, int nt_full) const { return nt_full; }
};

struct MoeDownOrder {
    static constexpr bool GATHER = false;
    const int* tile_e; int ntiles, G, vcu;
    __device__ bool next(int i, Unit& u) const {
        const int NU = ntiles * 4, rem = NU % G, nB = G - rem; long d;
        if (vcu >= rem) { const int ib = vcu - rem; d = (i < 2) ? (long)i * nB + ib : 2L * nB + (long)(i - 2) * G + ib; }
        else d = 2L * nB + (long)i * G + nB + vcu;
        if (d >= NU) return false;
        const int tile = (int)(d >> 2), pn = (int)(d & 3);
        u.pm = tile; u.pn = pn; u.pb = tile_e[tile] * 4 + pn; return true;
    }
    __device__ __forceinline__ unsigned a_row_off(const Unit&, int, unsigned) const { return 0u; }
    __device__ __forceinline__ int koff(const Unit&) const { return 0; }
    __device__ __forceinline__ int ntk(const Unit&, int nt_full) const { return nt_full; }
};

__device__ __forceinline__ unsigned cvt_pk_bf16(float lo, float hi) { unsigned r; asm volatile("v_cvt_pk_bf16_f32 %0, %1, %2" : "=v"(r) : "v"(lo), "v"(hi)); return r; }

template <class Epi, class Sched>
__device__ __forceinline__ void gemm_phase(LAS unsigned char* lds, const Gemm g, const Sched& S, const Epi& E) {
    const int tid = threadIdx.x, wid = __builtin_amdgcn_readfirstlane(tid >> 6), lane = tid & 63, wr = wid >> 2, wc = wid & 3, fr = lane & 15, fq = lane >> 4;
    const int K = g.K, nt_full = K / BK;
    int Rr[2], Cc[2];
    unsigned voffB[2];
#pragma unroll
    for (int i = 0; i < 2; ++i) { int R, C; stage_rc(tid * 16 + i * 8192, R, C); const int Rb = Epi::PERM ? ((R & ~31) + perm32(R & 31)) : R;
        Rr[i] = R; Cc[i] = C; voffB[i] = (unsigned)(Rb * K + C) * 2u; }
    const unsigned rowbytes = (unsigned)K * 2u;
    const size_t kstep = (size_t)(BK * 2);
    const size_t hstep = (size_t)HALF * K * 2;
    const size_t tstep = 2 * hstep;
    const unsigned ldsw = (unsigned)wid * 1024u;
    const int aoff = lds_byte(wr * 64 + fr, fq * 8), boff = lds_byte(wc * 32 + fr, fq * 8);
#define PG8_SA(b, h) (((b) * 2 + (h)) * HTB)
#define PG8_SB(b, h) ((4 + (b) * 2 + (h)) * HTB)
#define PG8_STAGE(bufoff, gbase, voff) do { _Pragma("unroll") for (int _i = 0; _i < 2; ++_i) \
        __builtin_amdgcn_global_load_lds((const unsigned*)((const char*)(gbase) + (voff)[_i]), (LAS unsigned*)(lds + (bufoff) + ldsw + _i * 8192), 16, 0, 0); } while (0)
#define PG8_STAGE_A(bufoff, gbase, vv, h) do { _Pragma("unroll") for (int _i = 0; _i < 2; ++_i) \
        __builtin_amdgcn_global_load_lds((const unsigned*)((const char*)(gbase) + (vv)[h][_i]), (LAS unsigned*)(lds + (bufoff) + ldsw + _i * 8192), 16, 0, 0); } while (0)
#define PG8_LDA(dst, b, h) do { _Pragma("unroll") for (int m = 0; m < 4; ++m) _Pragma("unroll") for (int k = 0; k < 2; ++k) dst[m][k] = *(const LAS bf16x8*)(lds + PG8_SA(b, h) + aoff + m * 2048 + k * 1024); } while (0)
#define PG8_LDB(dst, b, h) do { _Pragma("unroll") for (int n = 0; n < 2; ++n) _Pragma("unroll") for (int k = 0; k < 2; ++k) dst[n][k] = *(const LAS bf16x8*)(lds + PG8_SB(b, h) + boff + n * 2048 + k * 1024); } while (0)
#define PG8_MMA(ai, bj, At, Bt) do { __builtin_amdgcn_s_setprio(1); _Pragma("unroll") for (int m = 0; m < 4; ++m) _Pragma("unroll") for (int n = 0; n < 2; ++n) _Pragma("unroll") for (int k = 0; k < 2; ++k) \
        acc[ai][bj][m][n] = __builtin_amdgcn_mfma_f32_16x16x32_bf16(Bt[n][k], At[m][k], acc[ai][bj][m][n], 0, 0, 0); __builtin_amdgcn_s_setprio(0); } while (0)
#define PG8_WAIT_V(n) asm volatile("s_waitcnt vmcnt(" #n ")" ::: "memory")
#define PG8_WAIT_L(n) asm volatile("s_waitcnt lgkmcnt(" #n ")" ::: "memory")
#define PG8_BAR __builtin_amdgcn_s_barrier()
#define PG8_SCHED __builtin_amdgcn_sched_barrier(0)
#define PG8_SETOFF(vv, uu) do { _Pragma("unroll") for (int _h = 0; _h < 2; ++_h) _Pragma("unroll") for (int _i = 0; _i < 2; ++_i) { \
        if constexpr (Sched::GATHER) (vv)[_h][_i] = S.a_row_off((uu), _h * HALF + Rr[_i], rowbytes) + (unsigned)Cc[_i] * 2u; \
        else (vv)[_h][_i] = (unsigned)((_h * HALF + Rr[_i]) * K + Cc[_i]) * 2u; } } while (0)
    Unit cur, nxt; int ui = 0;
    if (!S.next(0, cur)) return;
    f32x4 acc[2][2][4][2];
#pragma unroll
    for (int a = 0; a < 2; ++a)
#pragma unroll
        for (int b = 0; b < 2; ++b)
#pragma unroll
            for (int m = 0; m < 4; ++m)
#pragma unroll
                for (int n = 0; n < 2; ++n) acc[a][b][m][n] = (f32x4){0.f, 0.f, 0.f, 0.f};
    bf16x8 At[4][2], B0[2][2], B1[2][2];
    unsigned vAc[2][2], vAn[2][2];
    PG8_SETOFF(vAc, cur);
    const char* cA = (Sched::GATHER ? (const char*)g.A : (const char*)g.A + (size_t)cur.pm * tstep) + (size_t)S.koff(cur) * 2;
    const char* cB = (const char*)g.Bt + (size_t)cur.pb * tstep + (size_t)S.koff(cur) * 2;
    int nt = S.ntk(cur, nt_full);
    PG8_STAGE(PG8_SB(0, 0), cB, voffB); PG8_STAGE(PG8_SB(0, 1), cB + hstep, voffB); PG8_STAGE_A(PG8_SA(0, 0), cA, vAc, 0); PG8_STAGE_A(PG8_SA(0, 1), cA, vAc, 1);
    if (wr == 1) PG8_BAR;
    PG8_WAIT_V(2); PG8_BAR;
    PG8_STAGE(PG8_SB(1, 0), cB + kstep, voffB); PG8_STAGE_A(PG8_SA(1, 0), cA + kstep, vAc, 0); PG8_STAGE(PG8_SB(1, 1), cB + hstep + kstep, voffB);
    PG8_WAIT_V(6); PG8_BAR;
    for (;;) {
        const bool has_next = S.next(ui + 1, nxt);
        const char* nA = cA; const char* nB = cB;
        if (has_next) { nA = (Sched::GATHER ? (const char*)g.A : (const char*)g.A + (size_t)nxt.pm * tstep) + (size_t)S.koff(nxt) * 2; nB = (const char*)g.Bt + (size_t)nxt.pb * tstep + (size_t)S.koff(nxt) * 2; }
        if constexpr (Sched::GATHER) {
            if (has_next) { PG8_SETOFF(vAn, nxt); }
            else {
#pragma unroll
                for (int h = 0; h < 2; ++h)
#pragma unroll
                    for (int i = 0; i < 2; ++i) vAn[h][i] = vAc[h][i];
            }
        }
#pragma unroll 1
        for (int t = 0; t < nt; t += 2) {
            const bool last = (t == nt - 2);
            const char* a1 = cA + (size_t)(t + 1) * kstep;
            const char* a2 = last ? nA : cA + (size_t)(t + 2) * kstep; const char* b2 = last ? nB : cB + (size_t)(t + 2) * kstep;
            const char* a3 = a2 + kstep; const char* b3 = b2 + kstep;
            unsigned vs[2][2];
#pragma unroll
            for (int h = 0; h < 2; ++h)
#pragma unroll
                for (int i = 0; i < 2; ++i) { if constexpr (Sched::GATHER) vs[h][i] = last ? vAn[h][i] : vAc[h][i]; else vs[h][i] = vAc[h][i]; }
            PG8_LDB(B0, 0, 0); PG8_LDB(B1, 0, 1); PG8_SCHED; PG8_LDA(At, 0, 0); PG8_STAGE_A(PG8_SA(1, 1), a1, vAc, 1);
            PG8_WAIT_V(8); PG8_WAIT_L(0); PG8_BAR; PG8_MMA(0, 0, At, B0); PG8_MMA(0, 1, At, B1); PG8_BAR; PG8_SCHED;
            PG8_LDA(At, 0, 1); PG8_STAGE(PG8_SB(0, 0), b2, voffB); PG8_STAGE(PG8_SB(0, 1), b2 + hstep, voffB); PG8_STAGE_A(PG8_SA(0, 0), a2, vs, 0);
            PG8_WAIT_V(8); PG8_WAIT_L(0); PG8_BAR; PG8_MMA(1, 0, At, B0); PG8_MMA(1, 1, At, B1); PG8_BAR; PG8_SCHED;
            PG8_LDB(B0, 1, 0); PG8_LDB(B1, 1, 1); PG8_SCHED; PG8_LDA(At, 1, 0); PG8_STAGE_A(PG8_SA(0, 1), a2, vs, 1);
            PG8_WAIT_V(8); PG8_WAIT_L(0); PG8_BAR; PG8_MMA(0, 0, At, B0); PG8_MMA(0, 1, At, B1); PG8_BAR; PG8_SCHED;
            PG8_LDA(At, 1, 1); PG8_STAGE(PG8_SB(1, 0), b3, voffB); PG8_STAGE(PG8_SB(1, 1), b3 + hstep, voffB); PG8_STAGE_A(PG8_SA(1, 0), a3, vs, 0);
            PG8_WAIT_V(8); PG8_WAIT_L(0); PG8_BAR; PG8_MMA(1, 0, At, B0); PG8_MMA(1, 1, At, B1); PG8_BAR; PG8_SCHED;
        }
        if (wr == 0) PG8_BAR;
        E(acc, cur, wr, wc, fr, fq);
        if (!has_next) break;
#pragma unroll
        for (int a = 0; a < 2; ++a)
#pragma unroll
            for (int b = 0; b < 2; ++b)
#pragma unroll
                for (int m = 0; m < 4; ++m)
#pragma unroll
                    for (int n = 0; n < 2; ++n) acc[a][b][m][n] = (f32x4){0.f, 0.f, 0.f, 0.f};
        cur = nxt; cA = nA; cB = nB; ++ui; nt = S.ntk(cur, nt_full);
        if constexpr (Sched::GATHER) {
#pragma unroll
            for (int h = 0; h < 2; ++h)
#pragma unroll
                for (int i = 0; i < 2; ++i) vAc[h][i] = vAn[h][i];
        }
        if (wr == 1) PG8_BAR;
    }
    PG8_WAIT_V(0);
    PG8_BAR;
#undef PG8_SA
#undef PG8_SB
#undef PG8_STAGE
#undef PG8_STAGE_A
#undef PG8_LDA
#undef PG8_LDB
#undef PG8_MMA
#undef PG8_WAIT_V
#undef PG8_WAIT_L
#undef PG8_BAR
#undef PG8_SCHED
#undef PG8_SETOFF
}
}

#define XB_TMO      128
#define XB_XCNT(j)  (256  + 64 * (j))
#define XB_XSUB(j)  (1280 + 64 * (j))
#define XB_XGEN(j)  (2304 + 64 * (j))
#define XB_TOP      3328
#define XB_TOPGEN   3392
#define XCD_BAR_WORDS 3456
#define XB_SPIN_CAP (1u << 18)
__device__ __forceinline__ unsigned xb_ld(unsigned* p)              { return __hip_atomic_load(p, __ATOMIC_RELAXED, __HIP_MEMORY_SCOPE_AGENT); }
__device__ __forceinline__ unsigned xb_add(unsigned* p, unsigned v) { return __hip_atomic_fetch_add(p, v, __ATOMIC_RELAXED, __HIP_MEMORY_SCOPE_AGENT); }
__device__ __forceinline__ unsigned xb_xcc_id() { return (unsigned)__builtin_amdgcn_s_getreg((3 << 11) | 20) & 0xFu; }
#define XB_SPIN(cond, bar) do { unsigned _sp = 0; while (cond) { __builtin_amdgcn_s_sleep(1); \
    if ((++_sp & 255u) == 0u) { if (xb_ld(&(bar)[XB_TMO])) break; if (_sp > XB_SPIN_CAP) { atomicAdd(&(bar)[XB_TMO], 1u); break; } } } } while (0)
struct XcdBarrier { unsigned* bar; unsigned x; volatile LAS unsigned* st; };
__device__ __forceinline__ XcdBarrier xcd_barrier_post(unsigned* bar, volatile LAS unsigned* st) {
    XcdBarrier b; b.bar = bar; b.x = xb_xcc_id(); b.st = st;
    if (threadIdx.x == 0) (void)xb_add(&bar[XB_XCNT(b.x)], 1u);
    return b;
}
__device__ __forceinline__ void xcd_barrier_complete(unsigned* bar, unsigned x, unsigned& nloc, unsigned& nx) {
    const unsigned G = gridDim.x * gridDim.y * gridDim.z;
    unsigned sum, cnt, mine, sp = 0u;
    for (;;) {
        sum = 0u; cnt = 0u; mine = 0u;
#pragma unroll
        for (unsigned j = 0; j < 16; ++j) { const unsigned c = xb_ld(&bar[XB_XCNT(j)]); sum += c; cnt += (c > 0u) ? 1u : 0u; mine = (j == x) ? c : mine; }
        if (sum == G) break;
        __builtin_amdgcn_s_sleep(1);
        if ((++sp & 255u) == 0u) { if (xb_ld(&bar[XB_TMO])) break; if (sp > XB_SPIN_CAP) { atomicAdd(&bar[XB_TMO], 1u); break; } }
    }
    nloc = mine > 0u ? mine : 1u; nx = cnt > 0u ? cnt : 1u;
}
__device__ __forceinline__ void xcd_barrier(const XcdBarrier& b) {
    asm volatile("s_waitcnt vmcnt(0)" ::: "memory");
    __syncthreads();
    if (threadIdx.x == 0) {
        unsigned* bar = b.bar;
        __builtin_amdgcn_s_waitcnt(0);
        unsigned nloc = b.st[0], nx = b.st[1];
        if (nloc == 0u) { xcd_barrier_complete(bar, b.x, nloc, nx); b.st[0] = nloc; b.st[1] = nx; }
        const unsigned old = xb_add(&bar[XB_XSUB(b.x)], 1u);
        const unsigned gen = old / nloc;
        if (old + 1u == (gen + 1u) * nloc) {
            __builtin_amdgcn_fence(__ATOMIC_RELEASE, "agent");
            asm volatile("s_waitcnt vmcnt(0)" ::: "memory");
            const unsigned og = xb_add(&bar[XB_TOP], 1u);
            const unsigned tg = og / nx;
            if (og + 1u == (tg + 1u) * nx) xb_add(&bar[XB_TOPGEN], 1u);
            else XB_SPIN(xb_ld(&bar[XB_TOPGEN]) == tg, bar);
            __builtin_amdgcn_fence(__ATOMIC_ACQUIRE, "agent");
            xb_add(&bar[XB_XGEN(b.x)], 1u);
            asm volatile("s_waitcnt vmcnt(0)" ::: "memory");
        } else {
            XB_SPIN(xb_ld(&bar[XB_XGEN(b.x)]) == gen, bar);
            __builtin_amdgcn_fence(__ATOMIC_ACQUIRE, "agent");
            asm volatile("s_waitcnt vmcnt(0)" ::: "memory");
        }
    }
    __syncthreads();
}

constexpr int NWAVES = 8;
constexpr int SEQ = 2048, NB = 16, DM = 1024, NTOK = NB * SEQ;
constexpr int DRW = 512, HD = 64;
constexpr int NPROJ = 3072, NEXT = 3584, NL1 = 512, KL2 = 256, NL2 = 1536;
constexpr int NEXP = 32, DEXP = 512;
constexpr int PROWS_MAX = 65536 + 32 * 256, MAXTILES = PROWS_MAX / 256;
constexpr float LN_EPS = 1e-5f, LNX_EPS = 64e-5f, ALPHA = 1.189207115002721f;

constexpr size_t MiB = 1u << 20;
constexpr size_t WS_CTL = 0, CTL_ZERO_BYTES = 65536;
constexpr size_t WS_WINT = 1 * MiB;
constexpr size_t WS_W2T = 8 * MiB;
constexpr size_t WS_WOT = 9 * MiB;
constexpr size_t WS_GT = 11 * MiB;
constexpr size_t WS_PT = 13 * MiB;
constexpr size_t WS_BIAS = 13 * MiB + 512 * 1024;
constexpr size_t WS_WRT = 13 * MiB + 640 * 1024;
constexpr size_t WS_TOKE = 14 * MiB;
constexpr size_t WS_TOKW = 14 * MiB + 256 * 1024;
constexpr size_t WS_ROWTOK = 14 * MiB + 512 * 1024;
constexpr size_t WS_ROWASG = 15 * MiB;
constexpr size_t WS_ROWW = 15 * MiB + 512 * 1024;
constexpr size_t WS_PB = 16 * MiB;
constexpr size_t WS_X1 = 32 * MiB;
constexpr size_t WS_XB = WS_X1, WS_LORA1 = WS_X1 + 64 * MiB;
constexpr size_t WS_LW = WS_X1, WS_AG = WS_X1 + 64 * MiB;
constexpr size_t WS_P = 160 * MiB;
constexpr size_t WS_HDN = WS_P;
constexpr size_t WS_PLE = WS_P + 72 * MiB;
constexpr size_t WS_Y = 352 * MiB;
constexpr size_t WS_WGUT = 416 * MiB;
constexpr size_t WS_WDT = 480 * MiB;
constexpr size_t WS_END = 512 * MiB;
constexpr int BIAS_LD = 132;
constexpr int CW_BAR = 4096;
constexpr int CW_CNT = 8192, CW_FILL = 8192 + 64, CW_NTILES = 8192 + 128, CW_TILEE = 8192 + 256;

constexpr int RING_OFF = 0, RING_BYTES = 131072;
constexpr int WRT_BYTES = 36 * 1024 * 4;
constexpr int LDS_BYTES = 160 * 1024;
constexpr int LDSCTL_OFF = LDS_BYTES - 1024, MISC_OFF = LDSCTL_OFF;
constexpr int MW_HIST = 0, MW_CNT = 32, MW_RS = 64, MW_LBASE = 96, MW_LFILL = 128, MW_BAR = 160;

struct Frame {
    LAS unsigned char* lds;
    volatile LAS unsigned* MISC;
    unsigned* ctl;
    int tid, lane, wave, vcu, G;
    unsigned char* ws;
    const float* const* in;
    float* out;
};
enum InIdx { I_X = 0, I_P, I_WIN, I_MURKV, I_MULORA, I_W0, I_WL1, I_WL2, I_A0, I_AL1, I_AL2, I_GL1, I_GL2, I_KK, I_KA, I_RK, I_LNXG, I_LNXB, I_RELB, I_WO,
             I_LN1G, I_LN1B, I_RG, I_RGB, I_RE, I_REB, I_WG, I_WU, I_WD, I_PG, I_PP, I_LN2G, I_LN2B };

__device__ __forceinline__ void tr_item(const float* W, int ldw, int k0, int n0, bf16_t* dst, int ldt, const float* mu, int smode, LAS float* scr, int lane) {
#pragma unroll 8
    for (int i = 0; i < 32; ++i) { const int kk = 2 * i + (lane >> 5); float v = W[(size_t)(k0 + kk) * ldw + n0 + (lane & 31)];
        if (smode == 1) v *= (1.0f - mu[k0 + kk]); else if (smode == 2) v *= mu[k0 + kk];
        scr[kk * 33 + (lane & 31)] = v; }
    LDS_WAIT(); asm volatile("" ::: "memory");
    const int c = lane & 7;
#pragma unroll
    for (int j = 0; j < 4; ++j) { const int n = (lane >> 3) + 8 * j; const LAS float* s = scr + (8 * c) * 33 + n;
        u32x4 o; o.x = pk2(s[0 * 33], s[1 * 33]); o.y = pk2(s[2 * 33], s[3 * 33]); o.z = pk2(s[4 * 33], s[5 * 33]); o.w = pk2(s[6 * 33], s[7 * 33]);
        *(u32x4*)(dst + (size_t)n * ldt + k0 + 8 * c) = o; }
    LDS_WAIT(); asm volatile("" ::: "memory");
}
__device__ __forceinline__ int t5_bucket(int n) {
    if (n < 16) return n;
    int b = 16;
    b += (n >= 22); b += (n >= 30); b += (n >= 40); b += (n >= 54); b += (n >= 73); b += (n >= 99); b += (n >= 134); b += (n >= 182);
    b += (n >= 246); b += (n >= 332); b += (n >= 450); b += (n >= 609); b += (n >= 825); b += (n >= 1117); b += (n >= 1513);
    return b;
}

__device__ __forceinline__ void ph_prologue_small(Frame& F) {
    const int gt = F.vcu * 512 + F.tid, NGT = F.G * 512;
    { bf16_t* w2t = (bf16_t*)(F.ws + WS_W2T);
      for (int i = gt; i < NL2 * KL2; i += NGT) { const int n = i / KL2, k = i % KL2; float v = 0.f;
          if (n < 512) { if (k < 64) v = F.in[I_WL2][k * 512 + n]; }
          else if (n < 1024) { if (k >= 64 && k < 128) v = F.in[I_AL2][(k - 64) * 512 + (n - 512)]; }
          else { if (k >= 128) v = F.in[I_GL2][(k - 128) * 512 + (n - 1024)]; }
          w2t[i] = (bf16_t)f2bf(v); } }
    { float* bt = (float*)(F.ws + WS_BIAS);
      for (int i = gt; i < 3 * 8 * BIAS_LD; i += NGT) { const int p = i / (8 * BIAS_LD), h = (i / BIAS_LD) % 8, m = i % BIAS_LD; const int dil = 1 << (2 * p);
          bt[i] = (m <= 128) ? F.in[I_RELB][t5_bucket(m * dil) * 8 + h] : 0.f; } }
    { bf16_t* wrt = (bf16_t*)(F.ws + WS_WRT);
      for (int i = gt; i < 48 * 1024; i += NGT) { const int n = i >> 10, k = i & 1023; float v = 0.f;
          if (n < 4) v = F.in[I_RG][k * 4 + n]; else if (n < 36) v = F.in[I_RE][k * 32 + (n - 4)];
          const unsigned hb = f2bf(v); const float hf = __builtin_bit_cast(float, hb << 16);
          wrt[i] = (bf16_t)hb; wrt[48 * 1024 + i] = (bf16_t)f2bf(v - hf); } }
}
__device__ __forceinline__ void ph_prologue(Frame& F) {
    const int gt = F.vcu * 512 + F.tid, NGT = F.G * 512;
    const int gw = F.vcu * NWAVES + F.wave, NGW = F.G * NWAVES;
    { const f32x4* x4 = (const f32x4*)F.in[I_X]; u32x4* o = (u32x4*)(F.ws + WS_XB);
      for (int i = gt; i < NTOK * DM / 8; i += NGT) { const f32x4 a = __builtin_nontemporal_load(x4 + 2 * i), b = __builtin_nontemporal_load(x4 + 2 * i + 1); u32x4 w;
        w.x = pk2(a.x, a.y); w.y = pk2(a.z, a.w); w.z = pk2(b.x, b.y); w.w = pk2(b.z, b.w); o[i] = w; } }
    LAS float* scr = (LAS float*)(F.lds + RING_OFF + F.wave * 16384);
    constexpr int IT_WIN = 16 * 96, IT_L1 = 256;
    constexpr int NIT = IT_WIN + IT_L1;
    bf16_t* WinT = (bf16_t*)(F.ws + WS_WINT);
    for (int it = gw; it < NIT; it += NGW) {
        int r = it;
        if (r < IT_WIN) { const int kb = r / 96, nb = r % 96; tr_item(F.in[I_WIN], NPROJ, kb * 64, nb * 32, WinT + (size_t)(nb * 32) * DM, DM, nullptr, 0, scr, F.lane); continue; } r -= IT_WIN;
        if (r < IT_L1) {
            int piece, sub;
            if (r < 128) { piece = r / 32; sub = r % 32; } else { piece = 4 + (r - 128) / 64; sub = (r - 128) % 64; }
            const int which = piece >> 1, isprev = piece & 1;
            const int ncols = (which == 2) ? 128 : 64, nblk = ncols / 32;
            const int kb = sub / nblk, nb = sub % nblk;
            const float* src = (which == 0) ? F.in[I_WL1] : (which == 1) ? F.in[I_AL1] : F.in[I_GL1];
            const int rowbase = (which == 0) ? 3072 + 64 * isprev : (which == 1) ? 3200 + 64 * isprev : 3328 + 128 * isprev;
            tr_item(src, ncols, kb * 64, nb * 32, WinT + (size_t)(rowbase + nb * 32) * DM, DM, F.in[I_MULORA] + which * DM, isprev ? 2 : 1, scr, F.lane); }
    }
}
constexpr int LATE_TILE_UNITS = (512 + 512 + 128) / NWAVES;
__device__ __forceinline__ void late_prologue_items(Frame& F, int unit, LAS float* scr) {
    { const f32x4* x4 = (const f32x4*)F.in[I_P]; u32x4* o = (u32x4*)(F.ws + WS_PB);
      int tid_ = F.tid; asm volatile("" : "+v"(tid_));
#pragma unroll
      for (int q = 0; q < 2; ++q) { const int i = unit * 1024 + q * 512 + tid_; const f32x4 a = __builtin_nontemporal_load(x4 + 2 * i), b = __builtin_nontemporal_load(x4 + 2 * i + 1); u32x4 w; w.x = pk2(a.x, a.y); w.y = pk2(a.z, a.w); w.z = pk2(b.x, b.y); w.w = pk2(b.z, b.w); o[i] = w; } }
    if (unit < LATE_TILE_UNITS) { int r = unit * NWAVES + F.wave; int lane_ = F.lane; asm volatile("" : "+v"(lane_));
        if (r < 512) { const int kb = r / 32, nb = r % 32; tr_item(F.in[I_WO], DM, kb * 64, nb * 32, (bf16_t*)(F.ws + WS_WOT) + (size_t)(nb * 32) * DM, DM, nullptr, 0, scr, lane_); }
        else if (r < 1024) { r -= 512; const int kb = r / 32, nb = r % 32; tr_item(F.in[I_PG], DM, kb * 64, nb * 32, (bf16_t*)(F.ws + WS_GT) + (size_t)(nb * 32) * DM, DM, nullptr, 0, scr, lane_); }
        else { r -= 1024; const int kb = r / 32, nb = r % 32; tr_item(F.in[I_PP], DM, kb * 64, nb * 32, (bf16_t*)(F.ws + WS_PT) + (size_t)(nb * 32) * 256, 256, nullptr, 0, scr, lane_); } }
}
constexpr int MOE_IT_GU = 64 * 256, MOE_IT_D = 32 * 256, MOE_ROUNDS_PER_UNIT = 3;
static_assert((MOE_IT_GU + MOE_IT_D) == NB * 8 * 8 * MOE_ROUNDS_PER_UNIT * NWAVES, "conversion items tile the attention queue exactly");
struct MoeItem { const float* src; bf16_t* dst; int ldw, ldt, k0; };
__device__ __forceinline__ MoeItem moe_item(const Frame& F, int it) {
    MoeItem m;
    if (it < MOE_IT_GU) { const int mat = it / 256, sub = it % 256, e = mat >> 1, up = mat & 1, kb = sub / 16, nb = sub % 16, n0 = nb * 32;
        m.src = (up ? F.in[I_WU] : F.in[I_WG]) + (size_t)e * DM * DEXP + (size_t)(kb * 64) * DEXP + n0; m.ldw = DEXP;
        m.dst = (bf16_t*)(F.ws + WS_WGUT) + ((size_t)e * 1024 + (n0 >> 7) * 256 + up * 128 + (n0 & 127)) * DM; m.ldt = DM; m.k0 = kb * 64; }
    else { const int r = it - MOE_IT_GU, e = r / 256, sub = r % 256, kb = sub / 32, nb = sub % 32;
        m.src = F.in[I_WD] + (size_t)e * DEXP * DM + (size_t)(kb * 64) * DM + nb * 32; m.ldw = DM;
        m.dst = (bf16_t*)(F.ws + WS_WDT) + ((size_t)e * 1024 + nb * 32) * DEXP; m.ldt = DEXP; m.k0 = kb * 64; }
    return m;
}
__device__ __forceinline__ void moe_weight_items3(Frame& F, int it0, LAS float* scr) {
    const int lane = F.lane;
    float v[MOE_ROUNDS_PER_UNIT][32]; MoeItem m[MOE_ROUNDS_PER_UNIT];
#pragma unroll
    for (int j = 0; j < MOE_ROUNDS_PER_UNIT; ++j) { m[j] = moe_item(F, it0 + j * NWAVES);
        const float* p = m[j].src + (size_t)(lane >> 5) * m[j].ldw + (lane & 31);
#pragma unroll
        for (int i = 0; i < 32; ++i) v[j][i] = __builtin_nontemporal_load(p + (size_t)(2 * i) * m[j].ldw); }
#pragma unroll
    for (int j = 0; j < MOE_ROUNDS_PER_UNIT; ++j) {
#pragma unroll
        for (int i = 0; i < 32; ++i) scr[(2 * i + (lane >> 5)) * 33 + (lane & 31)] = v[j][i];
        LDS_WAIT(); asm volatile("" ::: "memory");
        const int c = lane & 7;
#pragma unroll
        for (int q = 0; q < 4; ++q) { const int n = (lane >> 3) + 8 * q; const LAS float* sp = scr + (8 * c) * 33 + n;
            u32x4 o; o.x = pk2(sp[0 * 33], sp[1 * 33]); o.y = pk2(sp[2 * 33], sp[3 * 33]); o.z = pk2(sp[4 * 33], sp[5 * 33]); o.w = pk2(sp[6 * 33], sp[7 * 33]);
            *(u32x4*)(m[j].dst + (size_t)n * m[j].ldt + m[j].k0 + 8 * c) = o; }
        LDS_WAIT(); asm volatile("" ::: "memory");
    }
}

using pg8::Unit; using pg8::cvt_pk_bf16;
struct EpiProj {
    static constexpr bool PERM = true;
    bf16_t* proj; bf16_t* lora1;
    __device__ __forceinline__ void operator()(const f32x4 (&acc)[2][2][4][2], const Unit& u, int wr, int wc, int fr, int fq) const {
        const int row0 = u.pm * 256 + wr * 64 + fr;
        const bool isl = (u.pn >= 12);
        bf16_t* base = isl ? lora1 : proj; const int ld = isl ? NL1 : NPROJ;
        const int col0 = (isl ? (u.pn - 12) : u.pn) * 256 + wc * 32 + 8 * fq;
#pragma unroll
        for (int ai = 0; ai < 2; ++ai)
#pragma unroll
            for (int m = 0; m < 4; ++m) { bf16_t* rowp = base + (size_t)(row0 + ai * 128 + m * 16) * ld + col0;
#pragma unroll
                for (int bj = 0; bj < 2; ++bj) { const f32x4 v0 = acc[ai][bj][m][0], v1 = acc[ai][bj][m][1]; u32x4 w;
                    w.x = cvt2(v0[0], v0[1]); w.y = cvt2(v0[2], v0[3]); w.z = cvt2(v1[0], v1[1]); w.w = cvt2(v1[2], v1[3]);
                    *(u32x4*)(rowp + bj * 128) = w; } }
    }
};
struct EpiDag {
    static constexpr bool PERM = true;
    bf16_t* lw; bf16_t* ag; const float* w0; const float* a0;
    __device__ __forceinline__ void operator()(const f32x4 (&acc)[2][2][4][2], const Unit& u, int wr, int wc, int fr, int fq) const {
        const int row0 = u.pm * 256 + wr * 64 + fr;
        const int colt = u.pn * 256 + wc * 32 + 8 * fq;
        if (u.pn < 2) {
#pragma unroll
            for (int bj = 0; bj < 2; ++bj) {
                const f32x4 b0 = *(const f32x4*)(w0 + colt + bj * 128), b1 = *(const f32x4*)(w0 + colt + bj * 128 + 4);
#pragma unroll
                for (int ai = 0; ai < 2; ++ai)
#pragma unroll
                    for (int m = 0; m < 4; ++m) { bf16_t* rowp = lw + (size_t)(row0 + ai * 128 + m * 16) * 512 + colt + bj * 128;
                        const f32x4 z0 = acc[ai][bj][m][0] + b0, z1 = acc[ai][bj][m][1] + b1; f32x4 o0, o1;
#pragma unroll
                        for (int j = 0; j < 4; ++j) { o0[j] = -0.6065306597126334f * sigmoidf_(z0[j]); o1[j] = -0.6065306597126334f * sigmoidf_(z1[j]); }
                        u32x4 w; w.x = cvt2(o0[0], o0[1]); w.y = cvt2(o0[2], o0[3]); w.z = cvt2(o1[0], o1[1]); w.w = cvt2(o1[2], o1[3]);
                        *(u32x4*)(rowp) = w; }
                asm volatile("" ::: "memory");
            }
        } else {
            const bool isa = (u.pn < 4);
#pragma unroll
            for (int bj = 0; bj < 2; ++bj) {
                f32x4 b0 = (f32x4){0.f, 0.f, 0.f, 0.f}, b1 = (f32x4){0.f, 0.f, 0.f, 0.f};
                if (isa) { b0 = *(const f32x4*)(a0 + (colt - 512) + bj * 128); b1 = *(const f32x4*)(a0 + (colt - 512) + bj * 128 + 4); }
#pragma unroll
                for (int ai = 0; ai < 2; ++ai)
#pragma unroll
                    for (int m = 0; m < 4; ++m) { bf16_t* rowp = ag + (size_t)(row0 + ai * 128 + m * 16) * 1024 + (colt - 512) + bj * 128;
                        f32x4 v0 = acc[ai][bj][m][0] + b0, v1 = acc[ai][bj][m][1] + b1;
                        if (isa) {
#pragma unroll
                            for (int j = 0; j < 4; ++j) { v0[j] = sigmoidf_(v0[j]); v1[j] = sigmoidf_(v1[j]); } }
                        u32x4 w; w.x = cvt2(v0[0], v0[1]); w.y = cvt2(v0[2], v0[3]); w.z = cvt2(v1[0], v1[1]); w.w = cvt2(v1[2], v1[3]);
                        *(u32x4*)(rowp) = w; }
                asm volatile("" ::: "memory");
            }
        }
    }
};
struct EpiWo {
    static constexpr bool PERM = true;
    bf16_t* mix;
    __device__ __forceinline__ void operator()(const f32x4 (&acc)[2][2][4][2], const Unit& u, int wr, int wc, int fr, int fq) const {
        const int row0 = u.pm * 256 + wr * 64 + fr, col0 = u.pn * 256 + wc * 32 + 8 * fq;
#pragma unroll
        for (int ai = 0; ai < 2; ++ai)
#pragma unroll
            for (int m = 0; m < 4; ++m) { bf16_t* rowp = mix + (size_t)(row0 + ai * 128 + m * 16) * DM + col0;
#pragma unroll
                for (int bj = 0; bj < 2; ++bj) { const f32x4 v0 = acc[ai][bj][m][0], v1 = acc[ai][bj][m][1]; u32x4 w;
                    w.x = cvt2(v0[0], v0[1]); w.y = cvt2(v0[2], v0[3]); w.z = cvt2(v1[0], v1[1]); w.w = cvt2(v1[2], v1[3]);
                    *(u32x4*)(rowp + bj * 128) = w; } }
    }
};
struct EpiBf {
    static constexpr bool PERM = true;
    bf16_t* O; int ldc;
    __device__ __forceinline__ void operator()(const f32x4 (&acc)[2][2][4][2], const Unit& u, int wr, int wc, int fr, int fq) const {
        const int row0 = u.pm * 256 + wr * 64 + fr, col0 = u.pn * 256 + wc * 32 + 8 * fq;
#pragma unroll
        for (int ai = 0; ai < 2; ++ai)
#pragma unroll
            for (int m = 0; m < 4; ++m) { bf16_t* rowp = O + (size_t)(row0 + ai * 128 + m * 16) * ldc + col0;
#pragma unroll
                for (int bj = 0; bj < 2; ++bj) { const f32x4 v0 = acc[ai][bj][m][0], v1 = acc[ai][bj][m][1]; u32x4 w;
                    w.x = cvt2(v0[0], v0[1]); w.y = cvt2(v0[2], v0[3]); w.z = cvt2(v1[0], v1[1]); w.w = cvt2(v1[2], v1[3]);
                    *(u32x4*)(rowp + bj * 128) = w; } }
    }
};
struct EpiPle {
    static constexpr bool PERM = true;
    bf16_t* O; int ldc; const bf16_t* x1b;
    __device__ __forceinline__ void operator()(const f32x4 (&acc)[2][2][4][2], const Unit& u, int wr, int wc, int fr, int fq) const {
        const int row0 = u.pm * 256 + wr * 64 + fr, col0 = u.pn * 256 + wc * 32 + 8 * fq;
#pragma unroll
        for (int ai = 0; ai < 2; ++ai) {
            u32x4 pv[4][2], xv[4][2];
#pragma unroll
            for (int m = 0; m < 4; ++m)
#pragma unroll
                for (int bj = 0; bj < 2; ++bj) { const size_t off = (size_t)(row0 + ai * 128 + m * 16) * ldc + col0 + bj * 128; pv[m][bj] = *(const u32x4*)(O + off); xv[m][bj] = *(const u32x4*)(x1b + off); }
#pragma unroll
            for (int m = 0; m < 4; ++m)
#pragma unroll
                for (int bj = 0; bj < 2; ++bj) { const f32x4 a0 = acc[ai][bj][m][0], a1 = acc[ai][bj][m][1]; const u32x4 p = pv[m][bj], x = xv[m][bj]; u32x4 w;
                    w.x = cvt2(ALPHA * bf_lo(x.x) + sigmoidf_(a0[0]) * bf_lo(p.x), ALPHA * bf_hi(x.x) + sigmoidf_(a0[1]) * bf_hi(p.x));
                    w.y = cvt2(ALPHA * bf_lo(x.y) + sigmoidf_(a0[2]) * bf_lo(p.y), ALPHA * bf_hi(x.y) + sigmoidf_(a0[3]) * bf_hi(p.y));
                    w.z = cvt2(ALPHA * bf_lo(x.z) + sigmoidf_(a1[0]) * bf_lo(p.z), ALPHA * bf_hi(x.z) + sigmoidf_(a1[1]) * bf_hi(p.z));
                    w.w = cvt2(ALPHA * bf_lo(x.w) + sigmoidf_(a1[2]) * bf_lo(p.w), ALPHA * bf_hi(x.w) + sigmoidf_(a1[3]) * bf_hi(p.w));
                    *(u32x4*)(O + (size_t)(row0 + ai * 128 + m * 16) * ldc + col0 + bj * 128) = w; }
            asm volatile("" ::: "memory");
        }
    }
};
struct EpiGU {
    static constexpr bool PERM = true;
    bf16_t* hdn;
    __device__ __forceinline__ void operator()(const f32x4 (&acc)[2][2][4][2], const Unit& u, int wr, int wc, int fr, int fq) const {
        const int row0 = u.pm * 256 + wr * 64 + fr, col0 = u.pn * 128 + wc * 32 + 8 * fq;
#pragma unroll
        for (int ai = 0; ai < 2; ++ai)
#pragma unroll
            for (int m = 0; m < 4; ++m) { bf16_t* rowp = hdn + (size_t)(row0 + ai * 128 + m * 16) * DEXP + col0; float h[8];
#pragma unroll
                for (int n = 0; n < 2; ++n)
#pragma unroll
                    for (int j = 0; j < 4; ++j) { const float gt = acc[ai][0][m][n][j], up = acc[ai][1][m][n][j]; h[4 * n + j] = gt * sigmoidf_(gt) * up; }
                u32x4 w; w.x = cvt2(h[0], h[1]); w.y = cvt2(h[2], h[3]); w.z = cvt2(h[4], h[5]); w.w = cvt2(h[6], h[7]);
                *(u32x4*)rowp = w; }
    }
};
struct EpiDown {
    static constexpr bool PERM = true;
    bf16_t* lo; bf16_t* hi; const int* row_asg; const float* row_w;
    __device__ __forceinline__ void operator()(const f32x4 (&acc)[2][2][4][2], const Unit& u, int wr, int wc, int fr, int fq) const {
        const int row0 = u.pm * 256 + wr * 64 + fr, col0 = u.pn * 256 + wc * 32 + 8 * fq;
        int asg[2][4]; float wv[2][4];
#pragma unroll
        for (int ai = 0; ai < 2; ++ai)
#pragma unroll
            for (int m = 0; m < 4; ++m) { const int prow = row0 + ai * 128 + m * 16; asg[ai][m] = row_asg[prow]; wv[ai][m] = row_w[prow]; }
#pragma unroll
        for (int ai = 0; ai < 2; ++ai)
#pragma unroll
            for (int m = 0; m < 4; ++m) { const int ag_ = asg[ai][m]; const float w = wv[ai][m];
                if (ag_ >= 0) { bf16_t* rowp = lo + (size_t)ag_ * DM + col0;
#pragma unroll
                    for (int bj = 0; bj < 2; ++bj) { const f32x4 v0 = acc[ai][bj][m][0] * w, v1 = acc[ai][bj][m][1] * w; u32x4 o;
                        o.x = cvt2(v0[0], v0[1]); o.y = cvt2(v0[2], v0[3]); o.z = cvt2(v1[0], v1[1]); o.w = cvt2(v1[2], v1[3]);
                        *(u32x4*)(rowp + bj * 128) = o; } } }
    }
};

__device__ __forceinline__ void ph_lora_act(Frame& F) {
    const int gt = F.vcu * 512 + F.tid, NGT = F.G * 512;
    const bf16_t* l1 = (const bf16_t*)(F.ws + WS_LORA1); bf16_t* act = (bf16_t*)(F.ws + WS_Y);
    for (int i = gt; i < NTOK * 32; i += NGT) {
        const int t = i >> 5, c8 = (i & 31) * 8; const bool first = (t % SEQ) == 0;
        int ca, cb, mode;
        if (c8 < 64) { ca = c8; cb = 64 + c8; mode = 0; } else if (c8 < 128) { ca = 128 + (c8 - 64); cb = 192 + (c8 - 64); mode = 1; } else { ca = 256 + (c8 - 128); cb = 384 + (c8 - 128); mode = 2; }
        const u32x4 wa = *(const u32x4*)(l1 + (size_t)t * NL1 + ca);
        u32x4 wb = (u32x4){0u, 0u, 0u, 0u};
        if (!first) wb = *(const u32x4*)(l1 + (size_t)(t - 1) * NL1 + cb);
        float a[8];
        a[0] = bf_lo(wa.x) + bf_lo(wb.x); a[1] = bf_hi(wa.x) + bf_hi(wb.x); a[2] = bf_lo(wa.y) + bf_lo(wb.y); a[3] = bf_hi(wa.y) + bf_hi(wb.y);
        a[4] = bf_lo(wa.z) + bf_lo(wb.z); a[5] = bf_hi(wa.z) + bf_hi(wb.z); a[6] = bf_lo(wa.w) + bf_lo(wb.w); a[7] = bf_hi(wa.w) + bf_hi(wb.w);
        float o[8];
#pragma unroll
        for (int j = 0; j < 8; ++j) {
            const float sg = sigmoidf_(mode == 0 ? 2.0f * a[j] : a[j]);
            o[j] = (mode == 0) ? 2.0f * sg - 1.0f : (mode == 1) ? a[j] : sg; }
        u32x4 w; w.x = pk2(o[0], o[1]); w.y = pk2(o[2], o[3]); w.z = pk2(o[4], o[5]); w.w = pk2(o[6], o[7]);
        *(u32x4*)(act + (size_t)t * KL2 + c8) = w;
    }
}

__device__ __forceinline__ int sigma64(int i) { return (i & ~31) | (((i >> 2) & 3) << 3) | (((i >> 4) & 1) << 2) | (i & 3); }
__device__ __forceinline__ bf16x8 mk8(unsigned a, unsigned b, unsigned c, unsigned d) { u32x4 v; v.x = a; v.y = b; v.z = c; v.w = d; return __builtin_bit_cast(bf16x8, v); }
#define MFMA16(A, B, C) __builtin_amdgcn_mfma_f32_16x16x32_bf16((A), (B), (C), 0, 0, 0)

template <int CTRL> __device__ __forceinline__ float dppf(float v) { return __builtin_bit_cast(float, __builtin_amdgcn_update_dpp(0, __builtin_bit_cast(int, v), CTRL, 0xf, 0xf, true)); }
template <int CTRL, int ROWMASK> __device__ __forceinline__ float dppf_rm(float v) { return __builtin_bit_cast(float, __builtin_amdgcn_update_dpp(0, __builtin_bit_cast(int, v), CTRL, ROWMASK, 0xf, false)); }
__device__ __forceinline__ float wave_sum_u(float v) {
    v += dppf<0xB1>(v); v += dppf<0x4E>(v); v += dppf<0x141>(v); v += dppf<0x140>(v);
    v += dppf_rm<0x142, 0xA>(v);
    v += dppf_rm<0x143, 0xC>(v);
    return __builtin_bit_cast(float, __builtin_amdgcn_readlane(__builtin_bit_cast(int, v), 63));
}
__device__ __forceinline__ bf16_t bf1(float x) { return __builtin_bit_cast(bf16_t, (__bf16)x); }

#define SC_BAR() do { asm volatile("s_waitcnt lgkmcnt(0)" ::: "memory"); __builtin_amdgcn_s_barrier(); asm volatile("" ::: "memory"); } while (0)
constexpr int S3_RS = 144, S3_TS = 144;
constexpr int S3_AP = 0, S3_RP = 2304, S3_BN = 4608, S3_VN = 9216, S3_BR = 11520, S3_KR = 13824, S3_Y = 11520, S3_LF = 11520, S3_LKA = 16128, S3_TA = 17152, S3_LRA = 18176, S3_GC = 19200, S3_BON = 19456;
constexpr int S3_SL = 19584, S3_CT = 8 * S3_SL;
static_assert(S3_AP + 16 * S3_TS <= S3_RP && S3_RP + 16 * S3_TS <= S3_BN && S3_BN + 32 * S3_RS <= S3_VN && S3_VN + 16 * S3_RS <= S3_BR && S3_BR + 16 * S3_TS <= S3_KR && S3_KR + 16 * S3_TS <= S3_LKA && S3_Y + 4096 <= S3_LKA && S3_BON + 64 <= S3_SL, "scan slot map");
static_assert(S3_CT + 6 * 64 * 4 <= LDSCTL_OFF, "scan slots fit below the LDS control words");
__device__ __forceinline__ float rowsum4(float v) {
    const unsigned b = __builtin_bit_cast(unsigned, v);
    const auto r = __builtin_amdgcn_permlane16_swap(b, b, false, false);
    const float s = __builtin_bit_cast(float, (unsigned)r[0]) + __builtin_bit_cast(float, (unsigned)r[1]);
    const unsigned sb = __builtin_bit_cast(unsigned, s);
    const auto q = __builtin_amdgcn_permlane32_swap(sb, sb, false, false);
    return __builtin_bit_cast(float, (unsigned)q[0]) + __builtin_bit_cast(float, (unsigned)q[1]);
}
template <int CTRL> __device__ __forceinline__ float dpp_old(float oldv, float v) { return __builtin_bit_cast(float, __builtin_amdgcn_update_dpp(__builtin_bit_cast(int, oldv), __builtin_bit_cast(int, v), CTRL, 0xf, 0xf, false)); }
__device__ __forceinline__ u32x2 tr_read1(unsigned a) { u32x2 r; asm volatile("ds_read_b64_tr_b16 %0, %1\n\ts_waitcnt lgkmcnt(0)" : "=v"(r) : "v"(a) : "memory"); return r; }
__device__ __forceinline__ void tr_read_bk(unsigned a, bf16x8 (&bk)[4]) {
    u32x2 r[8];
    asm volatile("ds_read_b64_tr_b16 %0, %8\n\tds_read_b64_tr_b16 %1, %8 offset:576\n\tds_read_b64_tr_b16 %2, %8 offset:32\n\tds_read_b64_tr_b16 %3, %8 offset:608\n\t"
                 "ds_read_b64_tr_b16 %4, %8 offset:64\n\tds_read_b64_tr_b16 %5, %8 offset:640\n\tds_read_b64_tr_b16 %6, %8 offset:96\n\tds_read_b64_tr_b16 %7, %8 offset:672\n\ts_waitcnt lgkmcnt(0)"
                 : "=v"(r[0]), "=v"(r[1]), "=v"(r[2]), "=v"(r[3]), "=v"(r[4]), "=v"(r[5]), "=v"(r[6]), "=v"(r[7]) : "v"(a) : "memory");
#pragma unroll
    for (int m = 0; m < 4; ++m) bk[m] = mk8(r[2 * m].x, r[2 * m].y, r[2 * m + 1].x, r[2 * m + 1].y);
}
static_assert(4 * S3_RS == 576, "tr_read_bk offsets");

__device__ __forceinline__ void s3_gram_t(LAS unsigned char* myslot, int cc, int g) {
                f32x4 d1 = (f32x4){0.f, 0.f, 0.f, 0.f}, d2 = d1, d3 = d1, d4 = d1;
#pragma unroll
                for (int ks = 0; ks < 2; ++ks) {
                    const int off = cc * S3_TS + (32 * ks + 8 * g) * 2;
                    const bf16x8 fa = *(const LAS bf16x8*)(myslot + S3_AP + off), fr = *(const LAS bf16x8*)(myslot + S3_RP + off);
                    const bf16x8 fb = *(const LAS bf16x8*)(myslot + S3_BR + off), fk = *(const LAS bf16x8*)(myslot + S3_KR + off);
                    d1 = MFMA16(fa, fb, d1); d2 = MFMA16(fa, fk, d2); d3 = MFMA16(fr, fb, d3); d4 = MFMA16(fr, fk, d4);
                }
                asm volatile("" ::: "memory");
                const int colA = 8 * (cc >> 2) + (cc & 3);
#pragma unroll
                for (int reg = 0; reg < 4; ++reg) {
                    const int tt = 4 * g + reg, s = cc; const bool lo = s < tt, le = s <= tt;
                    *(LAS float*)(myslot + S3_LF + (tt * 16 + s) * 4) = lo ? d1[reg] : 0.f;
                    *(LAS bf16_t*)(myslot + S3_LKA + tt * 64 + (colA + 4) * 2) = bf1(lo ? d2[reg] : 0.f);
                    *(LAS bf16_t*)(myslot + S3_LKA + tt * 64 + colA * 2) = (bf16_t)0;
                    *(LAS bf16_t*)(myslot + S3_LRA + tt * 64 + colA * 2) = bf1(le ? d3[reg] : 0.f);
                    *(LAS bf16_t*)(myslot + S3_LRA + tt * 64 + (colA + 4) * 2) = bf1(le ? d4[reg] : 0.f);
                }
                LDS_WAIT();
                float Tc[16];
#pragma unroll
                for (int tt = 0; tt < 16; ++tt) {
                    float pa[4]; pa[0] = (cc == tt) ? 1.f : 0.f; pa[1] = 0.f; pa[2] = 0.f; pa[3] = 0.f;
#pragma unroll
                    for (int s4 = 0; s4 < (tt + 3) / 4; ++s4) { const f32x4 l4 = *(const LAS f32x4*)(myslot + S3_LF + (tt * 16 + 4 * s4) * 4);
#pragma unroll
                        for (int j = 0; j < 4; ++j) if (4 * s4 + j < tt) pa[j] += l4[j] * Tc[4 * s4 + j]; }
                    Tc[tt] = (pa[0] + pa[1]) + (pa[2] + pa[3]);
                }
                if (g == 0) {
#pragma unroll
                    for (int tt = 0; tt < 16; ++tt) { *(LAS bf16_t*)(myslot + S3_TA + tt * 64 + colA * 2) = bf1(Tc[tt]); *(LAS bf16_t*)(myslot + S3_TA + tt * 64 + (colA + 4) * 2) = (bf16_t)0; }
                }
}

__device__ __forceinline__ void ph_scan_pipe3(Frame& F) {
    if (F.vcu & 1) return;
    const int bh = F.vcu >> 1, b = bh >> 3, h = bh & 7, lane = F.lane, wave = F.wave;
    const int g = lane >> 4, cc = lane & 15;
    const bf16_t* proj = (const bf16_t*)(F.ws + WS_P); const bf16_t* lwb = (const bf16_t*)(F.ws + WS_LW); const bf16_t* ag = (const bf16_t*)(F.ws + WS_AG);
    bf16_t* ycat = (bf16_t*)(F.ws + WS_Y);
    constexpr int NR = SEQ / 64;
    for (int i = F.tid; i < 6 * 64; i += 512) { const int w_ = i >> 6, c_ = h * 64 + (i & 63);
        *(LAS float*)(F.lds + S3_CT + i * 4) = (w_ < 3) ? F.in[I_MURKV][w_ * 512 + c_] : (w_ == 3) ? F.in[I_KK][c_] : (w_ == 4) ? F.in[I_KA][c_] : F.in[I_RK][c_]; }
    __syncthreads();
    if (wave >= 4) {
        const int pw = wave - 4, t = cc;
        u32x4 qr[2], qk[2], qv[2], qa[2], pr[2], pk[2], pv[2], qlw[2];
#define S3_PREFETCH(cidx_) do { const int tl_ = 16 * (cidx_) + t; const size_t T_ = (size_t)b * SEQ + tl_; \
            const bf16_t* rp_ = proj + T_ * NPROJ + h * 64 + 16 * g; const bf16_t* ap_ = ag + T_ * 1024 + h * 64 + 16 * g; const bf16_t* lp_ = lwb + T_ * 512 + h * 64 + 16 * g; \
            _Pragma("unroll") for (int e_ = 0; e_ < 2; ++e_) { qr[e_] = *(const u32x4*)(rp_ + 8 * e_); qk[e_] = *(const u32x4*)(rp_ + 512 + 8 * e_); qv[e_] = *(const u32x4*)(rp_ + 1024 + 8 * e_); qa[e_] = *(const u32x4*)(ap_ + 8 * e_); } \
            _Pragma("unroll") for (int e_ = 0; e_ < 2; ++e_) qlw[e_] = *(const u32x4*)(lp_ + 8 * e_); \
            if (tl_ > 0) { _Pragma("unroll") for (int e_ = 0; e_ < 2; ++e_) { pr[e_] = *(const u32x4*)(rp_ - NPROJ + 8 * e_); pk[e_] = *(const u32x4*)(rp_ - NPROJ + 512 + 8 * e_); pv[e_] = *(const u32x4*)(rp_ - NPROJ + 1024 + 8 * e_); } } \
            else { _Pragma("unroll") for (int e_ = 0; e_ < 2; ++e_) { pr[e_] = (u32x4){0u, 0u, 0u, 0u}; pk[e_] = pr[e_]; pv[e_] = pr[e_]; } } } while (0)
        const LAS float* ct = (const LAS float*)(F.lds + S3_CT) + 16 * g;
        typedef float f32x2 __attribute__((ext_vector_type(2)));
#define S3_BF2(arr, j2) ((f32x2){bf_lo(arr[(j2) >> 2][(j2) & 3]), bf_hi(arr[(j2) >> 2][(j2) & 3])})
        f32x2 rr[8], kk[8], kq[8], av[8]; float cl[16]; unsigned vpk[8]; float ss = 0.f, bon = 0.f;
        auto stage1 = [&]() __attribute__((always_inline)) {
            f32x2 ssv = (f32x2){0.f, 0.f}, bov = ssv;
#pragma unroll
            for (int j4 = 0; j4 < 4; ++j4) {
                const f32x4 mur = *(const LAS f32x4*)(ct + 4 * j4), muk = *(const LAS f32x4*)(ct + 64 + 4 * j4), muv = *(const LAS f32x4*)(ct + 128 + 4 * j4);
                const f32x4 ckk = *(const LAS f32x4*)(ct + 192 + 4 * j4), cka = *(const LAS f32x4*)(ct + 256 + 4 * j4), crk = *(const LAS f32x4*)(ct + 320 + 4 * j4);
#pragma unroll
                for (int e = 0; e < 2; ++e) { const int j2 = 2 * j4 + e;
                    const f32x2 mur2 = (f32x2){mur[2 * e], mur[2 * e + 1]}, muk2 = (f32x2){muk[2 * e], muk[2 * e + 1]}, muv2 = (f32x2){muv[2 * e], muv[2 * e + 1]};
                    const f32x2 ckk2 = (f32x2){ckk[2 * e], ckk[2 * e + 1]}, cka2 = (f32x2){cka[2 * e], cka[2 * e + 1]}, crk2 = (f32x2){crk[2 * e], crk[2 * e + 1]};
                    const f32x2 r_ = S3_BF2(qr, j2), k_ = S3_BF2(qk, j2), v_ = S3_BF2(qv, j2); av[j2] = S3_BF2(qa, j2);
                    rr[j2] = r_ + (S3_BF2(pr, j2) - r_) * mur2; const f32x2 kx = k_ + (S3_BF2(pk, j2) - k_) * muk2; const f32x2 vv = v_ + (S3_BF2(pv, j2) - v_) * muv2;
                    kk[j2] = kx * ckk2; ssv += kk[j2] * kk[j2];
                    kq[j2] = kx * (1.0f + (av[j2] - 1.0f) * cka2); bov += rr[j2] * kq[j2] * crk2;
                    vpk[j2] = cvt2(vv[0], vv[1]); }
            }
#pragma unroll
            for (int j = 0; j < 16; ++j) cl[j] = (j & 1) ? bf_hi(qlw[j >> 3][(j >> 1) & 3]) : bf_lo(qlw[j >> 3][(j >> 1) & 3]);
            ss = rowsum4(ssv[0] + ssv[1]); bon = rowsum4(bov[0] + bov[1]);
        };
        S3_PREFETCH(pw);
        stage1();
#pragma unroll 1
        for (int R = 0; R <= NR; ++R) {
            __builtin_amdgcn_s_setprio(3);
            if (R < NR) {
                LAS unsigned char* myslot = F.lds + (4 * (R & 1) + pw) * S3_SL;
                if (R + 1 < NR) { S3_PREFETCH(4 * (R + 1) + pw); }
                { u32x4 w0, w1; w0.x = vpk[0]; w0.y = vpk[1]; w0.z = vpk[2]; w0.w = vpk[3]; w1.x = vpk[4]; w1.y = vpk[5]; w1.z = vpk[6]; w1.w = vpk[7];
                  *(LAS u32x4*)(myslot + S3_VN + t * S3_RS + 32 * g) = w0; *(LAS u32x4*)(myslot + S3_VN + t * S3_RS + 32 * g + 16) = w1; }
                const float nrm = rsqrtf(fmaxf(ss, 1e-24f));
                if (g == 0) *(LAS float*)(myslot + S3_BON + t * 4) = bon;
#pragma unroll
                for (int j = 0; j < 16; ++j) cl[j] += dppf<0x111>(cl[j]);
#pragma unroll
                for (int j = 0; j < 16; ++j) cl[j] += dppf<0x112>(cl[j]);
#pragma unroll
                for (int j = 0; j < 16; ++j) cl[j] += dppf<0x114>(cl[j]);
#pragma unroll
                for (int j = 0; j < 16; ++j) cl[j] += dppf<0x118>(cl[j]);
                const int rowb = (8 * (t >> 2) + (t & 3)) * S3_RS + 32 * g;
#pragma unroll
                for (int hf = 0; hf < 2; ++hf) {
                    f32x2 ec[4], ei[4], ep[4];
#pragma unroll
                    for (int e = 0; e < 4; ++e) { const int j2 = 4 * hf + e; ec[e][0] = __builtin_amdgcn_exp2f(1.4426950408889634f * cl[2 * j2]); ec[e][1] = __builtin_amdgcn_exp2f(1.4426950408889634f * cl[2 * j2 + 1]); }
#pragma unroll
                    for (int e = 0; e < 4; ++e) { ei[e][0] = __builtin_amdgcn_rcpf(ec[e][0]); ei[e][1] = __builtin_amdgcn_rcpf(ec[e][1]); ep[e][0] = dpp_old<0x111>(1.0f, ec[e][0]); ep[e][1] = dpp_old<0x111>(1.0f, ec[e][1]); }
                    if (t == 15) {
#pragma unroll
                        for (int q = 0; q < 2; ++q) *(LAS f32x4*)(myslot + S3_GC + (16 * g + 8 * hf + 4 * q) * 4) = (f32x4){ec[2 * q][0], ec[2 * q][1], ec[2 * q + 1][0], ec[2 * q + 1][1]}; }
                    unsigned apk[4], rpk[4], bpk[4], kpk[4];
#pragma unroll
                    for (int e = 0; e < 4; ++e) { const int j2 = 4 * hf + e;
                        const f32x2 kn = kk[j2] * nrm;
                        const f32x2 ah = -kn * ep[e], rh = rr[j2] * ec[e], bv = kn * av[j2] * ei[e], kv = kq[j2] * ei[e];
                        apk[e] = cvt2(ah[0], ah[1]); rpk[e] = cvt2(rh[0], rh[1]); bpk[e] = cvt2(bv[0], bv[1]); kpk[e] = cvt2(kv[0], kv[1]); }
#pragma unroll
                    for (int q2 = 0; q2 < 2; ++q2) { const int q = 2 * hf + q2; const int off = t * S3_TS + (32 * (g >> 1) + 8 * q + 4 * (g & 1)) * 2;
                        u32x2 w; w.x = apk[2 * q2]; w.y = apk[2 * q2 + 1]; *(LAS u32x2*)(myslot + S3_AP + off) = w;
                        w.x = rpk[2 * q2]; w.y = rpk[2 * q2 + 1]; *(LAS u32x2*)(myslot + S3_RP + off) = w;
                        w.x = bpk[2 * q2]; w.y = bpk[2 * q2 + 1]; *(LAS u32x2*)(myslot + S3_BR + off) = w;
                        w.x = kpk[2 * q2]; w.y = kpk[2 * q2 + 1]; *(LAS u32x2*)(myslot + S3_KR + off) = w; }
                    { u32x4 w0; w0.x = bpk[0]; w0.y = bpk[1]; w0.z = bpk[2]; w0.w = bpk[3]; *(LAS u32x4*)(myslot + S3_BN + rowb + 16 * hf) = w0;
                      w0.x = kpk[0]; w0.y = kpk[1]; w0.z = kpk[2]; w0.w = kpk[3]; *(LAS u32x4*)(myslot + S3_BN + 4 * S3_RS + rowb + 16 * hf) = w0; }
                }
            }
            SC_BAR();
            __builtin_amdgcn_s_setprio(0);
            if (R + 1 < NR) stage1();
            SC_BAR();
        }
#undef S3_PREFETCH
#undef S3_BF
#undef S3_BF2
    } else {
        const int es = lane >> 2, jq = lane & 3, jb = 16 * wave;
        float lnxg[16], lnxb[16];
#pragma unroll
        for (int j = 0; j < 16; ++j) { lnxg[j] = F.in[I_LNXG][h * 64 + 16 * jq + j]; lnxb[j] = F.in[I_LNXB][h * 64 + 16 * jq + j]; }
        f32x4 St[4];
#pragma unroll
        for (int m = 0; m < 4; ++m) St[m] = (f32x4){0.f, 0.f, 0.f, 0.f};
        bf16x8 Sb0 = mk8(0u, 0u, 0u, 0u), Sb1 = mk8(0u, 0u, 0u, 0u);
        const unsigned trl = (unsigned)((cc >> 2) * S3_RS + (cc & 3) * 8);
        SC_BAR();
        s3_gram_t(F.lds + (0 + wave) * S3_SL, cc, g);
        SC_BAR();
#pragma unroll 1
        for (int R = 0; R < NR; ++R) {
            const size_t tE = (size_t)b * SEQ + 16 * (4 * R + wave) + es;
            const u32x4 g0 = *(const u32x4*)(ag + tE * 1024 + 512 + h * 64 + 16 * jq), g1 = *(const u32x4*)(ag + tE * 1024 + 512 + h * 64 + 16 * jq + 8);
#pragma unroll 1
            for (int q = 0; q < 4; ++q) {
                const LAS unsigned char* sl = F.lds + (4 * (R & 1) + q) * S3_SL;
                const unsigned slb = (unsigned)(__UINTPTR_TYPE__)sl;
                const bf16x8 a0 = *(const LAS bf16x8*)(sl + S3_AP + cc * S3_TS + (8 * g) * 2), a1 = *(const LAS bf16x8*)(sl + S3_AP + cc * S3_TS + (32 + 8 * g) * 2);
                const bf16x8 r0 = *(const LAS bf16x8*)(sl + S3_RP + cc * S3_TS + (8 * g) * 2), r1 = *(const LAS bf16x8*)(sl + S3_RP + cc * S3_TS + (32 + 8 * g) * 2);
                const bf16x8 lka = *(const LAS bf16x8*)(sl + S3_LKA + cc * 64 + 16 * g), ta = *(const LAS bf16x8*)(sl + S3_TA + cc * 64 + 16 * g), lra = *(const LAS bf16x8*)(sl + S3_LRA + cc * 64 + 16 * g);
                f32x4 gc[4];
#pragma unroll
                for (int m = 0; m < 4; ++m) gc[m] = *(const LAS f32x4*)(sl + S3_GC + (16 * m + 4 * g) * 4);
                const u32x2 vd = tr_read1(slb + S3_VN + 4 * g * S3_RS + trl + 32 * wave);
                bf16x8 bkt[4]; tr_read_bk(slb + S3_BN + 8 * g * S3_RS + trl, bkt);
                const f32x4 z4 = (f32x4){0.f, 0.f, 0.f, 0.f};
                f32x4 X = MFMA16(lka, mk8(0u, 0u, vd.x, vd.y), z4); X = MFMA16(a0, Sb0, X); X = MFMA16(a1, Sb1, X);
                f32x4 Y = MFMA16(r0, Sb0, z4); Y = MFMA16(r1, Sb1, Y);
                const f32x4 U = MFMA16(ta, mk8(cvt2(X[0], X[1]), cvt2(X[2], X[3]), 0u, 0u), z4);
                const bf16x8 Bu = mk8(cvt2(U[0], U[1]), cvt2(U[2], U[3]), vd.x, vd.y);
#pragma unroll
                for (int m = 0; m < 4; ++m) St[m] = MFMA16(bkt[m], Bu, St[m]) * gc[m];
                Y = MFMA16(lra, Bu, Y);
                Sb0 = mk8(cvt2(St[0][0], St[0][1]), cvt2(St[0][2], St[0][3]), cvt2(St[1][0], St[1][1]), cvt2(St[1][2], St[1][3]));
                Sb1 = mk8(cvt2(St[2][0], St[2][1]), cvt2(St[2][2], St[2][3]), cvt2(St[3][0], St[3][1]), cvt2(St[3][2], St[3][3]));
#pragma unroll
                for (int reg = 0; reg < 4; ++reg) *(LAS float*)((LAS unsigned char*)sl + S3_Y + ((4 * g + reg) * 64 + jb + cc) * 4) = Y[reg];
            }
            SC_BAR();
            __builtin_amdgcn_s_setprio(3);
            {
                const LAS unsigned char* sl = F.lds + (4 * (R & 1) + wave) * S3_SL;
                const size_t t = tE;
                f32x4 y[4]; float s1 = 0.f;
#pragma unroll
                for (int k = 0; k < 4; ++k) { y[k] = *(const LAS f32x4*)(sl + S3_Y + (es * 64 + 16 * jq + 4 * k) * 4); s1 += (y[k][0] + y[k][1]) + (y[k][2] + y[k][3]); }
                s1 += dppf<0xB1>(s1); s1 += dppf<0x4E>(s1);
                const float mean = s1 * (1.0f / 64.0f); float s2 = 0.f;
#pragma unroll
                for (int k = 0; k < 4; ++k) { y[k] = y[k] - mean; s2 += (y[k][0] * y[k][0] + y[k][1] * y[k][1]) + (y[k][2] * y[k][2] + y[k][3] * y[k][3]); }
                s2 += dppf<0xB1>(s2); s2 += dppf<0x4E>(s2);
                const float rstd = rsqrtf(s2 * (1.0f / 64.0f) + LNX_EPS);
                const float bon = *(const LAS float*)(sl + S3_BON + es * 4);
                const u32x4 vv0 = *(const LAS u32x4*)(sl + S3_VN + es * S3_RS + 32 * jq), vv1 = *(const LAS u32x4*)(sl + S3_VN + es * S3_RS + 32 * jq + 16);
                float gg[16], vv[16];
                gg[0] = bf_lo(g0.x); gg[1] = bf_hi(g0.x); gg[2] = bf_lo(g0.y); gg[3] = bf_hi(g0.y); gg[4] = bf_lo(g0.z); gg[5] = bf_hi(g0.z); gg[6] = bf_lo(g0.w); gg[7] = bf_hi(g0.w);
                gg[8] = bf_lo(g1.x); gg[9] = bf_hi(g1.x); gg[10] = bf_lo(g1.y); gg[11] = bf_hi(g1.y); gg[12] = bf_lo(g1.z); gg[13] = bf_hi(g1.z); gg[14] = bf_lo(g1.w); gg[15] = bf_hi(g1.w);
                vv[0] = bf_lo(vv0.x); vv[1] = bf_hi(vv0.x); vv[2] = bf_lo(vv0.y); vv[3] = bf_hi(vv0.y); vv[4] = bf_lo(vv0.z); vv[5] = bf_hi(vv0.z); vv[6] = bf_lo(vv0.w); vv[7] = bf_hi(vv0.w);
                vv[8] = bf_lo(vv1.x); vv[9] = bf_hi(vv1.x); vv[10] = bf_lo(vv1.y); vv[11] = bf_hi(vv1.y); vv[12] = bf_lo(vv1.z); vv[13] = bf_hi(vv1.z); vv[14] = bf_lo(vv1.w); vv[15] = bf_hi(vv1.w);
                float o[16];
#pragma unroll
                for (int j = 0; j < 16; ++j) o[j] = (y[j >> 2][j & 3] * rstd * lnxg[j] + lnxb[j] + bon * vv[j]) * gg[j];
                u32x4 w0, w1; w0.x = cvt2(o[0], o[1]); w0.y = cvt2(o[2], o[3]); w0.z = cvt2(o[4], o[5]); w0.w = cvt2(o[6], o[7]);
                w1.x = cvt2(o[8], o[9]); w1.y = cvt2(o[10], o[11]); w1.z = cvt2(o[12], o[13]); w1.w = cvt2(o[14], o[15]);
                *(u32x4*)(ycat + t * DM + h * 64 + 16 * jq) = w0; *(u32x4*)(ycat + t * DM + h * 64 + 16 * jq + 8) = w1;
            }
            if (R + 1 < NR) s3_gram_t(F.lds + (4 * ((R + 1) & 1) + wave) * S3_SL, cc, g);
            __builtin_amdgcn_s_setprio(0);
            SC_BAR();
        }
    }
    __syncthreads();
}

constexpr int AT_OST = 0, AT_OST_CH = 4352, AT_ML = 69632, AT_BIAS = 71680, AT_V = 77824, AT_VW = 5120, AT_VRS = 160;
constexpr int AT_BLD = 512, AT_BOFF = 192;
static_assert(AT_V + 8 * AT_VW <= LDSCTL_OFF, "attention LDS map");
constexpr int MW_UNIT = 164;
constexpr int CW_ATTQ = 8192 + 192;
constexpr int CW_GUDONE = 8192 + 224;
constexpr int CW_STAMP = 8192 + 1024;
typedef short at_s16x4 __attribute__((ext_vector_type(4)));
__device__ __forceinline__ u32x2 at_tr16(unsigned a) { return __builtin_bit_cast(u32x2, __builtin_amdgcn_ds_read_tr16_b64_v4i16((LAS at_s16x4*)(__UINTPTR_TYPE__)a)); }
__device__ __forceinline__ void tr_read8(unsigned a, bf16x8 (&vt)[4]) {
#pragma unroll
    for (int mm = 0; mm < 4; ++mm) { const u32x2 r0 = at_tr16(a + 32 * mm), r1 = at_tr16(a + 2560 + 32 * mm); vt[mm] = mk8(r0.x, r0.y, r1.x, r1.y); }
}
static_assert(16 * AT_VRS == 2560, "tr_read8 offsets");
constexpr int AT2_OST = 0, AT2_OST_CH = 2176, AT2_ML = 34816, AT2_BIAS = 36864, AT2_V = 43008;
constexpr int AT_KRS = 144, AT_KW = 32 * AT_KRS, AT_WAVE = 2 * AT_VW + AT_KW;
static_assert(AT2_V + 8 * AT_WAVE <= LDSCTL_OFF, "paired attention LDS map");
struct AtSt { float m, l; f32x4 o[4]; };
__device__ __forceinline__ float rowmax4(float v) {
    const unsigned b = __builtin_bit_cast(unsigned, v);
    const auto r = __builtin_amdgcn_permlane16_swap(b, b, false, false);
    const float f0 = __builtin_bit_cast(float, (unsigned)r[0]), f1 = __builtin_bit_cast(float, (unsigned)r[1]);
    const float m = f0 > f1 ? f0 : f1;
    const unsigned mb = __builtin_bit_cast(unsigned, m);
    const auto q = __builtin_amdgcn_permlane32_swap(mb, mb, false, false);
    const float g0 = __builtin_bit_cast(float, (unsigned)q[0]), g1 = __builtin_bit_cast(float, (unsigned)q[1]);
    return g0 > g1 ? g0 : g1;
}
template <bool SHARED, int YSHIFT>
__device__ __forceinline__ void attn_pair(const bf16_t* projb, int h, int qposX, int qposY, int lq, int lk_start, int ntiles, int dil, int residX, int residY,
                                          const LAS float* biasp, LAS unsigned char* vbufX, LAS unsigned char* vbufY, LAS unsigned char* kst, int lane, AtSt& X, AtSt& Y) {
    const int g = lane >> 4, c = lane & 15;
    bf16x8 qfX[2], qfY[2];
#pragma unroll
    for (int ks = 0; ks < 2; ++ks) { qfX[ks] = *(const bf16x8*)(projb + (size_t)qposX * NPROJ + 1536 + h * 64 + 32 * ks + 8 * g); qfY[ks] = *(const bf16x8*)(projb + (size_t)qposY * NPROJ + 1536 + h * 64 + 32 * ks + 8 * g); }
    const int kt0 = (lk_start < 0) ? ((-lk_start) >> 5) : 0;
    bf16x8 kfX[2][2], kfY[2][2]; u32x4 krX[4], krY[4], vrX[4], vrY[4];
    constexpr int ROWB = NPROJ * 2;
    const char* hb = (const char*)(projb + h * 64);
    const unsigned koX = (unsigned)(((lane >> 3) * dil + residX) * ROWB + (2048 + 8 * (lane & 7)) * 2), koY = (unsigned)(((lane >> 3) * dil + residY) * ROWB + (2048 + 8 * (lane & 7)) * 2);
    const int step8 = 8 * dil * ROWB;
    const __amdgpu_buffer_rsrc_t rs = __builtin_amdgcn_make_buffer_rsrc((void*)hb, 0, 0x7fffffff, 0x00020000);
#define AT2_LOADKV(kr, vr, so, ko) do { \
        _Pragma("unroll") for (int k_ = 0; k_ < 4; ++k_) { kr[k_] = __builtin_amdgcn_raw_buffer_load_b128(rs, ko, (so) + k_ * step8, 0); vr[k_] = __builtin_amdgcn_raw_buffer_load_b128(rs, ko + 1024u, (so) + k_ * step8, 0); } } while (0)
#define AT2_LOADFIRST(kr, vr, resid_) do { \
        _Pragma("unroll") for (int k_ = 0; k_ < 4; ++k_) { int lk_ = lk_start + 32 * kt0 + 8 * k_ + (lane >> 3); lk_ = lk_ < 0 ? 0 : lk_; const unsigned o_ = (unsigned)((lk_ * dil + (resid_)) * ROWB + (2048 + 8 * (lane & 7)) * 2); \
            kr[k_] = __builtin_amdgcn_raw_buffer_load_b128(rs, o_, 0, 0); vr[k_] = __builtin_amdgcn_raw_buffer_load_b128(rs, o_ + 1024u, 0, 0); } } while (0)
#define AT2_KFRAGS(kf, kr) do { \
        _Pragma("unroll") for (int k_ = 0; k_ < 4; ++k_) *(LAS u32x4*)(kst + ((lane >> 3) + 8 * k_) * AT_KRS + (lane & 7) * 16) = kr[k_]; \
        _Pragma("unroll") for (int st = 0; st < 2; ++st) { kf[st][0] = *(const LAS bf16x8*)(kst + (16 * st + c) * AT_KRS + g * 16); kf[st][1] = *(const LAS bf16x8*)(kst + (16 * st + c) * AT_KRS + (4 + g) * 16); } } while (0)
    if (kt0 < ntiles) { AT2_LOADFIRST(krX, vrX, residX); if (!SHARED) AT2_LOADFIRST(krY, vrY, residY); }
    const bool negfirst = (lk_start + 32 * kt0) < 0;
    const unsigned trX = (unsigned)(__UINTPTR_TYPE__)vbufX + (unsigned)((4 * g + ((lane & 15) >> 2)) * AT_VRS + (lane & 3) * 8);
    const unsigned trY = (unsigned)(__UINTPTR_TYPE__)vbufY + (unsigned)((4 * g + ((lane & 15) >> 2)) * AT_VRS + (lane & 3) * 8);
    constexpr float C2 = 0.125f * 1.4426950408889634f;
#pragma unroll 1
    for (int kt = kt0; kt < ntiles; ++kt) {
#pragma unroll
        for (int k = 0; k < 4; ++k) { const int id = lane + 64 * k; *(LAS u32x4*)(vbufX + (id >> 3) * AT_VRS + (id & 7) * 16) = vrX[k]; if (!SHARED) *(LAS u32x4*)(vbufY + (id >> 3) * AT_VRS + (id & 7) * 16) = vrY[k]; }
        AT2_KFRAGS(kfX, krX); if (!SHARED) AT2_KFRAGS(kfY, krY);
        const f32x4 z4 = (f32x4){0.f, 0.f, 0.f, 0.f}; f32x4 sX[2], sY[2];
#pragma unroll
        for (int st = 0; st < 2; ++st) {
            sX[st] = MFMA16(kfX[st][0], qfX[0], z4); sX[st] = MFMA16(kfX[st][1], qfX[1], sX[st]);
            if (SHARED) { sY[st] = MFMA16(kfX[st][0], qfY[0], z4); sY[st] = MFMA16(kfX[st][1], qfY[1], sY[st]); }
            else { sY[st] = MFMA16(kfY[st][0], qfY[0], z4); sY[st] = MFMA16(kfY[st][1], qfY[1], sY[st]); }
        }
        if (kt + 1 < ntiles) { const int so = (lk_start + 32 * (kt + 1)) * dil * ROWB;
            AT2_LOADKV(krX, vrX, so, koX); if (!SHARED) AT2_LOADKV(krY, vrY, so, koY); }
        const int lkb = lk_start + 32 * kt + 4 * g;
        const int rel0 = lq - lkb;
        const LAS float* bp = biasp + (rel0 - 19 + AT_BOFF);
        float biaX[2][4], biaY[2][4];
#pragma unroll
        for (int st = 0; st < 2; ++st)
#pragma unroll
            for (int reg = 0; reg < 4; ++reg) biaX[st][reg] = bp[19 - 16 * st - reg];
#pragma unroll
        for (int reg = 0; reg < 4; ++reg) {
            if (SHARED && YSHIFT == 16) { biaY[0][reg] = bp[35 - reg]; biaY[1][reg] = biaX[0][reg]; }
            else if (SHARED) { biaY[0][reg] = reg ? biaX[0][reg - 1] : bp[19 + YSHIFT]; biaY[1][reg] = reg ? biaX[1][reg - 1] : bp[3 + YSHIFT]; }
            else { biaY[0][reg] = biaX[0][reg]; biaY[1][reg] = biaX[1][reg]; }
        }
        if (negfirst && kt == kt0) {
#pragma unroll
            for (int st = 0; st < 2; ++st)
#pragma unroll
                for (int reg = 0; reg < 4; ++reg) { const bool neg = (lkb + 16 * st + reg) < 0; biaX[st][reg] = neg ? -INFINITY : biaX[st][reg]; biaY[st][reg] = neg ? -INFINITY : biaY[st][reg]; }
        }
        float lgX[2][4], lgY[2][4];
#pragma unroll
        for (int st = 0; st < 2; ++st)
#pragma unroll
            for (int reg = 0; reg < 4; ++reg) { lgX[st][reg] = sX[st][reg] * C2 + biaX[st][reg]; lgY[st][reg] = sY[st][reg] * C2 + biaY[st][reg]; }
        float pX[2][4], pY[2][4]; float psX = 0.f, psY = 0.f;
#pragma unroll
        for (int st = 0; st < 2; ++st)
#pragma unroll
            for (int reg = 0; reg < 4; ++reg) { pX[st][reg] = __builtin_amdgcn_exp2f(lgX[st][reg] - X.m); psX += pX[st][reg];
                                                pY[st][reg] = __builtin_amdgcn_exp2f(lgY[st][reg] - Y.m); psY += pY[st][reg]; }
        if (__builtin_amdgcn_ballot_w64(!(psX <= 256.0f) || !(psY <= 256.0f)) != 0ull) {
            float tmX = fmaxf(fmaxf(lgX[0][0], lgX[0][1]), lgX[0][2]), tmY = fmaxf(fmaxf(lgY[0][0], lgY[0][1]), lgY[0][2]);
            tmX = fmaxf(fmaxf(tmX, lgX[0][3]), lgX[1][0]); tmY = fmaxf(fmaxf(tmY, lgY[0][3]), lgY[1][0]);
            tmX = fmaxf(fmaxf(tmX, lgX[1][1]), lgX[1][2]); tmY = fmaxf(fmaxf(tmY, lgY[1][1]), lgY[1][2]);
            tmX = fmaxf(tmX, lgX[1][3]); tmY = fmaxf(tmY, lgY[1][3]);
            tmX = rowmax4(tmX); tmY = rowmax4(tmY);
            const float mnX = fmaxf(X.m, tmX), mnY = fmaxf(Y.m, tmY);
            const float alX = __builtin_amdgcn_exp2f(X.m - mnX), alY = __builtin_amdgcn_exp2f(Y.m - mnY); X.m = mnX; Y.m = mnY;
            X.l *= alX; Y.l *= alY;
#pragma unroll
            for (int mm = 0; mm < 4; ++mm) { X.o[mm] = X.o[mm] * alX; Y.o[mm] = Y.o[mm] * alY; }
            psX = 0.f; psY = 0.f;
#pragma unroll
            for (int st = 0; st < 2; ++st)
#pragma unroll
                for (int reg = 0; reg < 4; ++reg) { pX[st][reg] = __builtin_amdgcn_exp2f(lgX[st][reg] - mnX); psX += pX[st][reg];
                                                    pY[st][reg] = __builtin_amdgcn_exp2f(lgY[st][reg] - mnY); psY += pY[st][reg]; }
        }
        X.l += psX; Y.l += psY;
        const bf16x8 PbX = mk8(cvt2(pX[0][0], pX[0][1]), cvt2(pX[0][2], pX[0][3]), cvt2(pX[1][0], pX[1][1]), cvt2(pX[1][2], pX[1][3]));
        const bf16x8 PbY = mk8(cvt2(pY[0][0], pY[0][1]), cvt2(pY[0][2], pY[0][3]), cvt2(pY[1][0], pY[1][1]), cvt2(pY[1][2], pY[1][3]));
        bf16x8 vt[4], vu[4]; tr_read8(trX, vt); if (!SHARED) tr_read8(trY, vu);
#pragma unroll
        for (int mm = 0; mm < 4; ++mm) X.o[mm] = MFMA16(vt[mm], PbX, X.o[mm]);
#pragma unroll
        for (int mm = 0; mm < 4; ++mm) Y.o[mm] = MFMA16(SHARED ? vt[mm] : vu[mm], PbY, Y.o[mm]);
    }
#undef AT2_LOADKV
#undef AT2_LOADFIRST
#undef AT2_KFRAGS
}

__device__ __forceinline__ void ph_attn_mfma2(Frame& F) {
    const bf16_t* proj = (const bf16_t*)(F.ws + WS_P); bf16_t* ycat = (bf16_t*)(F.ws + WS_Y); const float* bt = (const float*)(F.ws + WS_BIAS);
    const int lane = F.lane, wave = F.wave, g = lane >> 4, c = lane & 15;
    LAS unsigned char* vbufX = F.lds + AT2_V + wave * AT_WAVE; LAS unsigned char* vbufY = vbufX + AT_VW; LAS unsigned char* kst = vbufX + 2 * AT_VW;
    LAS float* biasl = (LAS float*)(F.lds + AT2_BIAS);
    int hload = -1;
    for (;;) {
        if (F.tid == 0) F.MISC[MW_UNIT] = atomicAdd(F.ctl + CW_ATTQ, 1u);
        __syncthreads();
        const int unit = __builtin_amdgcn_readfirstlane((int)F.MISC[MW_UNIT]);
        if (unit >= NB * 8 * 8) break;
        int u, b, h; if (unit < NB * 8 * 7) { h = unit / (NB * 7); const int r_ = unit % (NB * 7); b = r_ / 7; u = 1 + r_ % 7; } else { const int r_ = unit - NB * 8 * 7; h = r_ / NB; b = r_ % NB; u = 0; }
        if (h != hload) { hload = h;
            for (int i = F.tid; i < 3 * AT_BLD; i += 512) { const int p_ = i / AT_BLD, rel_ = (i % AT_BLD) - AT_BOFF; biasl[i] = (rel_ >= 0 && rel_ <= 128) ? 1.4426950408889634f * bt[(p_ * 8 + h) * BIAS_LD + rel_] : -INFINITY; }
            __syncthreads(); }
        const bf16_t* projb = proj + (size_t)b * SEQ * NPROJ;
        AtSt X, Y;
        {
            const int base = 256 * u + 32 * wave;
            X.m = -1e30f; X.l = 0.f; Y.m = -1e30f; Y.l = 0.f;
#pragma unroll
            for (int mm = 0; mm < 4; ++mm) { X.o[mm] = (f32x4){0.f, 0.f, 0.f, 0.f}; Y.o[mm] = (f32x4){0.f, 0.f, 0.f, 0.f}; }
            attn_pair<true, 16>(projb, h, base + c, base + 16 + c, base + c, base - 128, 5, 1, 0, 0, biasl, vbufX, vbufX, kst, lane, X, Y);
            X.l += __shfl_xor(X.l, 16); X.l += __shfl_xor(X.l, 32); Y.l += __shfl_xor(Y.l, 16); Y.l += __shfl_xor(Y.l, 32);
#pragma unroll
            for (int t2 = 0; t2 < 2; ++t2) { const AtSt& S = t2 ? Y : X; const int ql = 32 * wave + 16 * t2 + c, qp = ql + (ql >> 4);
#pragma unroll
                for (int mm = 0; mm < 4; ++mm) { u32x2 w; w.x = cvt2(S.o[mm][0], S.o[mm][1]); w.y = cvt2(S.o[mm][2], S.o[mm][3]); *(LAS u32x2*)(F.lds + AT2_OST + (mm * 4 + g) * AT2_OST_CH + qp * 8) = w; }
                if (g == 0) { *(LAS float*)(F.lds + AT2_ML + ql * 4) = S.m; *(LAS float*)(F.lds + AT2_ML + 1024 + ql * 4) = S.l; } }
        }
        __syncthreads();
        {
            const int d0 = (wave & 3) + 8 * (wave >> 2);
#pragma unroll
            for (int t2 = 0; t2 < 2; ++t2) { AtSt& S = t2 ? Y : X; const int ql = 16 * c + d0 + 4 * t2, qp = ql + (ql >> 4);
                S.m = *(const LAS float*)(F.lds + AT2_ML + ql * 4); S.l = (g == 0) ? *(const LAS float*)(F.lds + AT2_ML + 1024 + ql * 4) : 0.f;
#pragma unroll
                for (int mm = 0; mm < 4; ++mm) { const u32x2 w = *(const LAS u32x2*)(F.lds + AT2_OST + (mm * 4 + g) * AT2_OST_CH + qp * 8);
                    S.o[mm] = (f32x4){bf_lo(w.x), bf_hi(w.x), bf_lo(w.y), bf_hi(w.y)}; } }
            const int qposX = 256 * u + 16 * c + d0, qposY = qposX + 4;
            attn_pair<true, 1>(projb, h, qposX, qposY, 64 * u + 4 * c + (d0 >> 2), 64 * u + 61 + (d0 >> 2) - 191, 6, 4, d0 & 3, d0 & 3, biasl + AT_BLD, vbufX, vbufX, kst, lane, X, Y);
            attn_pair<false, 0>(projb, h, qposX, qposY, 16 * u + c, 16 * u - 144, 5, 16, d0, d0 + 4, biasl + 2 * AT_BLD, vbufX, vbufY, kst, lane, X, Y);
#pragma unroll
            for (int t2 = 0; t2 < 2; ++t2) { AtSt& S = t2 ? Y : X; float l = S.l; l += __shfl_xor(l, 16); l += __shfl_xor(l, 32); const float inv = 1.0f / l;
                bf16_t* op = ycat + ((size_t)b * SEQ + qposX + 4 * t2) * DM + 512 + h * 64 + 4 * g;
#pragma unroll
                for (int mm = 0; mm < 4; ++mm) { u32x2 w; w.x = cvt2(S.o[mm][0] * inv, S.o[mm][1] * inv); w.y = cvt2(S.o[mm][2] * inv, S.o[mm][3] * inv); *(u32x2*)(op + 16 * mm) = w; } }
        }
        __syncthreads();
        moe_weight_items3(F, unit * MOE_ROUNDS_PER_UNIT * NWAVES + wave, (LAS float*)(F.lds + AT2_V + wave * 8448));
        late_prologue_items(F, unit, (LAS float*)(F.lds + AT2_V + wave * 8448));
    }
}

constexpr int LR_XH = 0, LR_XL = 33280, LR_RS = 2064, LR_PP = 66560, LR_LG = 91136, LR_GB = 94208, LR_TOKE = 102400, LR_TOKW = 103424;
#define LR_BAR() do { asm volatile("s_waitcnt lgkmcnt(0)" ::: "memory"); __builtin_amdgcn_s_barrier(); asm volatile("" ::: "memory"); } while (0)
__device__ __forceinline__ void ph_ln1_router_mfma(Frame& F) {
    const int lane = F.lane, wave = F.wave, g = lane >> 4, c = lane & 15;
    if (F.tid < 32) F.MISC[MW_HIST + F.tid] = 0u;
    bf16_t* x1b = (bf16_t*)(F.ws + WS_Y);
    int* toke = (int*)(F.ws + WS_TOKE); float* tokw = (float*)(F.ws + WS_TOKW);
    const bf16_t* wrt = (const bf16_t*)(F.ws + WS_WRT);
    bf16x8 wf[2][4][3];
#pragma unroll
    for (int hl = 0; hl < 2; ++hl)
#pragma unroll
        for (int ks = 0; ks < 4; ++ks)
#pragma unroll
            for (int nt = 0; nt < 3; ++nt) wf[hl][ks][nt] = *(const bf16x8*)(wrt + (size_t)hl * 48 * 1024 + (size_t)(16 * nt + c) * 1024 + 128 * wave + 32 * ks + 8 * g);
    for (int i = F.tid; i < DM / 4; i += 512) { *(LAS f32x4*)(F.lds + LR_GB + i * 16) = *(const f32x4*)(F.in[I_LN1G] + 4 * i); *(LAS f32x4*)(F.lds + LR_GB + 4096 + i * 16) = *(const f32x4*)(F.in[I_LN1B] + 4 * i); }
    float rbias0, rbias1;
    { const int c0 = F.tid % 48, c1 = (F.tid + 512) % 48;
      rbias0 = (c0 < 4) ? F.in[I_RGB][c0] : (c0 < 36) ? F.in[I_REB][c0 - 4] : 0.f;
      rbias1 = (c1 < 4) ? F.in[I_RGB][c1] : (c1 < 36) ? F.in[I_REB][c1 - 4] : 0.f; }
    const int rows_per_wg = NTOK / F.G;
    const int ngrp = rows_per_wg / 16;
    __syncthreads();
    f32x4 pxv[2][4]; u32x2 pmw[2][4];
#define LR_PREFETCH(grp_) do { _Pragma("unroll") for (int rr_ = 0; rr_ < 2; ++rr_) { const int row_ = F.vcu * rows_per_wg + 16 * (grp_) + 2 * wave + rr_; \
        const float* xin_ = F.in[I_X] + (size_t)row_ * DM + 4 * lane; const bf16_t* mx_ = (const bf16_t*)(F.ws + WS_HDN) + (size_t)row_ * DM + 4 * lane; \
        _Pragma("unroll") for (int j_ = 0; j_ < 4; ++j_) { pxv[rr_][j_] = __builtin_nontemporal_load((const f32x4*)(xin_ + 256 * j_)); pmw[rr_][j_] = __builtin_nontemporal_load((const u32x2*)(mx_ + 256 * j_)); } } } while (0)
    LR_PREFETCH(0);
#pragma unroll 1
    for (int grp = 0; grp < ngrp; ++grp) {
        const int row0 = F.vcu * rows_per_wg + 16 * grp;
#pragma unroll
        for (int rr = 0; rr < 2; ++rr) {
            const int rl = 2 * wave + rr, row = row0 + rl;
            f32x4 v[4]; float s = 0.f;
#pragma unroll
            for (int j = 0; j < 4; ++j) { const f32x4 xv = pxv[rr][j]; const u32x2 mw = pmw[rr][j];
                v[j] = xv * ALPHA + (f32x4){bf_lo(mw.x), bf_hi(mw.x), bf_lo(mw.y), bf_hi(mw.y)}; s += (v[j][0] + v[j][1]) + (v[j][2] + v[j][3]); }
            const float mean = wave_sum_u(s) * (1.0f / DM); float s2 = 0.f;
#pragma unroll
            for (int j = 0; j < 4; ++j) { v[j] = v[j] - mean; s2 += (v[j][0] * v[j][0] + v[j][1] * v[j][1]) + (v[j][2] * v[j][2] + v[j][3] * v[j][3]); }
            const float rstd = rsqrtf(wave_sum_u(s2) * (1.0f / DM) + LN_EPS);
#pragma unroll
            for (int j = 0; j < 4; ++j) { const f32x4 gvj = *(const LAS f32x4*)(F.lds + LR_GB + (lane + 64 * j) * 16), bvj = *(const LAS f32x4*)(F.lds + LR_GB + 4096 + (lane + 64 * j) * 16);
                v[j] = v[j] * rstd * gvj + bvj;
                u32x2 wh; wh.x = cvt2(v[j][0], v[j][1]); wh.y = cvt2(v[j][2], v[j][3]);
                *(u32x2*)(x1b + (size_t)row * DM + 4 * lane + 256 * j) = wh;
                float lo[4];
                lo[0] = v[j][0] - bf_lo(wh.x); lo[1] = v[j][1] - bf_hi(wh.x); lo[2] = v[j][2] - bf_lo(wh.y); lo[3] = v[j][3] - bf_hi(wh.y);
                u32x2 wl; wl.x = cvt2(lo[0], lo[1]); wl.y = cvt2(lo[2], lo[3]);
                *(LAS u32x2*)(F.lds + LR_XH + rl * LR_RS + (4 * lane + 256 * j) * 2) = wh;
                *(LAS u32x2*)(F.lds + LR_XL + rl * LR_RS + (4 * lane + 256 * j) * 2) = wl; }
        }
        if (grp + 1 < ngrp) LR_PREFETCH(grp + 1);
        LR_BAR();
        {
            f32x4 acc[3];
#pragma unroll
            for (int nt = 0; nt < 3; ++nt) acc[nt] = (f32x4){0.f, 0.f, 0.f, 0.f};
#pragma unroll
            for (int ks = 0; ks < 4; ++ks) {
                const int off = c * LR_RS + (128 * wave + 32 * ks + 8 * g) * 2;
                const bf16x8 ah = *(const LAS bf16x8*)(F.lds + LR_XH + off), al = *(const LAS bf16x8*)(F.lds + LR_XL + off);
#pragma unroll
                for (int nt = 0; nt < 3; ++nt) { acc[nt] = MFMA16(ah, wf[0][ks][nt], acc[nt]); acc[nt] = MFMA16(al, wf[0][ks][nt], acc[nt]); acc[nt] = MFMA16(ah, wf[1][ks][nt], acc[nt]); }
            }
#pragma unroll
            for (int nt = 0; nt < 3; ++nt)
#pragma unroll
                for (int reg = 0; reg < 4; ++reg) *(LAS float*)(F.lds + LR_PP + ((wave * 16 + 4 * g + reg) * 48 + 16 * nt + c) * 4) = acc[nt][reg];
        }
        LR_BAR();
        for (int i = F.tid, it_ = 0; i < 16 * 48; i += 512, ++it_) { float a = it_ ? rbias1 : rbias0;
#pragma unroll
            for (int w = 0; w < 8; ++w) a += *(const LAS float*)(F.lds + LR_PP + (w * 16 * 48 + i) * 4);
            *(LAS float*)(F.lds + LR_LG + i * 4) = a; }
        LR_BAR();
        if (F.tid < 16) {
            const int row = row0 + F.tid; const LAS float* lgp = (const LAS float*)(F.lds + LR_LG + F.tid * 48 * 4);
            float gl[4];
#pragma unroll
            for (int i = 0; i < 4; ++i) gl[i] = lgp[i];
            int grpi = 0; float gm = gl[0];
#pragma unroll
            for (int i = 1; i < 4; ++i) if (gl[i] > gm) { gm = gl[i]; grpi = i; }
            float se = 0.f;
#pragma unroll
            for (int i = 0; i < 4; ++i) se += __expf(gl[i] - gm);
            const float wg = 1.0f / se;
            float le[8];
#pragma unroll
            for (int i = 0; i < 8; ++i) le[i] = lgp[4 + grpi * 8 + i];
            int i0 = 0; float v0 = le[0];
#pragma unroll
            for (int i = 1; i < 8; ++i) if (le[i] > v0) { v0 = le[i]; i0 = i; }
            int i1 = (i0 == 0) ? 1 : 0; float v1 = (i0 == 0) ? le[1] : le[0];
#pragma unroll
            for (int i = 0; i < 8; ++i) if (i != i0 && le[i] > v1) { v1 = le[i]; i1 = i; }
            const float e1 = __expf(v1 - v0); const float w0 = wg / (1.0f + e1), w1 = wg * e1 / (1.0f + e1);
            const int ex0 = grpi * 8 + i0, ex1 = grpi * 8 + i1;
            const unsigned ix0 = atomicAdd((unsigned*)&F.MISC[MW_HIST + ex0], 1u), ix1 = atomicAdd((unsigned*)&F.MISC[MW_HIST + ex1], 1u);
            const int al = 2 * (16 * grp + (int)F.tid);
            *(LAS unsigned*)(F.lds + LR_TOKE + al * 4) = (unsigned)ex0 | (ix0 << 5); *(LAS unsigned*)(F.lds + LR_TOKE + al * 4 + 4) = (unsigned)ex1 | (ix1 << 5);
            *(LAS float*)(F.lds + LR_TOKW + al * 4) = w0; *(LAS float*)(F.lds + LR_TOKW + al * 4 + 4) = w1;
        }
    }
    __syncthreads();
    if (F.tid < 32) { const unsigned hc = F.MISC[MW_HIST + F.tid]; F.MISC[MW_LBASE + F.tid] = hc ? atomicAdd(F.ctl + CW_CNT + F.tid, hc) : 0u; }
}

__device__ __forceinline__ void ph_positions(Frame& F) {
    int* row_tok = (int*)(F.ws + WS_ROWTOK); int* row_asg = (int*)(F.ws + WS_ROWASG); float* row_w = (float*)(F.ws + WS_ROWW);
    unsigned cnt = 0u;
    if (F.tid < 32) { cnt = __hip_atomic_load(F.ctl + CW_CNT + F.tid, RLX_AGENT); F.MISC[MW_CNT + F.tid] = cnt; }
    __syncthreads();
    if (F.tid < 32) {
        unsigned rs = 0u;
        for (int e = 0; e < (int)F.tid; ++e) rs += ((F.MISC[MW_CNT + e] + 255u) >> 8) << 8;
        F.MISC[MW_RS + F.tid] = rs;
        if (blockIdx.x == 0) { const unsigned nt = (cnt + 255u) >> 8;
            for (unsigned q = 0; q < nt; ++q) F.ctl[CW_TILEE + (rs >> 8) + q] = (unsigned)F.tid;
            if (F.tid == 31) F.ctl[CW_NTILES] = (rs >> 8) + nt; }
    }
    __syncthreads();
    const int per = NTOK / F.G;
    const int base = F.vcu * per;
    for (int a = F.tid; a < 2 * per; a += 512) {
        const unsigned pk = *(const LAS unsigned*)(F.lds + LR_TOKE + a * 4); const int e = (int)(pk & 31u), idx = (int)(pk >> 5);
        const int tok = base + (a >> 1);
        const unsigned pos = F.MISC[MW_RS + e] + F.MISC[MW_LBASE + e] + (unsigned)idx;
        row_tok[pos] = tok; row_asg[pos] = 2 * tok + (a & 1); row_w[pos] = *(const LAS float*)(F.lds + LR_TOKW + a * 4);
    }
    if (F.vcu < 32) { const int e = F.vcu; const unsigned cn = F.MISC[MW_CNT + e], rs = F.MISC[MW_RS + e], end = ((cn + 255u) >> 8) << 8;
        for (unsigned r = cn + F.tid; r < end; r += 512) { row_tok[rs + r] = 0; row_asg[rs + r] = -1; row_w[rs + r] = 0.f; } }
}

__device__ __forceinline__ void ph_final(Frame& F) {
    const int gw = F.vcu * NWAVES + F.wave, NGW = F.G * NWAVES, lane = F.lane;
    const bf16_t* x1b = (const bf16_t*)(F.ws + WS_Y); const bf16_t* mo = (const bf16_t*)(F.ws + WS_X1); const bf16_t* ple = (const bf16_t*)(F.ws + WS_PLE);
    f32x4 gv[4], bv[4];
#pragma unroll
    for (int j = 0; j < 4; ++j) { gv[j] = *(const f32x4*)(F.in[I_LN2G] + 4 * lane + 256 * j); bv[j] = *(const f32x4*)(F.in[I_LN2B] + 4 * lane + 256 * j); }
    for (int row = gw; row < NTOK; row += NGW) {
        const bf16_t* m0 = mo + (size_t)(2 * row) * DM;
        f32x4 v[4]; float s = 0.f;
#pragma unroll
        for (int j = 0; j < 4; ++j) { const int cix = 4 * lane + 256 * j;
            const u32x2 pw = __builtin_nontemporal_load((const u32x2*)(ple + (size_t)row * DM + cix));
            const u32x2 a = __builtin_nontemporal_load((const u32x2*)(m0 + cix)), b = __builtin_nontemporal_load((const u32x2*)(m0 + DM + cix));
            f32x4 mv; mv[0] = bf_lo(a.x) + bf_lo(b.x); mv[1] = bf_hi(a.x) + bf_hi(b.x); mv[2] = bf_lo(a.y) + bf_lo(b.y); mv[3] = bf_hi(a.y) + bf_hi(b.y);
            const f32x4 pv = (f32x4){bf_lo(pw.x), bf_hi(pw.x), bf_lo(pw.y), bf_hi(pw.y)};
            v[j] = mv + pv; s += (v[j][0] + v[j][1]) + (v[j][2] + v[j][3]); }
        const float mean = wave_sum_u(s) * (1.0f / DM); float s2 = 0.f;
#pragma unroll
        for (int j = 0; j < 4; ++j) { v[j] = v[j] - mean; s2 += (v[j][0] * v[j][0] + v[j][1] * v[j][1]) + (v[j][2] * v[j][2] + v[j][3] * v[j][3]); }
        const float rstd = rsqrtf(wave_sum_u(s2) * (1.0f / DM) + LN_EPS);
#pragma unroll
        for (int j = 0; j < 4; ++j) __builtin_nontemporal_store(v[j] * rstd * gv[j] + bv[j], (f32x4*)(F.out + (size_t)row * DM + 4 * lane + 256 * j));
    }
}

constexpr int NPHASE = 10;
struct Args { const float* in[33]; float* out; unsigned char* ws; int ph_lo, ph_hi; };
#ifndef PH_MASK
#define PH_MASK 0x3ff
#endif
__global__ void __launch_bounds__(NWAVES * 64, 2) hymba_fwd(const Args args) {
    extern __shared__ __attribute__((aligned(16))) unsigned char lds[];
    Frame F;
    F.lds = (LAS unsigned char*)lds;
    F.MISC = (volatile LAS unsigned*)(F.lds + MISC_OFF);
    F.tid = threadIdx.x; F.lane = F.tid & 63; F.wave = __builtin_amdgcn_readfirstlane(F.tid >> 6);
    F.G = gridDim.x; { const int bx = blockIdx.x; F.vcu = (F.G % 8 == 0) ? (bx % 8) * (F.G / 8) + bx / 8 : bx; }
    F.ws = args.ws; F.ctl = (unsigned*)(args.ws + WS_CTL); F.out = args.out;
    F.in = args.in;
    for (int u = F.tid; u < (LDS_BYTES - LDSCTL_OFF) / 4; u += NWAVES * 64) ((LAS unsigned*)(F.lds + LDSCTL_OFF))[u] = 0u;
    __syncthreads();
    const int lo = args.ph_lo, hi = args.ph_hi;
    XcdBarrier bar; bar.bar = F.ctl + CW_BAR; bar.x = 0; bar.st = nullptr;
    if (hi - lo > 1) bar = xcd_barrier_post(F.ctl + CW_BAR, F.MISC + MW_BAR);
#define IN(k) (((PH_MASK >> (k)) & 1) && lo <= (k) && (k) < hi)
#ifdef PROBE_T
#define STAMP(k) do { if (blockIdx.x == 0 && F.tid == 0) { const unsigned long long ts_ = wall_clock64(); F.ctl[CW_STAMP + 2 * (k)] = (unsigned)ts_; F.ctl[CW_STAMP + 2 * (k) + 1] = (unsigned)(ts_ >> 32); } } while (0)
#else
#define STAMP(k) do { } while (0)
#endif
#define SEAM(k) do { if (IN(k) && IN((k) + 1)) xcd_barrier(bar); STAMP((k) + 1); } while (0)
    LAS unsigned char* ring = F.lds + RING_OFF;

    STAMP(0);
    if (IN(0)) { ph_prologue(F); } SEAM(0);
    if (IN(1)) {
        pg8::Gemm g{(const bf16_t*)(F.ws + WS_XB), (const bf16_t*)(F.ws + WS_WINT), DM}; pg8::StaticOrder S; S.init(NTOK, NEXT, F.G, (int)blockIdx.x);
        EpiProj E{(bf16_t*)(F.ws + WS_P), (bf16_t*)(F.ws + WS_LORA1)};
        pg8::gemm_phase<EpiProj, pg8::StaticOrder>(ring, g, S, E);
        ph_prologue_small(F);
    } SEAM(1);
    if (IN(2)) { ph_lora_act(F); } SEAM(2);
    if (IN(3)) {
        pg8::Gemm g{(const bf16_t*)(F.ws + WS_Y), (const bf16_t*)(F.ws + WS_W2T), KL2}; pg8::LoraOrder S; S.init(NTOK, NL2, F.G, (int)blockIdx.x);
        EpiDag E{(bf16_t*)(F.ws + WS_LW), (bf16_t*)(F.ws + WS_AG), F.in[I_W0], F.in[I_A0]};
        pg8::gemm_phase<EpiDag, pg8::LoraOrder>(ring, g, S, E);
    } SEAM(3);
    if (IN(4)) { ph_scan_pipe3(F); ph_attn_mfma2(F); } SEAM(4);
    if (IN(5)) {
        pg8::Gemm g{(const bf16_t*)(F.ws + WS_Y), (const bf16_t*)(F.ws + WS_WOT), DM}; pg8::StaticOrder S; S.init(NTOK, DM, F.G, (int)blockIdx.x);
        EpiWo E{(bf16_t*)(F.ws + WS_HDN)};
        pg8::gemm_phase<EpiWo, pg8::StaticOrder>(ring, g, S, E);
    } SEAM(5);
    if (IN(6)) { ph_ln1_router_mfma(F); } SEAM(6);
    if (IN(7)) { ph_positions(F); } SEAM(7);
    if (IN(8)) {
        {
            pg8::MoeOrder<true> S{(const int*)(F.ctl + CW_TILEE), (const int*)(F.ws + WS_ROWTOK), (int)__hip_atomic_load(F.ctl + CW_NTILES, RLX_AGENT), F.G, F.vcu};
            pg8::Gemm g{(const bf16_t*)(F.ws + WS_Y), (const bf16_t*)(F.ws + WS_WGUT), DM};
            EpiGU E{(bf16_t*)(F.ws + WS_HDN)};
            pg8::gemm_phase<EpiGU, pg8::MoeOrder<true>>(ring, g, S, E);
        }
        if (F.tid == 0) {
            __builtin_amdgcn_fence(__ATOMIC_RELEASE, "agent");
            asm volatile("s_waitcnt vmcnt(0)" ::: "memory");
            (void)__hip_atomic_fetch_add(F.ctl + CW_GUDONE, 1u, RLX_AGENT);
        }
        {
            pg8::Gemm g{(const bf16_t*)(F.ws + WS_PB), (const bf16_t*)(F.ws + WS_PT), 256}; pg8::StaticOrder S; S.init(NTOK, DM, F.G, (int)blockIdx.x);
            EpiBf E{(bf16_t*)(F.ws + WS_PLE), DM};
            pg8::gemm_phase<EpiBf, pg8::StaticOrder>(ring, g, S, E);
        }
        {
            pg8::Gemm g{(const bf16_t*)(F.ws + WS_Y), (const bf16_t*)(F.ws + WS_GT), DM}; pg8::StaticOrder S; S.init(NTOK, DM, F.G, (int)blockIdx.x);
            EpiPle E{(bf16_t*)(F.ws + WS_PLE), DM, (const bf16_t*)(F.ws + WS_Y)};
            pg8::gemm_phase<EpiPle, pg8::StaticOrder>(ring, g, S, E);
        }
        if (F.tid == 0) {
            unsigned* barw = F.ctl + CW_BAR;
            XB_SPIN(__hip_atomic_load(F.ctl + CW_GUDONE, RLX_AGENT) < (unsigned)F.G, barw);
            __builtin_amdgcn_fence(__ATOMIC_ACQUIRE, "agent");
            asm volatile("s_waitcnt vmcnt(0)" ::: "memory");
        }
        __syncthreads();
        {
            pg8::MoeDownOrder S{(const int*)(F.ctl + CW_TILEE), (int)__hip_atomic_load(F.ctl + CW_NTILES, RLX_AGENT), F.G, F.vcu};
            pg8::Gemm g{(const bf16_t*)(F.ws + WS_HDN), (const bf16_t*)(F.ws + WS_WDT), DEXP};
            EpiDown E{(bf16_t*)(F.ws + WS_X1), (bf16_t*)(F.ws + WS_X1), (const int*)(F.ws + WS_ROWASG), (const float*)(F.ws + WS_ROWW)};
            pg8::gemm_phase<EpiDown, pg8::MoeDownOrder>(ring, g, S, E);
        }
    } SEAM(8);
    if (IN(9)) { ph_final(F); }
#undef IN
#undef SEAM
}

extern "C" void kernel_launch(void* const* d_in, const int* in_sizes, int n_in, void* d_out, int out_size, void* d_ws, size_t ws_size, hipStream_t stream) {
    static int grid = 0;
    if (grid == 0) {
        if (n_in != 33 || in_sizes[0] != NTOK * DM || out_size != NTOK * DM || ws_size < WS_END) { fprintf(stderr, "kernel_launch: unexpected problem (n_in %d, in0 %d, out %d, ws %zu)\n", n_in, n_in > 0 ? in_sizes[0] : -1, out_size, ws_size); grid = -1; return; }
        int dev = 0, cus = 0;
        if (hipGetDevice(&dev) != hipSuccess || hipDeviceGetAttribute(&cus, hipDeviceAttributeMultiprocessorCount, dev) != hipSuccess) { grid = -1; return; }
        if (hipFuncSetAttribute((const void*)hymba_fwd, hipFuncAttributeMaxDynamicSharedMemorySize, LDS_BYTES) != hipSuccess) { fprintf(stderr, "kernel_launch: hipFuncSetAttribute failed\n"); grid = -1; return; }
        int per_cu = 0;
        if (hipOccupancyMaxActiveBlocksPerMultiprocessor(&per_cu, (const void*)hymba_fwd, NWAVES * 64, LDS_BYTES) != hipSuccess || per_cu < 1) fprintf(stderr, "kernel_launch: occupancy query reports %d\n", per_cu);
        (void)hipGetLastError();
        grid = cus;
    }
    if (grid < 0) return;
    if (hipMemsetAsync((char*)d_ws + WS_CTL, 0, CTL_ZERO_BYTES, stream) != hipSuccess) return;
    Args a{};
    for (int i = 0; i < 33; ++i) a.in[i] = (const float*)d_in[i];
    a.out = (float*)d_out; a.ws = (unsigned char*)d_ws;
#if MK_ONE_LAUNCH
    a.ph_lo = 0; a.ph_hi = NPHASE;
    hipLaunchKernelGGL(hymba_fwd, dim3(grid), dim3(NWAVES * 64), LDS_BYTES, stream, a);
#else
    for (int ph = 0; ph < NPHASE; ++ph) { a.ph_lo = ph; a.ph_hi = ph + 1; hipLaunchKernelGGL(hymba_fwd, dim3(grid), dim3(NWAVES * 64), LDS_BYTES, stream, a); }
#endif
}
```

```cpp
#include <hip/hip_runtime.h>
#include <cstdio>
#include <cstdint>

#ifndef MK_ONE_LAUNCH
#define MK_ONE_LAUNCH 1
#endif

#define GAS __attribute__((address_space(1)))
#define LAS __attribute__((address_space(3)))
typedef unsigned short bf16_t;
typedef short bf16x8 __attribute__((ext_vector_type(8)));
typedef float f32x4 __attribute__((ext_vector_type(4)));
typedef float f32x2 __attribute__((ext_vector_type(2)));
typedef unsigned u32x4 __attribute__((ext_vector_type(4)));
typedef unsigned u32x2 __attribute__((ext_vector_type(2)));
#define RLX_AGENT __ATOMIC_RELAXED, __HIP_MEMORY_SCOPE_AGENT
#define LDS_WAIT() asm volatile("s_waitcnt lgkmcnt(0)" ::: "memory")
#define VM_WAIT() asm volatile("s_waitcnt vmcnt(0)" ::: "memory")

__device__ __forceinline__ unsigned f2bf(float f) { unsigned u = __builtin_bit_cast(unsigned, f); return (u + 0x7fffu + ((u >> 16) & 1u)) >> 16; }
typedef __bf16 bf16v2_t __attribute__((ext_vector_type(2)));
__device__ __forceinline__ unsigned cvt2(float lo, float hi) { bf16v2_t v; v.x = (__bf16)lo; v.y = (__bf16)hi; return __builtin_bit_cast(unsigned, v); }
__device__ __forceinline__ unsigned pk2(float lo, float hi) { return cvt2(lo, hi); }
__device__ __forceinline__ float bf_lo(unsigned w) { return __builtin_bit_cast(float, w << 16); }
__device__ __forceinline__ float bf_hi(unsigned w) { return __builtin_bit_cast(float, w & 0xffff0000u); }
__device__ __forceinline__ float bf2f(bf16_t b) { return __builtin_bit_cast(float, ((unsigned)b) << 16); }
__device__ __forceinline__ float sigmoidf_(float z) { return __builtin_amdgcn_rcpf(1.0f + __builtin_amdgcn_exp2f(-1.4426950408889634f * z)); }
__device__ __forceinline__ float wave_sum(float v) {
#pragma unroll
    for (int o = 1; o < 64; o <<= 1) v += __shfl_xor(v, o);
    return v;
}

namespace pg8 {
constexpr int BM = 256, BK = 64, HALF = 128, HTB = HALF * BK * 2, STAGE_BYTES = 8 * HTB, NXCD = 8, WGM = 8;
__host__ __device__ __forceinline__ int lds_byte(int r, int c) { const int st = (r >> 4) * 2 + (c >> 5), rr = r & 15, cc = c & 31, ob = rr * 64 + cc * 2; return st * 1024 + (ob ^ (((ob >> 9) & 1) << 5)); }
__host__ __device__ __forceinline__ void stage_rc(int b, int& R, int& C) { const int st = b / 1024, sb = b % 1024, swz = sb ^ (((sb >> 9) & 1) << 5); R = (st >> 1) * 16 + swz / 64; C = (st & 1) * 32 + (swz % 64) / 2; }
__host__ __device__ __forceinline__ int perm32(int rho) { const int n = rho >> 4, i = rho & 15; return 8 * (i >> 2) + 4 * n + (i & 3); }

struct Unit { int pm, pn, pb; };
struct Gemm { const bf16_t* A; const bf16_t* Bt; int K; };

struct StaticOrder {
    static constexpr bool GATHER = false;
    int nM, nN, nwg, G, c;
    __device__ void init(int M, int N, int G_, int c_) { nM = M / BM; nN = N / BM; nwg = nM * nN; G = G_; c = c_; }
    __device__ bool next(int i, Unit& u) const {
        const long L = (long)i * G + c; if (L >= nwg) return false;
        int wgid = (int)L; { const int q = nwg / NXCD, r = nwg % NXCD, xcd = wgid % NXCD, off = wgid / NXCD; wgid = (xcd < r ? xcd * (q + 1) : r * (q + 1) + (xcd - r) * q) + off; }
        const int nig = WGM * nN, gid = wgid / nig, fm = gid * WGM, gsz = (nM - fm) < WGM ? (nM - fm) : WGM;
        u.pm = fm + ((wgid % nig) % gsz); u.pn = (wgid % nig) / gsz; u.pb = u.pn; return true;
    }
    __device__ __forceinline__ unsigned a_row_off(const Unit&, int, unsigned) const { return 0u; }
    __device__ __forceinline__ int koff(const Unit&) const { return 0; }
    __device__ __forceinline__ int ntk(const Unit&, int nt_full) const { return nt_full; }
};
struct LoraOrder : StaticOrder {
    __device__ __forceinline__ int koff(const Unit& u) const { return u.pn >= 4 ? 128 : 0; }
    __device__ __forceinline__ int ntk(const Unit& u, int) const { return 2 + ((u.pn >> 6) << 1); }
};
template <bool GATHER_> struct MoeOrder {
    static constexpr bool GATHER = GATHER_;
    const int* tile_e; const int* row_tok; int ntiles, G, c;
    __device__ bool next(int i, Unit& u) const {
        const long L = (long)i * G + c; if (L >= (long)ntiles * 4) return false;
        const int tile = (int)(L >> 2), pn = (int)(L & 3);
        u.pm = tile; u.pn = pn; u.pb = tile_e[tile] * 4 + pn; return true;
    }
    __device__ __forceinline__ unsigned a_row_off(const Unit& u, int r, unsigned rowbytes) const { return (unsigned)row_tok[u.pm * 256 + r] * rowbytes; }
    __device__ __forceinline__ int koff(const Unit&) const { return 0; }
    __device__ __forceinline__ int ntk(const Unit&, int nt_full) const { return nt_full; }
};

struct MoeDownOrder {
    static constexpr bool GATHER = false;
    const int* tile_e; int ntiles, G, vcu;
    __device__ bool next(int i, Unit& u) const {
        const int NU = ntiles * 4, rem = NU % G, nB = G - rem; long d;
        if (vcu >= rem) { const int ib = vcu - rem; d = (i < 2) ? (long)i * nB + ib : 2L * nB + (long)(i - 2) * G + ib; }
        else d = 2L * nB + (long)i * G + nB + vcu;
        if (d >= NU) return false;
        const int tile = (int)(d >> 2), pn = (int)(d & 3);
        u.pm = tile; u.pn = pn; u.pb = tile_e[tile] * 4 + pn; return true;
    }
    __device__ __forceinline__ unsigned a_row_off(const Unit&, int, unsigned) const { return 0u; }
    __device__ __forceinline__ int koff(const Unit&) const { return 0; }
    __device__ __forceinline__ int ntk(const Unit&, int nt_full) const { return nt_full; }
};

__device__ __forceinline__ unsigned cvt_pk_bf16(float lo, float hi) { unsigned r; asm volatile("v_cvt_pk_bf16_f32 %0, %1, %2" : "=v"(r) : "v"(lo), "v"(hi)); return r; }

template <class Epi, class Sched>
__device__ __forceinline__ void gemm_phase(LAS unsigned char* lds, const Gemm g, const Sched& S, const Epi& E) {
    const int tid = threadIdx.x, wid = __builtin_amdgcn_readfirstlane(tid >> 6), lane = tid & 63, wr = wid >> 2, wc = wid & 3, fr = lane & 15, fq = lane >> 4;
    const int K = g.K, nt_full = K / BK;
    int Rr[2], Cc[2];
    unsigned voffB[2];
#pragma unroll
    for (int i = 0; i < 2; ++i) { int R, C; stage_rc(tid * 16 + i * 8192, R, C); const int Rb = Epi::PERM ? ((R & ~31) + perm32(R & 31)) : R;
        Rr[i] = R; Cc[i] = C; voffB[i] = (unsigned)(Rb * K + C) * 2u; }
    const unsigned rowbytes = (unsigned)K * 2u;
    const size_t kstep = (size_t)(BK * 2);
    const size_t hstep = (size_t)HALF * K * 2;
    const size_t tstep = 2 * hstep;
    const unsigned ldsw = (unsigned)wid * 1024u;
    const int aoff = lds_byte(wr * 64 + fr, fq * 8), boff = lds_byte(wc * 32 + fr, fq * 8);
#define PG8_SA(b, h) (((b) * 2 + (h)) * HTB)
#define PG8_SB(b, h) ((4 + (b) * 2 + (h)) * HTB)
#define PG8_STAGE(bufoff, gbase, voff) do { _Pragma("unroll") for (int _i = 0; _i < 2; ++_i) \
        __builtin_amdgcn_global_load_lds((const unsigned*)((const char*)(gbase) + (voff)[_i]), (LAS unsigned*)(lds + (bufoff) + ldsw + _i * 8192), 16, 0, 0); } while (0)
#define PG8_STAGE_A(bufoff, gbase, vv, h) do { _Pragma("unroll") for (int _i = 0; _i < 2; ++_i) \
        __builtin_amdgcn_global_load_lds((const unsigned*)((const char*)(gbase) + (vv)[h][_i]), (LAS unsigned*)(lds + (bufoff) + ldsw + _i * 8192), 16, 0, 0); } while (0)
#define PG8_LDA(dst, b, h) do { _Pragma("unroll") for (int m = 0; m < 4; ++m) _Pragma("unroll") for (int k = 0; k < 2; ++k) dst[m][k] = *(const LAS bf16x8*)(lds + PG8_SA(b, h) + aoff + m * 2048 + k * 1024); } while (0)
#define PG8_LDB(dst, b, h) do { _Pragma("unroll") for (int n = 0; n < 2; ++n) _Pragma("unroll") for (int k = 0; k < 2; ++k) dst[n][k] = *(const LAS bf16x8*)(lds + PG8_SB(b, h) + boff + n * 2048 + k * 1024); } while (0)
#define PG8_MMA(ai, bj, At, Bt) do { __builtin_amdgcn_s_setprio(1); _Pragma("unroll") for (int m = 0; m < 4; ++m) _Pragma("unroll") for (int n = 0; n < 2; ++n) _Pragma("unroll") for (int k = 0; k < 2; ++k) \
        acc[ai][bj][m][n] = __builtin_amdgcn_mfma_f32_16x16x32_bf16(Bt[n][k], At[m][k], acc[ai][bj][m][n], 0, 0, 0); __builtin_amdgcn_s_setprio(0); } while (0)
#define PG8_WAIT_V(n) asm volatile("s_waitcnt vmcnt(" #n ")" ::: "memory")
#define PG8_WAIT_L(n) asm volatile("s_waitcnt lgkmcnt(" #n ")" ::: "memory")
#define PG8_BAR __builtin_amdgcn_s_barrier()
#define PG8_SCHED __builtin_amdgcn_sched_barrier(0)
#define PG8_SETOFF(vv, uu) do { _Pragma("unroll") for (int _h = 0; _h < 2; ++_h) _Pragma("unroll") for (int _i = 0; _i < 2; ++_i) { \
        if constexpr (Sched::GATHER) (vv)[_h][_i] = S.a_row_off((uu), _h * HALF + Rr[_i], rowbytes) + (unsigned)Cc[_i] * 2u; \
        else (vv)[_h][_i] = (unsigned)((_h * HALF + Rr[_i]) * K + Cc[_i]) * 2u; } } while (0)
    Unit cur, nxt; int ui = 0;
    if (!S.next(0, cur)) return;
    f32x4 acc[2][2][4][2];
#pragma unroll
    for (int a = 0; a < 2; ++a)
#pragma unroll
        for (int b = 0; b < 2; ++b)
#pragma unroll
            for (int m = 0; m < 4; ++m)
#pragma unroll
                for (int n = 0; n < 2; ++n) acc[a][b][m][n] = (f32x4){0.f, 0.f, 0.f, 0.f};
    bf16x8 At[4][2], B0[2][2], B1[2][2];
    unsigned vAc[2][2], vAn[2][2];
    PG8_SETOFF(vAc, cur);
    const char* cA = (Sched::GATHER ? (const char*)g.A : (const char*)g.A + (size_t)cur.pm * tstep) + (size_t)S.koff(cur) * 2;
    const char* cB = (const char*)g.Bt + (size_t)cur.pb * tstep + (size_t)S.koff(cur) * 2;
    int nt = S.ntk(cur, nt_full);
    PG8_STAGE(PG8_SB(0, 0), cB, voffB); PG8_STAGE(PG8_SB(0, 1), cB + hstep, voffB); PG8_STAGE_A(PG8_SA(0, 0), cA, vAc, 0); PG8_STAGE_A(PG8_SA(0, 1), cA, vAc, 1);
    if (wr == 1) PG8_BAR;
    PG8_WAIT_V(2); PG8_BAR;
    PG8_STAGE(PG8_SB(1, 0), cB + kstep, voffB); PG8_STAGE_A(PG8_SA(1, 0), cA + kstep, vAc, 0); PG8_STAGE(PG8_SB(1, 1), cB + hstep + kstep, voffB);
    PG8_WAIT_V(6); PG8_BAR;
    for (;;) {
        const bool has_next = S.next(ui + 1, nxt);
        const char* nA = cA; const char* nB = cB;
        if (has_next) { nA = (Sched::GATHER ? (const char*)g.A : (const char*)g.A + (size_t)nxt.pm * tstep) + (size_t)S.koff(nxt) * 2; nB = (const char*)g.Bt + (size_t)nxt.pb * tstep + (size_t)S.koff(nxt) * 2; }
        if constexpr (Sched::GATHER) {
            if (has_next) { PG8_SETOFF(vAn, nxt); }
            else {
#pragma unroll
                for (int h = 0; h < 2; ++h)
#pragma unroll
                    for (int i = 0; i < 2; ++i) vAn[h][i] = vAc[h][i];
            }
        }
#pragma unroll 1
        for (int t = 0; t < nt; t += 2) {
            const bool last = (t == nt - 2);
            const char* a1 = cA + (size_t)(t + 1) * kstep;
            const char* a2 = last ? nA : cA + (size_t)(t + 2) * kstep; const char* b2 = last ? nB : cB + (size_t)(t + 2) * kstep;
            const char* a3 = a2 + kstep; const char* b3 = b2 + kstep;
            unsigned vs[2][2];
#pragma unroll
            for (int h = 0; h < 2; ++h)
#pragma unroll
                for (int i = 0; i < 2; ++i) { if constexpr (Sched::GATHER) vs[h][i] = last ? vAn[h][i] : vAc[h][i]; else vs[h][i] = vAc[h][i]; }
            PG8_LDB(B0, 0, 0); PG8_LDB(B1, 0, 1); PG8_SCHED; PG8_LDA(At, 0, 0); PG8_STAGE_A(PG8_SA(1, 1), a1, vAc, 1);
            PG8_WAIT_V(8); PG8_WAIT_L(0); PG8_BAR; PG8_MMA(0, 0, At, B0); PG8_MMA(0, 1, At, B1); PG8_BAR; PG8_SCHED;
            PG8_LDA(At, 0, 1); PG8_STAGE(PG8_SB(0, 0), b2, voffB); PG8_STAGE(PG8_SB(0, 1), b2 + hstep, voffB); PG8_STAGE_A(PG8_SA(0, 0), a2, vs, 0);
            PG8_WAIT_V(8); PG8_WAIT_L(0); PG8_BAR; PG8_MMA(1, 0, At, B0); PG8_MMA(1, 1, At, B1); PG8_BAR; PG8_SCHED;
            PG8_LDB(B0, 1, 0); PG8_LDB(B1, 1, 1); PG8_SCHED; PG8_LDA(At, 1, 0); PG8_STAGE_A(PG8_SA(0, 1), a2, vs, 1);
            PG8_WAIT_V(8); PG8_WAIT_L(0); PG8_BAR; PG8_MMA(0, 0, At, B0); PG8_MMA(0, 1, At, B1); PG8_BAR; PG8_SCHED;
            PG8_LDA(At, 1, 1); PG8_STAGE(PG8_SB(1, 0), b3, voffB); PG8_STAGE(PG8_SB(1, 1), b3 + hstep, voffB); PG8_STAGE_A(PG8_SA(1, 0), a3, vs, 0);
            PG8_WAIT_V(8); PG8_WAIT_L(0); PG8_BAR; PG8_MMA(1, 0, At, B0); PG8_MMA(1, 1, At, B1); PG8_BAR; PG8_SCHED;
        }
        if (wr == 0) PG8_BAR;
        E(acc, cur, wr, wc, fr, fq);
        if (!has_next) break;
#pragma unroll
        for (int a = 0; a < 2; ++a)
#pragma unroll
            for (int b = 0; b < 2; ++b)
#pragma unroll
                for (int m = 0; m < 4; ++m)
#pragma unroll
                    for (int n = 0; n < 2; ++n) acc[a][b][m][n] = (f32x4){0.f, 0.f, 0.f, 0.f};
        cur = nxt; cA = nA; cB = nB; ++ui; nt = S.ntk(cur, nt_full);
        if constexpr (Sched::GATHER) {
#pragma unroll
            for (int h = 0; h < 2; ++h)
#pragma unroll
                for (int i = 0; i < 2; ++i) vAc[h][i] = vAn[h][i];
        }
        if (wr == 1) PG8_BAR;
    }
    PG8_WAIT_V(0);
    PG8_BAR;
#undef PG8_SA
#undef PG8_SB
#undef PG8_STAGE
#undef PG8_STAGE_A
#undef PG8_LDA
#undef PG8_LDB
#undef PG8_MMA
#undef PG8_WAIT_V
#undef PG8_WAIT_L
#undef PG8_BAR
#undef PG8_SCHED
#undef PG8_SETOFF
}
}

#define XB_TMO      128
#define XB_XCNT(j)  (256  + 64 * (j))
#define XB_XSUB(j)  (1280 + 64 * (j))
#define XB_XGEN(j)  (2304 + 64 * (j))
#define XB_TOP      3328
#define XB_TOPGEN   3392
#define XCD_BAR_WORDS 3456
#define XB_SPIN_CAP (1u << 18)
__device__ __forceinline__ unsigned xb_ld(unsigned* p)              { return __hip_atomic_load(p, __ATOMIC_RELAXED, __HIP_MEMORY_SCOPE_AGENT); }
__device__ __forceinline__ unsigned xb_add(unsigned* p, unsigned v) { return __hip_atomic_fetch_add(p, v, __ATOMIC_RELAXED, __HIP_MEMORY_SCOPE_AGENT); }
__device__ __forceinline__ unsigned xb_xcc_id() { return (unsigned)__builtin_amdgcn_s_getreg((3 << 11) | 20) & 0xFu; }
#define XB_SPIN(cond, bar) do { unsigned _sp = 0; while (cond) { __builtin_amdgcn_s_sleep(1); \
    if ((++_sp & 255u) == 0u) { if (xb_ld(&(bar)[XB_TMO])) break; if (_sp > XB_SPIN_CAP) { atomicAdd(&(bar)[XB_TMO], 1u); break; } } } } while (0)
struct XcdBarrier { unsigned* bar; unsigned x; volatile LAS unsigned* st; };
__device__ __forceinline__ XcdBarrier xcd_barrier_post(unsigned* bar, volatile LAS unsigned* st) {
    XcdBarrier b; b.bar = bar; b.x = xb_xcc_id(); b.st = st;
    if (threadIdx.x == 0) (void)xb_add(&bar[XB_XCNT(b.x)], 1u);
    return b;
}
__device__ __forceinline__ void xcd_barrier_complete(unsigned* bar, unsigned x, unsigned& nloc, unsigned& nx) {
    const unsigned G = gridDim.x * gridDim.y * gridDim.z;
    unsigned sum, cnt, mine, sp = 0u;
    for (;;) {
        sum = 0u; cnt = 0u; mine = 0u;
#pragma unroll
        for (unsigned j = 0; j < 16; ++j) { const unsigned c = xb_ld(&bar[XB_XCNT(j)]); sum += c; cnt += (c > 0u) ? 1u : 0u; mine = (j == x) ? c : mine; }
        if (sum == G) break;
        __builtin_amdgcn_s_sleep(1);
        if ((++sp & 255u) == 0u) { if (xb_ld(&bar[XB_TMO])) break; if (sp > XB_SPIN_CAP) { atomicAdd(&bar[XB_TMO], 1u); break; } }
    }
    nloc = mine > 0u ? mine : 1u; nx = cnt > 0u ? cnt : 1u;
}
__device__ __forceinline__ void xcd_barrier(const XcdBarrier& b) {
    asm volatile("s_waitcnt vmcnt(0)" ::: "memory");
    __syncthreads();
    if (threadIdx.x == 0) {
        unsigned* bar = b.bar;
        __builtin_amdgcn_s_waitcnt(0);
        unsigned nloc = b.st[0], nx = b.st[1];
        if (nloc == 0u) { xcd_barrier_complete(bar, b.x, nloc, nx); b.st[0] = nloc; b.st[1] = nx; }
        const unsigned old = xb_add(&bar[XB_XSUB(b.x)], 1u);
        const unsigned gen = old / nloc;
        if (old + 1u == (gen + 1u) * nloc) {
            __builtin_amdgcn_fence(__ATOMIC_RELEASE, "agent");
            asm volatile("s_waitcnt vmcnt(0)" ::: "memory");
            const unsigned og = xb_add(&bar[XB_TOP], 1u);
            const unsigned tg = og / nx;
            if (og + 1u == (tg + 1u) * nx) xb_add(&bar[XB_TOPGEN], 1u);
            else XB_SPIN(xb_ld(&bar[XB_TOPGEN]) == tg, bar);
            __builtin_amdgcn_fence(__ATOMIC_ACQUIRE, "agent");
            xb_add(&bar[XB_XGEN(b.x)], 1u);
            asm volatile("s_waitcnt vmcnt(0)" ::: "memory");
        } else {
            XB_SPIN(xb_ld(&bar[XB_XGEN(b.x)]) == gen, bar);
            __builtin_amdgcn_fence(__ATOMIC_ACQUIRE, "agent");
            asm volatile("s_waitcnt vmcnt(0)" ::: "memory");
        }
    }
    __syncthreads();
}

constexpr int NWAVES = 8;
constexpr int SEQ = 2048, NB = 16, DM = 1024, NTOK = NB * SEQ;
constexpr int DRW = 512, HD = 64;
constexpr int NPROJ = 3072, NEXT = 3584, NL1 = 512, KL2 = 256, NL2 = 1536;
constexpr int NEXP = 32, DEXP = 512;
constexpr int PROWS_MAX = 65536 + 32 * 256, MAXTILES = PROWS_MAX / 256;
constexpr float LN_EPS = 1e-5f, LNX_EPS = 64e-5f, ALPHA = 1.189207115002721f;

constexpr size_t MiB = 1u << 20;
constexpr size_t WS_CTL = 0, CTL_ZERO_BYTES = 65536;
constexpr size_t WS_WINT = 1 * MiB;
constexpr size_t WS_W2T = 8 * MiB;
constexpr size_t WS_WOT = 9 * MiB;
constexpr size_t WS_GT = 11 * MiB;
constexpr size_t WS_PT = 13 * MiB;
constexpr size_t WS_BIAS = 13 * MiB + 512 * 1024;
constexpr size_t WS_WRT = 13 * MiB + 640 * 1024;
constexpr size_t WS_TOKE = 14 * MiB;
constexpr size_t WS_TOKW = 14 * MiB + 256 * 1024;
constexpr size_t WS_ROWTOK = 14 * MiB + 512 * 1024;
constexpr size_t WS_ROWASG = 15 * MiB;
constexpr size_t WS_ROWW = 15 * MiB + 512 * 1024;
constexpr size_t WS_PB = 16 * MiB;
constexpr size_t WS_X1 = 32 * MiB;
constexpr size_t WS_XB = WS_X1, WS_LORA1 = WS_X1 + 64 * MiB;
constexpr size_t WS_LW = WS_X1, WS_AG = WS_X1 + 64 * MiB;
constexpr size_t WS_P = 160 * MiB;
constexpr size_t WS_HDN = WS_P;
constexpr size_t WS_PLE = WS_P + 72 * MiB;
constexpr size_t WS_Y = 352 * MiB;
constexpr size_t WS_WGUT = 416 * MiB;
constexpr size_t WS_WDT = 480 * MiB;
constexpr size_t WS_END = 512 * MiB;
constexpr int BIAS_LD = 132;
constexpr int CW_BAR = 4096;
constexpr int CW_CNT = 8192, CW_FILL = 8192 + 64, CW_NTILES = 8192 + 128, CW_TILEE = 8192 + 256;

constexpr int RING_OFF = 0, RING_BYTES = 131072;
constexpr int WRT_BYTES = 36 * 1024 * 4;
constexpr int LDS_BYTES = 160 * 1024;
constexpr int LDSCTL_OFF = LDS_BYTES - 1024, MISC_OFF = LDSCTL_OFF;
constexpr int MW_HIST = 0, MW_CNT = 32, MW_RS = 64, MW_LBASE = 96, MW_LFILL = 128, MW_BAR = 160;

struct Frame {
    LAS unsigned char* lds;
    volatile LAS unsigned* MISC;
    unsigned* ctl;
    int tid, lane, wave, vcu, G;
    unsigned char* ws;
    const float* const* in;
    float* out;
};
enum InIdx { I_X = 0, I_P, I_WIN, I_MURKV, I_MULORA, I_W0, I_WL1, I_WL2, I_A0, I_AL1, I_AL2, I_GL1, I_GL2, I_KK, I_KA, I_RK, I_LNXG, I_LNXB, I_RELB, I_WO,
             I_LN1G, I_LN1B, I_RG, I_RGB, I_RE, I_REB, I_WG, I_WU, I_WD, I_PG, I_PP, I_LN2G, I_LN2B };

__device__ __forceinline__ void tr_item(const float* W, int ldw, int k0, int n0, bf16_t* dst, int ldt, const float* mu, int smode, LAS float* scr, int lane) {
#pragma unroll 8
    for (int i = 0; i < 32; ++i) { const int kk = 2 * i + (lane >> 5); float v = W[(size_t)(k0 + kk) * ldw + n0 + (lane & 31)];
        if (smode == 1) v *= (1.0f - mu[k0 + kk]); else if (smode == 2) v *= mu[k0 + kk];
        scr[kk * 33 + (lane & 31)] = v; }
    LDS_WAIT(); asm volatile("" ::: "memory");
    const int c = lane & 7;
#pragma unroll
    for (int j = 0; j < 4; ++j) { const int n = (lane >> 3) + 8 * j; const LAS float* s = scr + (8 * c) * 33 + n;
        u32x4 o; o.x = pk2(s[0 * 33], s[1 * 33]); o.y = pk2(s[2 * 33], s[3 * 33]); o.z = pk2(s[4 * 33], s[5 * 33]); o.w = pk2(s[6 * 33], s[7 * 33]);
        *(u32x4*)(dst + (size_t)n * ldt + k0 + 8 * c) = o; }
    LDS_WAIT(); asm volatile("" ::: "memory");
}
__device__ __forceinline__ int t5_bucket(int n) {
    if (n < 16) return n;
    int b = 16;
    b += (n >= 22); b += (n >= 30); b += (n >= 40); b += (n >= 54); b += (n >= 73); b += (n >= 99); b += (n >= 134); b += (n >= 182);
    b += (n >= 246); b += (n >= 332); b += (n >= 450); b += (n >= 609); b += (n >= 825); b += (n >= 1117); b += (n >= 1513);
    return b;
}

__device__ __forceinline__ void ph_prologue_small(Frame& F) {
    const int gt = F.vcu * 512 + F.tid, NGT = F.G * 512;
    { bf16_t* w2t = (bf16_t*)(F.ws + WS_W2T);
      for (int i = gt; i < NL2 * KL2; i += NGT) { const int n = i / KL2, k = i % KL2; float v = 0.f;
          if (n < 512) { if (k < 64) v = F.in[I_WL2][k * 512 + n]; }
          else if (n < 1024) { if (k >= 64 && k < 128) v = F.in[I_AL2][(k - 64) * 512 + (n - 512)]; }
          else { if (k >= 128) v = F.in[I_GL2][(k - 128) * 512 + (n - 1024)]; }
          w2t[i] = (bf16_t)f2bf(v); } }
    { float* bt = (float*)(F.ws + WS_BIAS);
      for (int i = gt; i < 3 * 8 * BIAS_LD; i += NGT) { const int p = i / (8 * BIAS_LD), h = (i / BIAS_LD) % 8, m = i % BIAS_LD; const int dil = 1 << (2 * p);
          bt[i] = (m <= 128) ? F.in[I_RELB][t5_bucket(m * dil) * 8 + h] : 0.f; } }
    { bf16_t* wrt = (bf16_t*)(F.ws + WS_WRT);
      for (int i = gt; i < 48 * 1024; i += NGT) { const int n = i >> 10, k = i & 1023; float v = 0.f;
          if (n < 4) v = F.in[I_RG][k * 4 + n]; else if (n < 36) v = F.in[I_RE][k * 32 + (n - 4)];
          const unsigned hb = f2bf(v); const float hf = __builtin_bit_cast(float, hb << 16);
          wrt[i] = (bf16_t)hb; wrt[48 * 1024 + i] = (bf16_t)f2bf(v - hf); } }
}
__device__ __forceinline__ void ph_prologue(Frame& F) {
    const int gt = F.vcu * 512 + F.tid, NGT = F.G * 512;
    const int gw = F.vcu * NWAVES + F.wave, NGW = F.G * NWAVES;
    { const f32x4* x4 = (const f32x4*)F.in[I_X]; u32x4* o = (u32x4*)(F.ws + WS_XB);
      for (int i = gt; i < NTOK * DM / 8; i += NGT) { const f32x4 a = __builtin_nontemporal_load(x4 + 2 * i), b = __builtin_nontemporal_load(x4 + 2 * i + 1); u32x4 w;
        w.x = pk2(a.x, a.y); w.y = pk2(a.z, a.w); w.z = pk2(b.x, b.y); w.w = pk2(b.z, b.w); o[i] = w; } }
    LAS float* scr = (LAS float*)(F.lds + RING_OFF + F.wave * 16384);
    constexpr int IT_WIN = 16 * 96, IT_L1 = 256;
    constexpr int NIT = IT_WIN + IT_L1;
    bf16_t* WinT = (bf16_t*)(F.ws + WS_WINT);
    for (int it = gw; it < NIT; it += NGW) {
        int r = it;
        if (r < IT_WIN) { const int kb = r / 96, nb = r % 96; tr_item(F.in[I_WIN], NPROJ, kb * 64, nb * 32, WinT + (size_t)(nb * 32) * DM, DM, nullptr, 0, scr, F.lane); continue; } r -= IT_WIN;
        if (r < IT_L1) {
            int piece, sub;
            if (r < 128) { piece = r / 32; sub = r % 32; } else { piece = 4 + (r - 128) / 64; sub = (r - 128) % 64; }
            const int which = piece >> 1, isprev = piece & 1;
            const int ncols = (which == 2) ? 128 : 64, nblk = ncols / 32;
            const int kb = sub / nblk, nb = sub % nblk;
            const float* src = (which == 0) ? F.in[I_WL1] : (which == 1) ? F.in[I_AL1] : F.in[I_GL1];
            const int rowbase = (which == 0) ? 3072 + 64 * isprev : (which == 1) ? 3200 + 64 * isprev : 3328 + 128 * isprev;
            tr_item(src, ncols, kb * 64, nb * 32, WinT + (size_t)(rowbase + nb * 32) * DM, DM, F.in[I_MULORA] + which * DM, isprev ? 2 : 1, scr, F.lane); }
    }
}
constexpr int LATE_TILE_UNITS = (512 + 512 + 128) / NWAVES;
__device__ __forceinline__ void late_prologue_items(Frame& F, int unit, LAS float* scr) {
    { const f32x4* x4 = (const f32x4*)F.in[I_P]; u32x4* o = (u32x4*)(F.ws + WS_PB);
      int tid_ = F.tid; asm volatile("" : "+v"(tid_));
#pragma unroll
      for (int q = 0; q < 2; ++q) { const int i = unit * 1024 + q * 512 + tid_; const f32x4 a = __builtin_nontemporal_load(x4 + 2 * i), b = __builtin_nontemporal_load(x4 + 2 * i + 1); u32x4 w; w.x = pk2(a.x, a.y); w.y = pk2(a.z, a.w); w.z = pk2(b.x, b.y); w.w = pk2(b.z, b.w); o[i] = w; } }
    if (unit < LATE_TILE_UNITS) { int r = unit * NWAVES + F.wave; int lane_ = F.lane; asm volatile("" : "+v"(lane_));
        if (r < 512) { const int kb = r / 32, nb = r % 32; tr_item(F.in[I_WO], DM, kb * 64, nb * 32, (bf16_t*)(F.ws + WS_WOT) + (size_t)(nb * 32) * DM, DM, nullptr, 0, scr, lane_); }
        else if (r < 1024) { r -= 512; const int kb = r / 32, nb = r % 32; tr_item(F.in[I_PG], DM, kb * 64, nb * 32, (bf16_t*)(F.ws + WS_GT) + (size_t)(nb * 32) * DM, DM, nullptr, 0, scr, lane_); }
        else { r -= 1024; const int kb = r / 32, nb = r % 32; tr_item(F.in[I_PP], DM, kb * 64, nb * 32, (bf16_t*)(F.ws + WS_PT) + (size_t)(nb * 32) * 256, 256, nullptr, 0, scr, lane_); } }
}
constexpr int MOE_IT_GU = 64 * 256, MOE_IT_D = 32 * 256, MOE_ROUNDS_PER_UNIT = 3;
static_assert((MOE_IT_GU + MOE_IT_D) == NB * 8 * 8 * MOE_ROUNDS_PER_UNIT * NWAVES, "conversion items tile the attention queue exactly");
struct MoeItem { const float* src; bf16_t* dst; int ldw, ldt, k0; };
__device__ __forceinline__ MoeItem moe_item(const Frame& F, int it) {
    MoeItem m;
    if (it < MOE_IT_GU) { const int mat = it / 256, sub = it % 256, e = mat >> 1, up = mat & 1, kb = sub / 16, nb = sub % 16, n0 = nb * 32;
        m.src = (up ? F.in[I_WU] : F.in[I_WG]) + (size_t)e * DM * DEXP + (size_t)(kb * 64) * DEXP + n0; m.ldw = DEXP;
        m.dst = (bf16_t*)(F.ws + WS_WGUT) + ((size_t)e * 1024 + (n0 >> 7) * 256 + up * 128 + (n0 & 127)) * DM; m.ldt = DM; m.k0 = kb * 64; }
    else { const int r = it - MOE_IT_GU, e = r / 256, sub = r % 256, kb = sub / 32, nb = sub % 32;
        m.src = F.in[I_WD] + (size_t)e * DEXP * DM + (size_t)(kb * 64) * DM + nb * 32; m.ldw = DM;
        m.dst = (bf16_t*)(F.ws + WS_WDT) + ((size_t)e * 1024 + nb * 32) * DEXP; m.ldt = DEXP; m.k0 = kb * 64; }
    return m;
}
__device__ __forceinline__ void moe_weight_items3(Frame& F, int it0, LAS float* scr) {
    const int lane = F.lane;
    float v[MOE_ROUNDS_PER_UNIT][32]; MoeItem m[MOE_ROUNDS_PER_UNIT];
#pragma unroll
    for (int j = 0; j < MOE_ROUNDS_PER_UNIT; ++j) { m[j] = moe_item(F, it0 + j * NWAVES);
        const float* p = m[j].src + (size_t)(lane >> 5) * m[j].ldw + (lane & 31);
#pragma unroll
        for (int i = 0; i < 32; ++i) v[j][i] = __builtin_nontemporal_load(p + (size_t)(2 * i) * m[j].ldw); }
#pragma unroll
    for (int j = 0; j < MOE_ROUNDS_PER_UNIT; ++j) {
#pragma unroll
        for (int i = 0; i < 32; ++i) scr[(2 * i + (lane >> 5)) * 33 + (lane & 31)] = v[j][i];
        LDS_WAIT(); asm volatile("" ::: "memory");
        const int c = lane & 7;
#pragma unroll
        for (int q = 0; q < 4; ++q) { const int n = (lane >> 3) + 8 * q; const LAS float* sp = scr + (8 * c) * 33 + n;
            u32x4 o; o.x = pk2(sp[0 * 33], sp[1 * 33]); o.y = pk2(sp[2 * 33], sp[3 * 33]); o.z = pk2(sp[4 * 33], sp[5 * 33]); o.w = pk2(sp[6 * 33], sp[7 * 33]);
            *(u32x4*)(m[j].dst + (size_t)n * m[j].ldt + m[j].k0 + 8 * c) = o; }
        LDS_WAIT(); asm volatile("" ::: "memory");
    }
}

using pg8::Unit; using pg8::cvt_pk_bf16;
struct EpiProj {
    static constexpr bool PERM = true;
    bf16_t* proj; bf16_t* lora1;
    __device__ __forceinline__ void operator()(const f32x4 (&acc)[2][2][4][2], const Unit& u, int wr, int wc, int fr, int fq) const {
        const int row0 = u.pm * 256 + wr * 64 + fr;
        const bool isl = (u.pn >= 12);
        bf16_t* base = isl ? lora1 : proj; const int ld = isl ? NL1 : NPROJ;
        const int col0 = (isl ? (u.pn - 12) : u.pn) * 256 + wc * 32 + 8 * fq;
#pragma unroll
        for (int ai = 0; ai < 2; ++ai)
#pragma unroll
            for (int m = 0; m < 4; ++m) { bf16_t* rowp = base + (size_t)(row0 + ai * 128 + m * 16) * ld + col0;
#pragma unroll
                for (int bj = 0; bj < 2; ++bj) { const f32x4 v0 = acc[ai][bj][m][0], v1 = acc[ai][bj][m][1]; u32x4 w;
                    w.x = cvt2(v0[0], v0[1]); w.y = cvt2(v0[2], v0[3]); w.z = cvt2(v1[0], v1[1]); w.w = cvt2(v1[2], v1[3]);
                    *(u32x4*)(rowp + bj * 128) = w; } }
    }
};
struct EpiDag {
    static constexpr bool PERM = true;
    bf16_t* lw; bf16_t* ag; const float* w0; const float* a0;
    __device__ __forceinline__ void operator()(const f32x4 (&acc)[2][2][4][2], const Unit& u, int wr, int wc, int fr, int fq) const {
        const int row0 = u.pm * 256 + wr * 64 + fr;
        const int colt = u.pn * 256 + wc * 32 + 8 * fq;
        if (u.pn < 2) {
#pragma unroll
            for (int bj = 0; bj < 2; ++bj) {
                const f32x4 b0 = *(const f32x4*)(w0 + colt + bj * 128), b1 = *(const f32x4*)(w0 + colt + bj * 128 + 4);
#pragma unroll
                for (int ai = 0; ai < 2; ++ai)
#pragma unroll
                    for (int m = 0; m < 4; ++m) { bf16_t* rowp = lw + (size_t)(row0 + ai * 128 + m * 16) * 512 + colt + bj * 128;
                        const f32x4 z0 = acc[ai][bj][m][0] + b0, z1 = acc[ai][bj][m][1] + b1; f32x4 o0, o1;
#pragma unroll
                        for (int j = 0; j < 4; ++j) { o0[j] = -0.6065306597126334f * sigmoidf_(z0[j]); o1[j] = -0.6065306597126334f * sigmoidf_(z1[j]); }
                        u32x4 w; w.x = cvt2(o0[0], o0[1]); w.y = cvt2(o0[2], o0[3]); w.z = cvt2(o1[0], o1[1]); w.w = cvt2(o1[2], o1[3]);
                        *(u32x4*)(rowp) = w; }
                asm volatile("" ::: "memory");
            }
        } else {
            const bool isa = (u.pn < 4);
#pragma unroll
            for (int bj = 0; bj < 2; ++bj) {
                f32x4 b0 = (f32x4){0.f, 0.f, 0.f, 0.f}, b1 = (f32x4){0.f, 0.f, 0.f, 0.f};
                if (isa) { b0 = *(const f32x4*)(a0 + (colt - 512) + bj * 128); b1 = *(const f32x4*)(a0 + (colt - 512) + bj * 128 + 4); }
#pragma unroll
                for (int ai = 0; ai < 2; ++ai)
#pragma unroll
                    for (int m = 0; m < 4; ++m) { bf16_t* rowp = ag + (size_t)(row0 + ai * 128 + m * 16) * 1024 + (colt - 512) + bj * 128;
                        f32x4 v0 = acc[ai][bj][m][0] + b0, v1 = acc[ai][bj][m][1] + b1;
                        if (isa) {
#pragma unroll
                            for (int j = 0; j < 4; ++j) { v0[j] = sigmoidf_(v0[j]); v1[j] = sigmoidf_(v1[j]); } }
                        u32x4 w; w.x = cvt2(v0[0], v0[1]); w.y = cvt2(v0[2], v0[3]); w.z = cvt2(v1[0], v1[1]); w.w = cvt2(v1[2], v1[3]);
                        *(u32x4*)(rowp) = w; }
                asm volatile("" ::: "memory");
            }
        }
    }
};
struct EpiWo {
    static constexpr bool PERM = true;
    bf16_t* mix;
    __device__ __forceinline__ void operator()(const f32x4 (&acc)[2][2][4][2], const Unit& u, int wr, int wc, int fr, int fq) const {
        const int row0 = u.pm * 256 + wr * 64 + fr, col0 = u.pn * 256 + wc * 32 + 8 * fq;
#pragma unroll
        for (int ai = 0; ai < 2; ++ai)
#pragma unroll
            for (int m = 0; m < 4; ++m) { bf16_t* rowp = mix + (size_t)(row0 + ai * 128 + m * 16) * DM + col0;
#pragma unroll
                for (int bj = 0; bj < 2; ++bj) { const f32x4 v0 = acc[ai][bj][m][0], v1 = acc[ai][bj][m][1]; u32x4 w;
                    w.x = cvt2(v0[0], v0[1]); w.y = cvt2(v0[2], v0[3]); w.z = cvt2(v1[0], v1[1]); w.w = cvt2(v1[2], v1[3]);
                    *(u32x4*)(rowp + bj * 128) = w; } }
    }
};
struct EpiBf {
    static constexpr bool PERM = true;
    bf16_t* O; int ldc;
    __device__ __forceinline__ void operator()(const f32x4 (&acc)[2][2][4][2], const Unit& u, int wr, int wc, int fr, int fq) const {
        const int row0 = u.pm * 256 + wr * 64 + fr, col0 = u.pn * 256 + wc * 32 + 8 * fq;
#pragma unroll
        for (int ai = 0; ai < 2; ++ai)
#pragma unroll
            for (int m = 0; m < 4; ++m) { bf16_t* rowp = O + (size_t)(row0 + ai * 128 + m * 16) * ldc + col0;
#pragma unroll
                for (int bj = 0; bj < 2; ++bj) { const f32x4 v0 = acc[ai][bj][m][0], v1 = acc[ai][bj][m][1]; u32x4 w;
                    w.x = cvt2(v0[0], v0[1]); w.y = cvt2(v0[2], v0[3]); w.z = cvt2(v1[0], v1[1]); w.w = cvt2(v1[2], v1[3]);
                    *(u32x4*)(rowp + bj * 128) = w; } }
    }
};
struct EpiPle {
    static constexpr bool PERM = true;
    bf16_t* O; int ldc; const bf16_t* x1b;
    __device__ __forceinline__ void operator()(const f32x4 (&acc)[2][2][4][2], const Unit& u, int wr, int wc, int fr, int fq) const {
        const int row0 = u.pm * 256 + wr * 64 + fr, col0 = u.pn * 256 + wc * 32 + 8 * fq;
#pragma unroll
        for (int ai = 0; ai < 2; ++ai) {
            u32x4 pv[4][2], xv[4][2];
#pragma unroll
            for (int m = 0; m < 4; ++m)
#pragma unroll
                for (int bj = 0; bj < 2; ++bj) { const size_t off = (size_t)(row0 + ai * 128 + m * 16) * ldc + col0 + bj * 128; pv[m][bj] = *(const u32x4*)(O + off); xv[m][bj] = *(const u32x4*)(x1b + off); }
#pragma unroll
            for (int m = 0; m < 4; ++m)
#pragma unroll
                for (int bj = 0; bj < 2; ++bj) { const f32x4 a0 = acc[ai][bj][m][0], a1 = acc[ai][bj][m][1]; const u32x4 p = pv[m][bj], x = xv[m][bj]; u32x4 w;
                    w.x = cvt2(ALPHA * bf_lo(x.x) + sigmoidf_(a0[0]) * bf_lo(p.x), ALPHA * bf_hi(x.x) + sigmoidf_(a0[1]) * bf_hi(p.x));
                    w.y = cvt2(ALPHA * bf_lo(x.y) + sigmoidf_(a0[2]) * bf_lo(p.y), ALPHA * bf_hi(x.y) + sigmoidf_(a0[3]) * bf_hi(p.y));
                    w.z = cvt2(ALPHA * bf_lo(x.z) + sigmoidf_(a1[0]) * bf_lo(p.z), ALPHA * bf_hi(x.z) + sigmoidf_(a1[1]) * bf_hi(p.z));
                    w.w = cvt2(ALPHA * bf_lo(x.w) + sigmoidf_(a1[2]) * bf_lo(p.w), ALPHA * bf_hi(x.w) + sigmoidf_(a1[3]) * bf_hi(p.w));
                    *(u32x4*)(O + (size_t)(row0 + ai * 128 + m * 16) * ldc + col0 + bj * 128) = w; }
            asm volatile("" ::: "memory");
        }
    }
};
struct EpiGU {
    static constexpr bool PERM = true;
    bf16_t* hdn;
    __device__ __forceinline__ void operator()(const f32x4 (&acc)[2][2][4][2], const Unit& u, int wr, int wc, int fr, int fq) const {
        const int row0 = u.pm * 256 + wr * 64 + fr, col0 = u.pn * 128 + wc * 32 + 8 * fq;
#pragma unroll
        for (int ai = 0; ai < 2; ++ai)
#pragma unroll
            for (int m = 0; m < 4; ++m) { bf16_t* rowp = hdn + (size_t)(row0 + ai * 128 + m * 16) * DEXP + col0; float h[8];
#pragma unroll
                for (int n = 0; n < 2; ++n)
#pragma unroll
                    for (int j = 0; j < 4; ++j) { const float gt = acc[ai][0][m][n][j], up = acc[ai][1][m][n][j]; h[4 * n + j] = gt * sigmoidf_(gt) * up; }
                u32x4 w; w.x = cvt2(h[0], h[1]); w.y = cvt2(h[2], h[3]); w.z = cvt2(h[4], h[5]); w.w = cvt2(h[6], h[7]);
                *(u32x4*)rowp = w; }
    }
};
struct EpiDown {
    static constexpr bool PERM = true;
    bf16_t* lo; bf16_t* hi; const int* row_asg; const float* row_w;
    __device__ __forceinline__ void operator()(const f32x4 (&acc)[2][2][4][2], const Unit& u, int wr, int wc, int fr, int fq) const {
        const int row0 = u.pm * 256 + wr * 64 + fr, col0 = u.pn * 256 + wc * 32 + 8 * fq;
        int asg[2][4]; float wv[2][4];
#pragma unroll
        for (int ai = 0; ai < 2; ++ai)
#pragma unroll
            for (int m = 0; m < 4; ++m) { const int prow = row0 + ai * 128 + m * 16; asg[ai][m] = row_asg[prow]; wv[ai][m] = row_w[prow]; }
#pragma unroll
        for (int ai = 0; ai < 2; ++ai)
#pragma unroll
            for (int m = 0; m < 4; ++m) { const int ag_ = asg[ai][m]; const float w = wv[ai][m];
                if (ag_ >= 0) { bf16_t* rowp = lo + (size_t)ag_ * DM + col0;
#pragma unroll
                    for (int bj = 0; bj < 2; ++bj) { const f32x4 v0 = acc[ai][bj][m][0] * w, v1 = acc[ai][bj][m][1] * w; u32x4 o;
                        o.x = cvt2(v0[0], v0[1]); o.y = cvt2(v0[2], v0[3]); o.z = cvt2(v1[0], v1[1]); o.w = cvt2(v1[2], v1[3]);
                        *(u32x4*)(rowp + bj * 128) = o; } } }
    }
};

__device__ __forceinline__ void ph_lora_act(Frame& F) {
    const int gt = F.vcu * 512 + F.tid, NGT = F.G * 512;
    const bf16_t* l1 = (const bf16_t*)(F.ws + WS_LORA1); bf16_t* act = (bf16_t*)(F.ws + WS_Y);
    for (int i = gt; i < NTOK * 32; i += NGT) {
        const int t = i >> 5, c8 = (i & 31) * 8; const bool first = (t % SEQ) == 0;
        int ca, cb, mode;
        if (c8 < 64) { ca = c8; cb = 64 + c8; mode = 0; } else if (c8 < 128) { ca = 128 + (c8 - 64); cb = 192 + (c8 - 64); mode = 1; } else { ca = 256 + (c8 - 128); cb = 384 + (c8 - 128); mode = 2; }
        const u32x4 wa = *(const u32x4*)(l1 + (size_t)t * NL1 + ca);
        u32x4 wb = (u32x4){0u, 0u, 0u, 0u};
        if (!first) wb = *(const u32x4*)(l1 + (size_t)(t - 1) * NL1 + cb);
        float a[8];
        a[0] = bf_lo(wa.x) + bf_lo(wb.x); a[1] = bf_hi(wa.x) + bf_hi(wb.x); a[2] = bf_lo(wa.y) + bf_lo(wb.y); a[3] = bf_hi(wa.y) + bf_hi(wb.y);
        a[4] = bf_lo(wa.z) + bf_lo(wb.z); a[5] = bf_hi(wa.z) + bf_hi(wb.z); a[6] = bf_lo(wa.w) + bf_lo(wb.w); a[7] = bf_hi(wa.w) + bf_hi(wb.w);
        float o[8];
#pragma unroll
        for (int j = 0; j < 8; ++j) {
            const float sg = sigmoidf_(mode == 0 ? 2.0f * a[j] : a[j]);
            o[j] = (mode == 0) ? 2.0f * sg - 1.0f : (mode == 1) ? a[j] : sg; }
        u32x4 w; w.x = pk2(o[0], o[1]); w.y = pk2(o[2], o[3]); w.z = pk2(o[4], o[5]); w.w = pk2(o[6], o[7]);
        *(u32x4*)(act + (size_t)t * KL2 + c8) = w;
    }
}

__device__ __forceinline__ int sigma64(int i) { return (i & ~31) | (((i >> 2) & 3) << 3) | (((i >> 4) & 1) << 2) | (i & 3); }
__device__ __forceinline__ bf16x8 mk8(unsigned a, unsigned b, unsigned c, unsigned d) { u32x4 v; v.x = a; v.y = b; v.z = c; v.w = d; return __builtin_bit_cast(bf16x8, v); }
#define MFMA16(A, B, C) __builtin_amdgcn_mfma_f32_16x16x32_bf16((A), (B), (C), 0, 0, 0)

template <int CTRL> __device__ __forceinline__ float dppf(float v) { return __builtin_bit_cast(float, __builtin_amdgcn_update_dpp(0, __builtin_bit_cast(int, v), CTRL, 0xf, 0xf, true)); }
template <int CTRL, int ROWMASK> __device__ __forceinline__ float dppf_rm(float v) { return __builtin_bit_cast(float, __builtin_amdgcn_update_dpp(0, __builtin_bit_cast(int, v), CTRL, ROWMASK, 0xf, false)); }
__device__ __forceinline__ float wave_sum_u(float v) {
    v += dppf<0xB1>(v); v += dppf<0x4E>(v); v += dppf<0x141>(v); v += dppf<0x140>(v);
    v += dppf_rm<0x142, 0xA>(v);
    v += dppf_rm<0x143, 0xC>(v);
    return __builtin_bit_cast(float, __builtin_amdgcn_readlane(__builtin_bit_cast(int, v), 63));
}
__device__ __forceinline__ bf16_t bf1(float x) { return __builtin_bit_cast(bf16_t, (__bf16)x); }

#define SC_BAR() do { asm volatile("s_waitcnt lgkmcnt(0)" ::: "memory"); __builtin_amdgcn_s_barrier(); asm volatile("" ::: "memory"); } while (0)
constexpr int S3_RS = 144, S3_TS = 144;
constexpr int S3_AP = 0, S3_RP = 2304, S3_BN = 4608, S3_VN = 9216, S3_BR = 11520, S3_KR = 13824, S3_Y = 11520, S3_LF = 11520, S3_LKA = 16128, S3_TA = 17152, S3_LRA = 18176, S3_GC = 19200, S3_BON = 19456;
constexpr int S3_SL = 19584, S3_CT = 8 * S3_SL;
static_assert(S3_AP + 16 * S3_TS <= S3_RP && S3_RP + 16 * S3_TS <= S3_BN && S3_BN + 32 * S3_RS <= S3_VN && S3_VN + 16 * S3_RS <= S3_BR && S3_BR + 16 * S3_TS <= S3_KR && S3_KR + 16 * S3_TS <= S3_LKA && S3_Y + 4096 <= S3_LKA && S3_BON + 64 <= S3_SL, "scan slot map");
static_assert(S3_CT + 6 * 64 * 4 <= LDSCTL_OFF, "scan slots fit below the LDS control words");
__device__ __forceinline__ float rowsum4(float v) {
    const unsigned b = __builtin_bit_cast(unsigned, v);
    const auto r = __builtin_amdgcn_permlane16_swap(b, b, false, false);
    const float s = __builtin_bit_cast(float, (unsigned)r[0]) + __builtin_bit_cast(float, (unsigned)r[1]);
    const unsigned sb = __builtin_bit_cast(unsigned, s);
    const auto q = __builtin_amdgcn_permlane32_swap(sb, sb, false, false);
    return __builtin_bit_cast(float, (unsigned)q[0]) + __builtin_bit_cast(float, (unsigned)q[1]);
}
template <int CTRL> __device__ __forceinline__ float dpp_old(float oldv, float v) { return __builtin_bit_cast(float, __builtin_amdgcn_update_dpp(__builtin_bit_cast(int, oldv), __builtin_bit_cast(int, v), CTRL, 0xf, 0xf, false)); }
__device__ __forceinline__ u32x2 tr_read1(unsigned a) { u32x2 r; asm volatile("ds_read_b64_tr_b16 %0, %1\n\ts_waitcnt lgkmcnt(0)" : "=v"(r) : "v"(a) : "memory"); return r; }
__device__ __forceinline__ void tr_read_bk(unsigned a, bf16x8 (&bk)[4]) {
    u32x2 r[8];
    asm volatile("ds_read_b64_tr_b16 %0, %8\n\tds_read_b64_tr_b16 %1, %8 offset:576\n\tds_read_b64_tr_b16 %2, %8 offset:32\n\tds_read_b64_tr_b16 %3, %8 offset:608\n\t"
                 "ds_read_b64_tr_b16 %4, %8 offset:64\n\tds_read_b64_tr_b16 %5, %8 offset:640\n\tds_read_b64_tr_b16 %6, %8 offset:96\n\tds_read_b64_tr_b16 %7, %8 offset:672\n\ts_waitcnt lgkmcnt(0)"
                 : "=v"(r[0]), "=v"(r[1]), "=v"(r[2]), "=v"(r[3]), "=v"(r[4]), "=v"(r[5]), "=v"(r[6]), "=v"(r[7]) : "v"(a) : "memory");
#pragma unroll
    for (int m = 0; m < 4; ++m) bk[m] = mk8(r[2 * m].x, r[2 * m].y, r[2 * m + 1].x, r[2 * m + 1].y);
}
static_assert(4 * S3_RS == 576, "tr_read_bk offsets");

__device__ __forceinline__ void s3_gram_t(LAS unsigned char* myslot, int cc, int g) {
                f32x4 d1 = (f32x4){0.f, 0.f, 0.f, 0.f}, d2 = d1, d3 = d1, d4 = d1;
#pragma unroll
                for (int ks = 0; ks < 2; ++ks) {
                    const int off = cc * S3_TS + (32 * ks + 8 * g) * 2;
                    const bf16x8 fa = *(const LAS bf16x8*)(myslot + S3_AP + off), fr = *(const LAS bf16x8*)(myslot + S3_RP + off);
                    const bf16x8 fb = *(const LAS bf16x8*)(myslot + S3_BR + off), fk = *(const LAS bf16x8*)(myslot + S3_KR + off);
                    d1 = MFMA16(fa, fb, d1); d2 = MFMA16(fa, fk, d2); d3 = MFMA16(fr, fb, d3); d4 = MFMA16(fr, fk, d4);
                }
                asm volatile("" ::: "memory");
                const int colA = 8 * (cc >> 2) + (cc & 3);
#pragma unroll
                for (int reg = 0; reg < 4; ++reg) {
                    const int tt = 4 * g + reg, s = cc; const bool lo = s < tt, le = s <= tt;
                    *(LAS float*)(myslot + S3_LF + (tt * 16 + s) * 4) = lo ? d1[reg] : 0.f;
                    *(LAS bf16_t*)(myslot + S3_LKA + tt * 64 + (colA + 4) * 2) = bf1(lo ? d2[reg] : 0.f);
                    *(LAS bf16_t*)(myslot + S3_LKA + tt * 64 + colA * 2) = (bf16_t)0;
                    *(LAS bf16_t*)(myslot + S3_LRA + tt * 64 + colA * 2) = bf1(le ? d3[reg] : 0.f);
                    *(LAS bf16_t*)(myslot + S3_LRA + tt * 64 + (colA + 4) * 2) = bf1(le ? d4[reg] : 0.f);
                }
                LDS_WAIT();
                float Tc[16];
#pragma unroll
                for (int tt = 0; tt < 16; ++tt) {
                    float pa[4]; pa[0] = (cc == tt) ? 1.f : 0.f; pa[1] = 0.f; pa[2] = 0.f; pa[3] = 0.f;
#pragma unroll
                    for (int s4 = 0; s4 < (tt + 3) / 4; ++s4) { const f32x4 l4 = *(const LAS f32x4*)(myslot + S3_LF + (tt * 16 + 4 * s4) * 4);
#pragma unroll
                        for (int j = 0; j < 4; ++j) if (4 * s4 + j < tt) pa[j] += l4[j] * Tc[4 * s4 + j]; }
                    Tc[tt] = (pa[0] + pa[1]) + (pa[2] + pa[3]);
                }
                if (g == 0) {
#pragma unroll
                    for (int tt = 0; tt < 16; ++tt) { *(LAS bf16_t*)(myslot + S3_TA + tt * 64 + colA * 2) = bf1(Tc[tt]); *(LAS bf16_t*)(myslot + S3_TA + tt * 64 + (colA + 4) * 2) = (bf16_t)0; }
                }
}

__device__ __forceinline__ void ph_scan_pipe3(Frame& F) {
    if (F.vcu & 1) return;
    const int bh = F.vcu >> 1, b = bh >> 3, h = bh & 7, lane = F.lane, wave = F.wave;
    const int g = lane >> 4, cc = lane & 15;
    const bf16_t* proj = (const bf16_t*)(F.ws + WS_P); const bf16_t* lwb = (const bf16_t*)(F.ws + WS_LW); const bf16_t* ag = (const bf16_t*)(F.ws + WS_AG);
    bf16_t* ycat = (bf16_t*)(F.ws + WS_Y);
    constexpr int NR = SEQ / 64;
    for (int i = F.tid; i < 6 * 64; i += 512) { const int w_ = i >> 6, c_ = h * 64 + (i & 63);
        *(LAS float*)(F.lds + S3_CT + i * 4) = (w_ < 3) ? F.in[I_MURKV][w_ * 512 + c_] : (w_ == 3) ? F.in[I_KK][c_] : (w_ == 4) ? F.in[I_KA][c_] : F.in[I_RK][c_]; }
    __syncthreads();
    if (wave >= 4) {
        const int pw = wave - 4, t = cc;
        u32x4 qr[2], qk[2], qv[2], qa[2], pr[2], pk[2], pv[2], qlw[2];
#define S3_PREFETCH(cidx_) do { const int tl_ = 16 * (cidx_) + t; const size_t T_ = (size_t)b * SEQ + tl_; \
            const bf16_t* rp_ = proj + T_ * NPROJ + h * 64 + 16 * g; const bf16_t* ap_ = ag + T_ * 1024 + h * 64 + 16 * g; const bf16_t* lp_ = lwb + T_ * 512 + h * 64 + 16 * g; \
            _Pragma("unroll") for (int e_ = 0; e_ < 2; ++e_) { qr[e_] = *(const u32x4*)(rp_ + 8 * e_); qk[e_] = *(const u32x4*)(rp_ + 512 + 8 * e_); qv[e_] = *(const u32x4*)(rp_ + 1024 + 8 * e_); qa[e_] = *(const u32x4*)(ap_ + 8 * e_); } \
            _Pragma("unroll") for (int e_ = 0; e_ < 2; ++e_) qlw[e_] = *(const u32x4*)(lp_ + 8 * e_); \
            if (tl_ > 0) { _Pragma("unroll") for (int e_ = 0; e_ < 2; ++e_) { pr[e_] = *(const u32x4*)(rp_ - NPROJ + 8 * e_); pk[e_] = *(const u32x4*)(rp_ - NPROJ + 512 + 8 * e_); pv[e_] = *(const u32x4*)(rp_ - NPROJ + 1024 + 8 * e_); } } \
            else { _Pragma("unroll") for (int e_ = 0; e_ < 2; ++e_) { pr[e_] = (u32x4){0u, 0u, 0u, 0u}; pk[e_] = pr[e_]; pv[e_] = pr[e_]; } } } while (0)
        const LAS float* ct = (const LAS float*)(F.lds + S3_CT) + 16 * g;
        typedef float f32x2 __attribute__((ext_vector_type(2)));
#define S3_BF2(arr, j2) ((f32x2){bf_lo(arr[(j2) >> 2][(j2) & 3]), bf_hi(arr[(j2) >> 2][(j2) & 3])})
        f32x2 rr[8], kk[8], kq[8], av[8]; float cl[16]; unsigned vpk[8]; float ss = 0.f, bon = 0.f;
        auto stage1 = [&]() __attribute__((always_inline)) {
            f32x2 ssv = (f32x2){0.f, 0.f}, bov = ssv;
#pragma unroll
            for (int j4 = 0; j4 < 4; ++j4) {
                const f32x4 mur = *(const LAS f32x4*)(ct + 4 * j4), muk = *(const LAS f32x4*)(ct + 64 + 4 * j4), muv = *(const LAS f32x4*)(ct + 128 + 4 * j4);
                const f32x4 ckk = *(const LAS f32x4*)(ct + 192 + 4 * j4), cka = *(const LAS f32x4*)(ct + 256 + 4 * j4), crk = *(const LAS f32x4*)(ct + 320 + 4 * j4);
#pragma unroll
                for (int e = 0; e < 2; ++e) { const int j2 = 2 * j4 + e;
                    const f32x2 mur2 = (f32x2){mur[2 * e], mur[2 * e + 1]}, muk2 = (f32x2){muk[2 * e], muk[2 * e + 1]}, muv2 = (f32x2){muv[2 * e], muv[2 * e + 1]};
                    const f32x2 ckk2 = (f32x2){ckk[2 * e], ckk[2 * e + 1]}, cka2 = (f32x2){cka[2 * e], cka[2 * e + 1]}, crk2 = (f32x2){crk[2 * e], crk[2 * e + 1]};
                    const f32x2 r_ = S3_BF2(qr, j2), k_ = S3_BF2(qk, j2), v_ = S3_BF2(qv, j2); av[j2] = S3_BF2(qa, j2);
                    rr[j2] = r_ + (S3_BF2(pr, j2) - r_) * mur2; const f32x2 kx = k_ + (S3_BF2(pk, j2) - k_) * muk2; const f32x2 vv = v_ + (S3_BF2(pv, j2) - v_) * muv2;
                    kk[j2] = kx * ckk2; ssv += kk[j2] * kk[j2];
                    kq[j2] = kx * (1.0f + (av[j2] - 1.0f) * cka2); bov += rr[j2] * kq[j2] * crk2;
                    vpk[j2] = cvt2(vv[0], vv[1]); }
            }
#pragma unroll
            for (int j = 0; j < 16; ++j) cl[j] = (j & 1) ? bf_hi(qlw[j >> 3][(j >> 1) & 3]) : bf_lo(qlw[j >> 3][(j >> 1) & 3]);
            ss = rowsum4(ssv[0] + ssv[1]); bon = rowsum4(bov[0] + bov[1]);
        };
        S3_PREFETCH(pw);
        stage1();
#pragma unroll 1
        for (int R = 0; R <= NR; ++R) {
            __builtin_amdgcn_s_setprio(3);
            if (R < NR) {
                LAS unsigned char* myslot = F.lds + (4 * (R & 1) + pw) * S3_SL;
                if (R + 1 < NR) { S3_PREFETCH(4 * (R + 1) + pw); }
                { u32x4 w0, w1; w0.x = vpk[0]; w0.y = vpk[1]; w0.z = vpk[2]; w0.w = vpk[3]; w1.x = vpk[4]; w1.y = vpk[5]; w1.z = vpk[6]; w1.w = vpk[7];
                  *(LAS u32x4*)(myslot + S3_VN + t * S3_RS + 32 * g) = w0; *(LAS u32x4*)(myslot + S3_VN + t * S3_RS + 32 * g + 16) = w1; }
                const float nrm = rsqrtf(fmaxf(ss, 1e-24f));
                if (g == 0) *(LAS float*)(myslot + S3_BON + t * 4) = bon;
#pragma unroll
                for (int j = 0; j < 16; ++j) cl[j] += dppf<0x111>(cl[j]);
#pragma unroll
                for (int j = 0; j < 16; ++j) cl[j] += dppf<0x112>(cl[j]);
#pragma unroll
                for (int j = 0; j < 16; ++j) cl[j] += dppf<0x114>(cl[j]);
#pragma unroll
                for (int j = 0; j < 16; ++j) cl[j] += dppf<0x118>(cl[j]);
                const int rowb = (8 * (t >> 2) + (t & 3)) * S3_RS + 32 * g;
#pragma unroll
                for (int hf = 0; hf < 2; ++hf) {
                    f32x2 ec[4], ei[4], ep[4];
#pragma unroll
                    for (int e = 0; e < 4; ++e) { const int j2 = 4 * hf + e; ec[e][0] = __builtin_amdgcn_exp2f(1.4426950408889634f * cl[2 * j2]); ec[e][1] = __builtin_amdgcn_exp2f(1.4426950408889634f * cl[2 * j2 + 1]); }
#pragma unroll
                    for (int e = 0; e < 4; ++e) { ei[e][0] = __builtin_amdgcn_rcpf(ec[e][0]); ei[e][1] = __builtin_amdgcn_rcpf(ec[e][1]); ep[e][0] = dpp_old<0x111>(1.0f, ec[e][0]); ep[e][1] = dpp_old<0x111>(1.0f, ec[e][1]); }
                    if (t == 15) {
#pragma unroll
                        for (int q = 0; q < 2; ++q) *(LAS f32x4*)(myslot + S3_GC + (16 * g + 8 * hf + 4 * q) * 4) = (f32x4){ec[2 * q][0], ec[2 * q][1], ec[2 * q + 1][0], ec[2 * q + 1][1]}; }
                    unsigned apk[4], rpk[4], bpk[4], kpk[4];
#pragma unroll
                    for (int e = 0; e < 4; ++e) { const int j2 = 4 * hf + e;
                        const f32x2 kn = kk[j2] * nrm;
                        const f32x2 ah = -kn * ep[e], rh = rr[j2] * ec[e], bv = kn * av[j2] * ei[e], kv = kq[j2] * ei[e];
                        apk[e] = cvt2(ah[0], ah[1]); rpk[e] = cvt2(rh[0], rh[1]); bpk[e] = cvt2(bv[0], bv[1]); kpk[e] = cvt2(kv[0], kv[1]); }
#pragma unroll
                    for (int q2 = 0; q2 < 2; ++q2) { const int q = 2 * hf + q2; const int off = t * S3_TS + (32 * (g >> 1) + 8 * q + 4 * (g & 1)) * 2;
                        u32x2 w; w.x = apk[2 * q2]; w.y = apk[2 * q2 + 1]; *(LAS u32x2*)(myslot + S3_AP + off) = w;
                        w.x = rpk[2 * q2]; w.y = rpk[2 * q2 + 1]; *(LAS u32x2*)(myslot + S3_RP + off) = w;
                        w.x = bpk[2 * q2]; w.y = bpk[2 * q2 + 1]; *(LAS u32x2*)(myslot + S3_BR + off) = w;
                        w.x = kpk[2 * q2]; w.y = kpk[2 * q2 + 1]; *(LAS u32x2*)(myslot + S3_KR + off) = w; }
                    { u32x4 w0; w0.x = bpk[0]; w0.y = bpk[1]; w0.z = bpk[2]; w0.w = bpk[3]; *(LAS u32x4*)(myslot + S3_BN + rowb + 16 * hf) = w0;
                      w0.x = kpk[0]; w0.y = kpk[1]; w0.z = kpk[2]; w0.w = kpk[3]; *(LAS u32x4*)(myslot + S3_BN + 4 * S3_RS + rowb + 16 * hf) = w0; }
                }
            }
            SC_BAR();
            __builtin_amdgcn_s_setprio(0);
            if (R + 1 < NR) stage1();
            SC_BAR();
        }
#undef S3_PREFETCH
#undef S3_BF
#undef S3_BF2
    } else {
        const int es = lane >> 2, jq = lane & 3, jb = 16 * wave;
        float lnxg[16], lnxb[16];
#pragma unroll
        for (int j = 0; j < 16; ++j) { lnxg[j] = F.in[I_LNXG][h * 64 + 16 * jq + j]; lnxb[j] = F.in[I_LNXB][h * 64 + 16 * jq + j]; }
        f32x4 St[4];
#pragma unroll
        for (int m = 0; m < 4; ++m) St[m] = (f32x4){0.f, 0.f, 0.f, 0.f};
        bf16x8 Sb0 = mk8(0u, 0u, 0u, 0u), Sb1 = mk8(0u, 0u, 0u, 0u);
        const unsigned trl = (unsigned)((cc >> 2) * S3_RS + (cc & 3) * 8);
        SC_BAR();
        s3_gram_t(F.lds + (0 + wave) * S3_SL, cc, g);
        SC_BAR();
#pragma unroll 1
        for (int R = 0; R < NR; ++R) {
            const size_t tE = (size_t)b * SEQ + 16 * (4 * R + wave) + es;
            const u32x4 g0 = *(const u32x4*)(ag + tE * 1024 + 512 + h * 64 + 16 * jq), g1 = *(const u32x4*)(ag + tE * 1024 + 512 + h * 64 + 16 * jq + 8);
#pragma unroll 1
            for (int q = 0; q < 4; ++q) {
                const LAS unsigned char* sl = F.lds + (4 * (R & 1) + q) * S3_SL;
                const unsigned slb = (unsigned)(__UINTPTR_TYPE__)sl;
                const bf16x8 a0 = *(const LAS bf16x8*)(sl + S3_AP + cc * S3_TS + (8 * g) * 2), a1 = *(const LAS bf16x8*)(sl + S3_AP + cc * S3_TS + (32 + 8 * g) * 2);
                const bf16x8 r0 = *(const LAS bf16x8*)(sl + S3_RP + cc * S3_TS + (8 * g) * 2), r1 = *(const LAS bf16x8*)(sl + S3_RP + cc * S3_TS + (32 + 8 * g) * 2);
                const bf16x8 lka = *(const LAS bf16x8*)(sl + S3_LKA + cc * 64 + 16 * g), ta = *(const LAS bf16x8*)(sl + S3_TA + cc * 64 + 16 * g), lra = *(const LAS bf16x8*)(sl + S3_LRA + cc * 64 + 16 * g);
                f32x4 gc[4];
#pragma unroll
                for (int m = 0; m < 4; ++m) gc[m] = *(const LAS f32x4*)(sl + S3_GC + (16 * m + 4 * g) * 4);
                const u32x2 vd = tr_read1(slb + S3_VN + 4 * g * S3_RS + trl + 32 * wave);
                bf16x8 bkt[4]; tr_read_bk(slb + S3_BN + 8 * g * S3_RS + trl, bkt);
                const f32x4 z4 = (f32x4){0.f, 0.f, 0.f, 0.f};
                f32x4 X = MFMA16(lka, mk8(0u, 0u, vd.x, vd.y), z4); X = MFMA16(a0, Sb0, X); X = MFMA16(a1, Sb1, X);
                f32x4 Y = MFMA16(r0, Sb0, z4); Y = MFMA16(r1, Sb1, Y);
                const f32x4 U = MFMA16(ta, mk8(cvt2(X[0], X[1]), cvt2(X[2], X[3]), 0u, 0u), z4);
                const bf16x8 Bu = mk8(cvt2(U[0], U[1]), cvt2(U[2], U[3]), vd.x, vd.y);
#pragma unroll
                for (int m = 0; m < 4; ++m) St[m] = MFMA16(bkt[m], Bu, St[m]) * gc[m];
                Y = MFMA16(lra, Bu, Y);
                Sb0 = mk8(cvt2(St[0][0], St[0][1]), cvt2(St[0][2], St[0][3]), cvt2(St[1][0], St[1][1]), cvt2(St[1][2], St[1][3]));
                Sb1 = mk8(cvt2(St[2][0], St[2][1]), cvt2(St[2][2], St[2][3]), cvt2(St[3][0], St[3][1]), cvt2(St[3][2], St[3][3]));
#pragma unroll
                for (int reg = 0; reg < 4; ++reg) *(LAS float*)((LAS unsigned char*)sl + S3_Y + ((4 * g + reg) * 64 + jb + cc) * 4) = Y[reg];
            }
            SC_BAR();
            __builtin_amdgcn_s_setprio(3);
            {
                const LAS unsigned char* sl = F.lds + (4 * (R & 1) + wave) * S3_SL;
                const size_t t = tE;
                f32x4 y[4]; float s1 = 0.f;
#pragma unroll
                for (int k = 0; k < 4; ++k) { y[k] = *(const LAS f32x4*)(sl + S3_Y + (es * 64 + 16 * jq + 4 * k) * 4); s1 += (y[k][0] + y[k][1]) + (y[k][2] + y[k][3]); }
                s1 += dppf<0xB1>(s1); s1 += dppf<0x4E>(s1);
                const float mean = s1 * (1.0f / 64.0f); float s2 = 0.f;
#pragma unroll
                for (int k = 0; k < 4; ++k) { y[k] = y[k] - mean; s2 += (y[k][0] * y[k][0] + y[k][1] * y[k][1]) + (y[k][2] * y[k][2] + y[k][3] * y[k][3]); }
                s2 += dppf<0xB1>(s2); s2 += dppf<0x4E>(s2);
                const float rstd = rsqrtf(s2 * (1.0f / 64.0f) + LNX_EPS);
                const float bon = *(const LAS float*)(sl + S3_BON + es * 4);
                const u32x4 vv0 = *(const LAS u32x4*)(sl + S3_VN + es * S3_RS + 32 * jq), vv1 = *(const LAS u32x4*)(sl + S3_VN + es * S3_RS + 32 * jq + 16);
                float gg[16], vv[16];
                gg[0] = bf_lo(g0.x); gg[1] = bf_hi(g0.x); gg[2] = bf_lo(g0.y); gg[3] = bf_hi(g0.y); gg[4] = bf_lo(g0.z); gg[5] = bf_hi(g0.z); gg[6] = bf_lo(g0.w); gg[7] = bf_hi(g0.w);
                gg[8] = bf_lo(g1.x); gg[9] = bf_hi(g1.x); gg[10] = bf_lo(g1.y); gg[11] = bf_hi(g1.y); gg[12] = bf_lo(g1.z); gg[13] = bf_hi(g1.z); gg[14] = bf_lo(g1.w); gg[15] = bf_hi(g1.w);
                vv[0] = bf_lo(vv0.x); vv[1] = bf_hi(vv0.x); vv[2] = bf_lo(vv0.y); vv[3] = bf_hi(vv0.y); vv[4] = bf_lo(vv0.z); vv[5] = bf_hi(vv0.z); vv[6] = bf_lo(vv0.w); vv[7] = bf_hi(vv0.w);
                vv[8] = bf_lo(vv1.x); vv[9] = bf_hi(vv1.x); vv[10] = bf_lo(vv1.y); vv[11] = bf_hi(vv1.y); vv[12] = bf_lo(vv1.z); vv[13] = bf_hi(vv1.z); vv[14] = bf_lo(vv1.w); vv[15] = bf_hi(vv1.w);
                float o[16];
#pragma unroll
                for (int j = 0; j < 16; ++j) o[j] = (y[j >> 2][j & 3] * rstd * lnxg[j] + lnxb[j] + bon * vv[j]) * gg[j];
                u32x4 w0, w1; w0.x = cvt2(o[0], o[1]); w0.y = cvt2(o[2], o[3]); w0.z = cvt2(o[4], o[5]); w0.w = cvt2(o[6], o[7]);
                w1.x = cvt2(o[8], o[9]); w1.y = cvt2(o[10], o[11]); w1.z = cvt2(o[12], o[13]); w1.w = cvt2(o[14], o[15]);
                *(u32x4*)(ycat + t * DM + h * 64 + 16 * jq) = w0; *(u32x4*)(ycat + t * DM + h * 64 + 16 * jq + 8) = w1;
            }
            if (R + 1 < NR) s3_gram_t(F.lds + (4 * ((R + 1) & 1) + wave) * S3_SL, cc, g);
            __builtin_amdgcn_s_setprio(0);
            SC_BAR();
        }
    }
    __syncthreads();
}

constexpr int AT_OST = 0, AT_OST_CH = 4352, AT_ML = 69632, AT_BIAS = 71680, AT_V = 77824, AT_VW = 5120, AT_VRS = 160;
constexpr int AT_BLD = 512, AT_BOFF = 192;
static_assert(AT_V + 8 * AT_VW <= LDSCTL_OFF, "attention LDS map");
constexpr int MW_UNIT = 164;
constexpr int CW_ATTQ = 8192 + 192;
constexpr int CW_GUDONE = 8192 + 224;
constexpr int CW_STAMP = 8192 + 1024;
typedef short at_s16x4 __attribute__((ext_vector_type(4)));
__device__ __forceinline__ u32x2 at_tr16(unsigned a) { return __builtin_bit_cast(u32x2, __builtin_amdgcn_ds_read_tr16_b64_v4i16((LAS at_s16x4*)(__UINTPTR_TYPE__)a)); }
__device__ __forceinline__ void tr_read8(unsigned a, bf16x8 (&vt)[4]) {
#pragma unroll
    for (int mm = 0; mm < 4; ++mm) { const u32x2 r0 = at_tr16(a + 32 * mm), r1 = at_tr16(a + 2560 + 32 * mm); vt[mm] = mk8(r0.x, r0.y, r1.x, r1.y); }
}
static_assert(16 * AT_VRS == 2560, "tr_read8 offsets");
constexpr int AT2_OST = 0, AT2_OST_CH = 2176, AT2_ML = 34816, AT2_BIAS = 36864, AT2_V = 43008;
constexpr int AT_KRS = 144, AT_KW = 32 * AT_KRS, AT_WAVE = 2 * AT_VW + AT_KW;
static_assert(AT2_V + 8 * AT_WAVE <= LDSCTL_OFF, "paired attention LDS map");
struct AtSt { float m, l; f32x4 o[4]; };
__device__ __forceinline__ float rowmax4(float v) {
    const unsigned b = __builtin_bit_cast(unsigned, v);
    const auto r = __builtin_amdgcn_permlane16_swap(b, b, false, false);
    const float f0 = __builtin_bit_cast(float, (unsigned)r[0]), f1 = __builtin_bit_cast(float, (unsigned)r[1]);
    const float m = f0 > f1 ? f0 : f1;
    const unsigned mb = __builtin_bit_cast(unsigned, m);
    const auto q = __builtin_amdgcn_permlane32_swap(mb, mb, false, false);
    const float g0 = __builtin_bit_cast(float, (unsigned)q[0]), g1 = __builtin_bit_cast(float, (unsigned)q[1]);
    return g0 > g1 ? g0 : g1;
}
template <bool SHARED, int YSHIFT>
__device__ __forceinline__ void attn_pair(const bf16_t* projb, int h, int qposX, int qposY, int lq, int lk_start, int ntiles, int dil, int residX, int residY,
                                          const LAS float* biasp, LAS unsigned char* vbufX, LAS unsigned char* vbufY, LAS unsigned char* kst, int lane, AtSt& X, AtSt& Y) {
    const int g = lane >> 4, c = lane & 15;
    bf16x8 qfX[2], qfY[2];
#pragma unroll
    for (int ks = 0; ks < 2; ++ks) { qfX[ks] = *(const bf16x8*)(projb + (size_t)qposX * NPROJ + 1536 + h * 64 + 32 * ks + 8 * g); qfY[ks] = *(const bf16x8*)(projb + (size_t)qposY * NPROJ + 1536 + h * 64 + 32 * ks + 8 * g); }
    const int kt0 = (lk_start < 0) ? ((-lk_start) >> 5) : 0;
    bf16x8 kfX[2][2], kfY[2][2]; u32x4 krX[4], krY[4], vrX[4], vrY[4];
    constexpr int ROWB = NPROJ * 2;
    const char* hb = (const char*)(projb + h * 64);
    const unsigned koX = (unsigned)(((lane >> 3) * dil + residX) * ROWB + (2048 + 8 * (lane & 7)) * 2), koY = (unsigned)(((lane >> 3) * dil + residY) * ROWB + (2048 + 8 * (lane & 7)) * 2);
    const int step8 = 8 * dil * ROWB;
    const __amdgpu_buffer_rsrc_t rs = __builtin_amdgcn_make_buffer_rsrc((void*)hb, 0, 0x7fffffff, 0x00020000);
#define AT2_LOADKV(kr, vr, so, ko) do { \
        _Pragma("unroll") for (int k_ = 0; k_ < 4; ++k_) { kr[k_] = __builtin_amdgcn_raw_buffer_load_b128(rs, ko, (so) + k_ * step8, 0); vr[k_] = __builtin_amdgcn_raw_buffer_load_b128(rs, ko + 1024u, (so) + k_ * step8, 0); } } while (0)
#define AT2_LOADFIRST(kr, vr, resid_) do { \
        _Pragma("unroll") for (int k_ = 0; k_ < 4; ++k_) { int lk_ = lk_start + 32 * kt0 + 8 * k_ + (lane >> 3); lk_ = lk_ < 0 ? 0 : lk_; const unsigned o_ = (unsigned)((lk_ * dil + (resid_)) * ROWB + (2048 + 8 * (lane & 7)) * 2); \
            kr[k_] = __builtin_amdgcn_raw_buffer_load_b128(rs, o_, 0, 0); vr[k_] = __builtin_amdgcn_raw_buffer_load_b128(rs, o_ + 1024u, 0, 0); } } while (0)
#define AT2_KFRAGS(kf, kr) do { \
        _Pragma("unroll") for (int k_ = 0; k_ < 4; ++k_) *(LAS u32x4*)(kst + ((lane >> 3) + 8 * k_) * AT_KRS + (lane & 7) * 16) = kr[k_]; \
        _Pragma("unroll") for (int st = 0; st < 2; ++st) { kf[st][0] = *(const LAS bf16x8*)(kst + (16 * st + c) * AT_KRS + g * 16); kf[st][1] = *(const LAS bf16x8*)(kst + (16 * st + c) * AT_KRS + (4 + g) * 16); } } while (0)
    if (kt0 < ntiles) { AT2_LOADFIRST(krX, vrX, residX); if (!SHARED) AT2_LOADFIRST(krY, vrY, residY); }
    const bool negfirst = (lk_start + 32 * kt0) < 0;
    const unsigned trX = (unsigned)(__UINTPTR_TYPE__)vbufX + (unsigned)((4 * g + ((lane & 15) >> 2)) * AT_VRS + (lane & 3) * 8);
    const unsigned trY = (unsigned)(__UINTPTR_TYPE__)vbufY + (unsigned)((4 * g + ((lane & 15) >> 2)) * AT_VRS + (lane & 3) * 8);
    constexpr float C2 = 0.125f * 1.4426950408889634f;
#pragma unroll 1
    for (int kt = kt0; kt < ntiles; ++kt) {
#pragma unroll
        for (int k = 0; k < 4; ++k) { const int id = lane + 64 * k; *(LAS u32x4*)(vbufX + (id >> 3) * AT_VRS + (id & 7) * 16) = vrX[k]; if (!SHARED) *(LAS u32x4*)(vbufY + (id >> 3) * AT_VRS + (id & 7) * 16) = vrY[k]; }
        AT2_KFRAGS(kfX, krX); if (!SHARED) AT2_KFRAGS(kfY, krY);
        const f32x4 z4 = (f32x4){0.f, 0.f, 0.f, 0.f}; f32x4 sX[2], sY[2];
#pragma unroll
        for (int st = 0; st < 2; ++st) {
            sX[st] = MFMA16(kfX[st][0], qfX[0], z4); sX[st] = MFMA16(kfX[st][1], qfX[1], sX[st]);
            if (SHARED) { sY[st] = MFMA16(kfX[st][0], qfY[0], z4); sY[st] = MFMA16(kfX[st][1], qfY[1], sY[st]); }
            else { sY[st] = MFMA16(kfY[st][0], qfY[0], z4); sY[st] = MFMA16(kfY[st][1], qfY[1], sY[st]); }
        }
        if (kt + 1 < ntiles) { const int so = (lk_start + 32 * (kt + 1)) * dil * ROWB;
            AT2_LOADKV(krX, vrX, so, koX); if (!SHARED) AT2_LOADKV(krY, vrY, so, koY); }
        const int lkb = lk_start + 32 * kt + 4 * g;
        const int rel0 = lq - lkb;
        const LAS float* bp = biasp + (rel0 - 19 + AT_BOFF);
        float biaX[2][4], biaY[2][4];
#pragma unroll
        for (int st = 0; st < 2; ++st)
#pragma unroll
            for (int reg = 0; reg < 4; ++reg) biaX[st][reg] = bp[19 - 16 * st - reg];
#pragma unroll
        for (int reg = 0; reg < 4; ++reg) {
            if (SHARED && YSHIFT == 16) { biaY[0][reg] = bp[35 - reg]; biaY[1][reg] = biaX[0][reg]; }
            else if (SHARED) { biaY[0][reg] = reg ? biaX[0][reg - 1] : bp[19 + YSHIFT]; biaY[1][reg] = reg ? biaX[1][reg - 1] : bp[3 + YSHIFT]; }
            else { biaY[0][reg] = biaX[0][reg]; biaY[1][reg] = biaX[1][reg]; }
        }
        if (negfirst && kt == kt0) {
#pragma unroll
            for (int st = 0; st < 2; ++st)
#pragma unroll
                for (int reg = 0; reg < 4; ++reg) { const bool neg = (lkb + 16 * st + reg) < 0; biaX[st][reg] = neg ? -INFINITY : biaX[st][reg]; biaY[st][reg] = neg ? -INFINITY : biaY[st][reg]; }
        }
        float lgX[2][4], lgY[2][4];
#pragma unroll
        for (int st = 0; st < 2; ++st)
#pragma unroll
            for (int reg = 0; reg < 4; ++reg) { lgX[st][reg] = sX[st][reg] * C2 + biaX[st][reg]; lgY[st][reg] = sY[st][reg] * C2 + biaY[st][reg]; }
        float pX[2][4], pY[2][4]; float psX = 0.f, psY = 0.f;
#pragma unroll
        for (int st = 0; st < 2; ++st)
#pragma unroll
            for (int reg = 0; reg < 4; ++reg) { pX[st][reg] = __builtin_amdgcn_exp2f(lgX[st][reg] - X.m); psX += pX[st][reg];
                                                pY[st][reg] = __builtin_amdgcn_exp2f(lgY[st][reg] - Y.m); psY += pY[st][reg]; }
        if (__builtin_amdgcn_ballot_w64(!(psX <= 256.0f) || !(psY <= 256.0f)) != 0ull) {
            float tmX = fmaxf(fmaxf(lgX[0][0], lgX[0][1]), lgX[0][2]), tmY = fmaxf(fmaxf(lgY[0][0], lgY[0][1]), lgY[0][2]);
            tmX = fmaxf(fmaxf(tmX, lgX[0][3]), lgX[1][0]); tmY = fmaxf(fmaxf(tmY, lgY[0][3]), lgY[1][0]);
            tmX = fmaxf(fmaxf(tmX, lgX[1][1]), lgX[1][2]); tmY = fmaxf(fmaxf(tmY, lgY[1][1]), lgY[1][2]);
            tmX = fmaxf(tmX, lgX[1][3]); tmY = fmaxf(tmY, lgY[1][3]);
            tmX = rowmax4(tmX); tmY = rowmax4(tmY);
            const float mnX = fmaxf(X.m, tmX), mnY = fmaxf(Y.m, tmY);
            const float alX = __builtin_amdgcn_exp2f(X.m - mnX), alY = __builtin_amdgcn_exp2f(Y.m - mnY); X.m = mnX; Y.m = mnY;
            X.l *= alX; Y.l *= alY;
#pragma unroll
            for (int mm = 0; mm < 4; ++mm) { X.o[mm] = X.o[mm] * alX; Y.o[mm] = Y.o[mm] * alY; }
            psX = 0.f; psY = 0.f;
#pragma unroll
            for (int st = 0; st < 2; ++st)
#pragma unroll
                for (int reg = 0; reg < 4; ++reg) { pX[st][reg] = __builtin_amdgcn_exp2f(lgX[st][reg] - mnX); psX += pX[st][reg];
                                                    pY[st][reg] = __builtin_amdgcn_exp2f(lgY[st][reg] - mnY); psY += pY[st][reg]; }
        }
        X.l += psX; Y.l += psY;
        const bf16x8 PbX = mk8(cvt2(pX[0][0], pX[0][1]), cvt2(pX[0][2], pX[0][3]), cvt2(pX[1][0], pX[1][1]), cvt2(pX[1][2], pX[1][3]));
        const bf16x8 PbY = mk8(cvt2(pY[0][0], pY[0][1]), cvt2(pY[0][2], pY[0][3]), cvt2(pY[1][0], pY[1][1]), cvt2(pY[1][2], pY[1][3]));
        bf16x8 vt[4], vu[4]; tr_read8(trX, vt); if (!SHARED) tr_read8(trY, vu);
#pragma unroll
        for (int mm = 0; mm < 4; ++mm) X.o[mm] = MFMA16(vt[mm], PbX, X.o[mm]);
#pragma unroll
        for (int mm = 0; mm < 4; ++mm) Y.o[mm] = MFMA16(SHARED ? vt[mm] : vu[mm], PbY, Y.o[mm]);
    }
#undef AT2_LOADKV
#undef AT2_LOADFIRST
#undef AT2_KFRAGS
}

__device__ __forceinline__ void ph_attn_mfma2(Frame& F) {
    const bf16_t* proj = (const bf16_t*)(F.ws + WS_P); bf16_t* ycat = (bf16_t*)(F.ws + WS_Y); const float* bt = (const float*)(F.ws + WS_BIAS);
    const int lane = F.lane, wave = F.wave, g = lane >> 4, c = lane & 15;
    LAS unsigned char* vbufX = F.lds + AT2_V + wave * AT_WAVE; LAS unsigned char* vbufY = vbufX + AT_VW; LAS unsigned char* kst = vbufX + 2 * AT_VW;
    LAS float* biasl = (LAS float*)(F.lds + AT2_BIAS);
    int hload = -1;
    for (;;) {
        if (F.tid == 0) F.MISC[MW_UNIT] = atomicAdd(F.ctl + CW_ATTQ, 1u);
        __syncthreads();
        const int unit = __builtin_amdgcn_readfirstlane((int)F.MISC[MW_UNIT]);
        if (unit >= NB * 8 * 8) break;
        int u, b, h; if (unit < NB * 8 * 7) { h = unit / (NB * 7); const int r_ = unit % (NB * 7); b = r_ / 7; u = 1 + r_ % 7; } else { const int r_ = unit - NB * 8 * 7; h = r_ / NB; b = r_ % NB; u = 0; }
        if (h != hload) { hload = h;
            for (int i = F.tid; i < 3 * AT_BLD; i += 512) { const int p_ = i / AT_BLD, rel_ = (i % AT_BLD) - AT_BOFF; biasl[i] = (rel_ >= 0 && rel_ <= 128) ? 1.4426950408889634f * bt[(p_ * 8 + h) * BIAS_LD + rel_] : -INFINITY; }
            __syncthreads(); }
        const bf16_t* projb = proj + (size_t)b * SEQ * NPROJ;
        AtSt X, Y;
        {
            const int base = 256 * u + 32 * wave;
            X.m = -1e30f; X.l = 0.f; Y.m = -1e30f; Y.l = 0.f;
#pragma unroll
            for (int mm = 0; mm < 4; ++mm) { X.o[mm] = (f32x4){0.f, 0.f, 0.f, 0.f}; Y.o[mm] = (f32x4){0.f, 0.f, 0.f, 0.f}; }
            attn_pair<true, 16>(projb, h, base + c, base + 16 + c, base + c, base - 128, 5, 1, 0, 0, biasl, vbufX, vbufX, kst, lane, X, Y);
            X.l += __shfl_xor(X.l, 16); X.l += __shfl_xor(X.l, 32); Y.l += __shfl_xor(Y.l, 16); Y.l += __shfl_xor(Y.l, 32);
#pragma unroll
            for (int t2 = 0; t2 < 2; ++t2) { const AtSt& S = t2 ? Y : X; const int ql = 32 * wave + 16 * t2 + c, qp = ql + (ql >> 4);
#pragma unroll
                for (int mm = 0; mm < 4; ++mm) { u32x2 w; w.x = cvt2(S.o[mm][0], S.o[mm][1]); w.y = cvt2(S.o[mm][2], S.o[mm][3]); *(LAS u32x2*)(F.lds + AT2_OST + (mm * 4 + g) * AT2_OST_CH + qp * 8) = w; }
                if (g == 0) { *(LAS float*)(F.lds + AT2_ML + ql * 4) = S.m; *(LAS float*)(F.lds + AT2_ML + 1024 + ql * 4) = S.l; } }
        }
        __syncthreads();
        {
            const int d0 = (wave & 3) + 8 * (wave >> 2);
#pragma unroll
            for (int t2 = 0; t2 < 2; ++t2) { AtSt& S = t2 ? Y : X; const int ql = 16 * c + d0 + 4 * t2, qp = ql + (ql >> 4);
                S.m = *(const LAS float*)(F.lds + AT2_ML + ql * 4); S.l = (g == 0) ? *(const LAS float*)(F.lds + AT2_ML + 1024 + ql * 4) : 0.f;
#pragma unroll
                for (int mm = 0; mm < 4; ++mm) { const u32x2 w = *(const LAS u32x2*)(F.lds + AT2_OST + (mm * 4 + g) * AT2_OST_CH + qp * 8);
                    S.o[mm] = (f32x4){bf_lo(w.x), bf_hi(w.x), bf_lo(w.y), bf_hi(w.y)}; } }
            const int qposX = 256 * u + 16 * c + d0, qposY = qposX + 4;
            attn_pair<true, 1>(projb, h, qposX, qposY, 64 * u + 4 * c + (d0 >> 2), 64 * u + 61 + (d0 >> 2) - 191, 6, 4, d0 & 3, d0 & 3, biasl + AT_BLD, vbufX, vbufX, kst, lane, X, Y);
            attn_pair<false, 0>(projb, h, qposX, qposY, 16 * u + c, 16 * u - 144, 5, 16, d0, d0 + 4, biasl + 2 * AT_BLD, vbufX, vbufY, kst, lane, X, Y);
#pragma unroll
            for (int t2 = 0; t2 < 2; ++t2) { AtSt& S = t2 ? Y : X; float l = S.l; l += __shfl_xor(l, 16); l += __shfl_xor(l, 32); const float inv = 1.0f / l;
                bf16_t* op = ycat + ((size_t)b * SEQ + qposX + 4 * t2) * DM + 512 + h * 64 + 4 * g;
#pragma unroll
                for (int mm = 0; mm < 4; ++mm) { u32x2 w; w.x = cvt2(S.o[mm][0] * inv, S.o[mm][1] * inv); w.y = cvt2(S.o[mm][2] * inv, S.o[mm][3] * inv); *(u32x2*)(op + 16 * mm) = w; } }
        }
        __syncthreads();
        moe_weight_items3(F, unit * MOE_ROUNDS_PER_UNIT * NWAVES + wave, (LAS float*)(F.lds + AT2_V + wave * 8448));
        late_prologue_items(F, unit, (LAS float*)(F.lds + AT2_V + wave * 8448));
    }
}

constexpr int LR_XH = 0, LR_XL = 33280, LR_RS = 2064, LR_PP = 66560, LR_LG = 91136, LR_GB = 94208, LR_TOKE = 102400, LR_TOKW = 103424;
#define LR_BAR() do { asm volatile("s_waitcnt lgkmcnt(0)" ::: "memory"); __builtin_amdgcn_s_barrier(); asm volatile("" ::: "memory"); } while (0)
__device__ __forceinline__ void ph_ln1_router_mfma(Frame& F) {
    const int lane = F.lane, wave = F.wave, g = lane >> 4, c = lane & 15;
    if (F.tid < 32) F.MISC[MW_HIST + F.tid] = 0u;
    bf16_t* x1b = (bf16_t*)(F.ws + WS_Y);
    int* toke = (int*)(F.ws + WS_TOKE); float* tokw = (float*)(F.ws + WS_TOKW);
    const bf16_t* wrt = (const bf16_t*)(F.ws + WS_WRT);
    bf16x8 wf[2][4][3];
#pragma unroll
    for (int hl = 0; hl < 2; ++hl)
#pragma unroll
        for (int ks = 0; ks < 4; ++ks)
#pragma unroll
            for (int nt = 0; nt < 3; ++nt) wf[hl][ks][nt] = *(const bf16x8*)(wrt + (size_t)hl * 48 * 1024 + (size_t)(16 * nt + c) * 1024 + 128 * wave + 32 * ks + 8 * g);
    for (int i = F.tid; i < DM / 4; i += 512) { *(LAS f32x4*)(F.lds + LR_GB + i * 16) = *(const f32x4*)(F.in[I_LN1G] + 4 * i); *(LAS f32x4*)(F.lds + LR_GB + 4096 + i * 16) = *(const f32x4*)(F.in[I_LN1B] + 4 * i); }
    float rbias0, rbias1;
    { const int c0 = F.tid % 48, c1 = (F.tid + 512) % 48;
      rbias0 = (c0 < 4) ? F.in[I_RGB][c0] : (c0 < 36) ? F.in[I_REB][c0 - 4] : 0.f;
      rbias1 = (c1 < 4) ? F.in[I_RGB][c1] : (c1 < 36) ? F.in[I_REB][c1 - 4] : 0.f; }
    const int rows_per_wg = NTOK / F.G;
    const int ngrp = rows_per_wg / 16;
    __syncthreads();
    f32x4 pxv[2][4]; u32x2 pmw[2][4];
#define LR_PREFETCH(grp_) do { _Pragma("unroll") for (int rr_ = 0; rr_ < 2; ++rr_) { const int row_ = F.vcu * rows_per_wg + 16 * (grp_) + 2 * wave + rr_; \
        const float* xin_ = F.in[I_X] + (size_t)row_ * DM + 4 * lane; const bf16_t* mx_ = (const bf16_t*)(F.ws + WS_HDN) + (size_t)row_ * DM + 4 * lane; \
        _Pragma("unroll") for (int j_ = 0; j_ < 4; ++j_) { pxv[rr_][j_] = __builtin_nontemporal_load((const f32x4*)(xin_ + 256 * j_)); pmw[rr_][j_] = __builtin_nontemporal_load((const u32x2*)(mx_ + 256 * j_)); } } } while (0)
    LR_PREFETCH(0);
#pragma unroll 1
    for (int grp = 0; grp < ngrp; ++grp) {
        const int row0 = F.vcu * rows_per_wg + 16 * grp;
#pragma unroll
        for (int rr = 0; rr < 2; ++rr) {
            const int rl = 2 * wave + rr, row = row0 + rl;
            f32x4 v[4]; float s = 0.f;
#pragma unroll
            for (int j = 0; j < 4; ++j) { const f32x4 xv = pxv[rr][j]; const u32x2 mw = pmw[rr][j];
                v[j] = xv * ALPHA + (f32x4){bf_lo(mw.x), bf_hi(mw.x), bf_lo(mw.y), bf_hi(mw.y)}; s += (v[j][0] + v[j][1]) + (v[j][2] + v[j][3]); }
            const float mean = wave_sum_u(s) * (1.0f / DM); float s2 = 0.f;
#pragma unroll
            for (int j = 0; j < 4; ++j) { v[j] = v[j] - mean; s2 += (v[j][0] * v[j][0] + v[j][1] * v[j][1]) + (v[j][2] * v[j][2] + v[j][3] * v[j][3]); }
            const float rstd = rsqrtf(wave_sum_u(s2) * (1.0f / DM) + LN_EPS);
#pragma unroll
            for (int j = 0; j < 4; ++j) { const f32x4 gvj = *(const LAS f32x4*)(F.lds + LR_GB + (lane + 64 * j) * 16), bvj = *(const LAS f32x4*)(F.lds + LR_GB + 4096 + (lane + 64 * j) * 16);
                v[j] = v[j] * rstd * gvj + bvj;
                u32x2 wh; wh.x = cvt2(v[j][0], v[j][1]); wh.y = cvt2(v[j][2], v[j][3]);
                *(u32x2*)(x1b + (size_t)row * DM + 4 * lane + 256 * j) = wh;
                float lo[4];
                lo[0] = v[j][0] - bf_lo(wh.x); lo[1] = v[j][1] - bf_hi(wh.x); lo[2] = v[j][2] - bf_lo(wh.y); lo[3] = v[j][3] - bf_hi(wh.y);
                u32x2 wl; wl.x = cvt2(lo[0], lo[1]); wl.y = cvt2(lo[2], lo[3]);
                *(LAS u32x2*)(F.lds + LR_XH + rl * LR_RS + (4 * lane + 256 * j) * 2) = wh;
                *(LAS u32x2*)(F.lds + LR_XL + rl * LR_RS + (4 * lane + 256 * j) * 2) = wl; }
        }
        if (grp + 1 < ngrp) LR_PREFETCH(grp + 1);
        LR_BAR();
        {
            f32x4 acc[3];
#pragma unroll
            for (int nt = 0; nt < 3; ++nt) acc[nt] = (f32x4){0.f, 0.f, 0.f, 0.f};
#pragma unroll
            for (int ks = 0; ks < 4; ++ks) {
                const int off = c * LR_RS + (128 * wave + 32 * ks + 8 * g) * 2;
                const bf16x8 ah = *(const LAS bf16x8*)(F.lds + LR_XH + off), al = *(const LAS bf16x8*)(F.lds + LR_XL + off);
#pragma unroll
                for (int nt = 0; nt < 3; ++nt) { acc[nt] = MFMA16(ah, wf[0][ks][nt], acc[nt]); acc[nt] = MFMA16(al, wf[0][ks][nt], acc[nt]); acc[nt] = MFMA16(ah, wf[1][ks][nt], acc[nt]); }
            }
#pragma unroll
            for (int nt = 0; nt < 3; ++nt)
#pragma unroll
                for (int reg = 0; reg < 4; ++reg) *(LAS float*)(F.lds + LR_PP + ((wave * 16 + 4 * g + reg) * 48 + 16 * nt + c) * 4) = acc[nt][reg];
        }
        LR_BAR();
        for (int i = F.tid, it_ = 0; i < 16 * 48; i += 512, ++it_) { float a = it_ ? rbias1 : rbias0;
#pragma unroll
            for (int w = 0; w < 8; ++w) a += *(const LAS float*)(F.lds + LR_PP + (w * 16 * 48 + i) * 4);
            *(LAS float*)(F.lds + LR_LG + i * 4) = a; }
        LR_BAR();
        if (F.tid < 16) {
            const int row = row0 + F.tid; const LAS float* lgp = (const LAS float*)(F.lds + LR_LG + F.tid * 48 * 4);
            float gl[4];
#pragma unroll
            for (int i = 0; i < 4; ++i) gl[i] = lgp[i];
            int grpi = 0; float gm = gl[0];
#pragma unroll
            for (int i = 1; i < 4; ++i) if (gl[i] > gm) { gm = gl[i]; grpi = i; }
            float se = 0.f;
#pragma unroll
            for (int i = 0; i < 4; ++i) se += __expf(gl[i] - gm);
            const float wg = 1.0f / se;
            float le[8];
#pragma unroll
            for (int i = 0; i < 8; ++i) le[i] = lgp[4 + grpi * 8 + i];
            int i0 = 0; float v0 = le[0];
#pragma unroll
            for (int i = 1; i < 8; ++i) if (le[i] > v0) { v0 = le[i]; i0 = i; }
            int i1 = (i0 == 0) ? 1 : 0; float v1 = (i0 == 0) ? le[1] : le[0];
#pragma unroll
            for (int i = 0; i < 8; ++i) if (i != i0 && le[i] > v1) { v1 = le[i]; i1 = i; }
            const float e1 = __expf(v1 - v0); const float w0 = wg / (1.0f + e1), w1 = wg * e1 / (1.0f + e1);
            const int ex0 = grpi * 8 + i0, ex1 = grpi * 8 + i1;
            const unsigned ix0 = atomicAdd((unsigned*)&F.MISC[MW_HIST + ex0], 1u), ix1 = atomicAdd((unsigned*)&F.MISC[MW_HIST + ex1], 1u);
            const int al = 2 * (16 * grp + (int)F.tid);
            *(LAS unsigned*)(F.lds + LR_TOKE + al * 4) = (unsigned)ex0 | (ix0 << 5); *(LAS unsigned*)(F.lds + LR_TOKE + al * 4 + 4) = (unsigned)ex1 | (ix1 << 5);
            *(LAS float*)(F.lds + LR_TOKW + al * 4) = w0; *(LAS float*)(F.lds + LR_TOKW + al * 4 + 4) = w1;
        }
    }
    __syncthreads();
    if (F.tid < 32) { const unsigned hc = F.MISC[MW_HIST + F.tid]; F.MISC[MW_LBASE + F.tid] = hc ? atomicAdd(F.ctl + CW_CNT + F.tid, hc) : 0u; }
}

__device__ __forceinline__ void ph_positions(Frame& F) {
    int* row_tok = (int*)(F.ws + WS_ROWTOK); int* row_asg = (int*)(F.ws + WS_ROWASG); float* row_w = (float*)(F.ws + WS_ROWW);
    unsigned cnt = 0u;
    if (F.tid < 32) { cnt = __hip_atomic_load(F.ctl + CW_CNT + F.tid, RLX_AGENT); F.MISC[MW_CNT + F.tid] = cnt; }
    __syncthreads();
    if (F.tid < 32) {
        unsigned rs = 0u;
        for (int e = 0; e < (int)F.tid; ++e) rs += ((F.MISC[MW_CNT + e] + 255u) >> 8) << 8;
        F.MISC[MW_RS + F.tid] = rs;
        if (blockIdx.x == 0) { const unsigned nt = (cnt + 255u) >> 8;
            for (unsigned q = 0; q < nt; ++q) F.ctl[CW_TILEE + (rs >> 8) + q] = (unsigned)F.tid;
            if (F.tid == 31) F.ctl[CW_NTILES] = (rs >> 8) + nt; }
    }
    __syncthreads();
    const int per = NTOK / F.G;
    const int base = F.vcu * per;
    for (int a = F.tid; a < 2 * per; a += 512) {
        const unsigned pk = *(const LAS unsigned*)(F.lds + LR_TOKE + a * 4); const int e = (int)(pk & 31u), idx = (int)(pk >> 5);
        const int tok = base + (a >> 1);
        const unsigned pos = F.MISC[MW_RS + e] + F.MISC[MW_LBASE + e] + (unsigned)idx;
        row_tok[pos] = tok; row_asg[pos] = 2 * tok + (a & 1); row_w[pos] = *(const LAS float*)(F.lds + LR_TOKW + a * 4);
    }
    if (F.vcu < 32) { const int e = F.vcu; const unsigned cn = F.MISC[MW_CNT + e], rs = F.MISC[MW_RS + e], end = ((cn + 255u) >> 8) << 8;
        for (unsigned r = cn + F.tid; r < end; r += 512) { row_tok[rs + r] = 0; row_asg[rs + r] = -1; row_w[rs + r] = 0.f; } }
}

__device__ __forceinline__ void ph_final(Frame& F) {
    const int gw = F.vcu * NWAVES + F.wave, NGW = F.G * NWAVES, lane = F.lane;
    const bf16_t* x1b = (const bf16_t*)(F.ws + WS_Y); const bf16_t* mo = (const bf16_t*)(F.ws + WS_X1); const bf16_t* ple = (const bf16_t*)(F.ws + WS_PLE);
    f32x4 gv[4], bv[4];
#pragma unroll
    for (int j = 0; j < 4; ++j) { gv[j] = *(const f32x4*)(F.in[I_LN2G] + 4 * lane + 256 * j); bv[j] = *(const f32x4*)(F.in[I_LN2B] + 4 * lane + 256 * j); }
    for (int row = gw; row < NTOK; row += NGW) {
        const bf16_t* m0 = mo + (size_t)(2 * row) * DM;
        f32x4 v[4]; float s = 0.f;
#pragma unroll
        for (int j = 0; j < 4; ++j) { const int cix = 4 * lane + 256 * j;
            const u32x2 pw = __builtin_nontemporal_load((const u32x2*)(ple + (size_t)row * DM + cix));
            const u32x2 a = __builtin_nontemporal_load((const u32x2*)(m0 + cix)), b = __builtin_nontemporal_load((const u32x2*)(m0 + DM + cix));
            f32x4 mv; mv[0] = bf_lo(a.x) + bf_lo(b.x); mv[1] = bf_hi(a.x) + bf_hi(b.x); mv[2] = bf_lo(a.y) + bf_lo(b.y); mv[3] = bf_hi(a.y) + bf_hi(b.y);
            const f32x4 pv = (f32x4){bf_lo(pw.x), bf_hi(pw.x), bf_lo(pw.y), bf_hi(pw.y)};
            v[j] = mv + pv; s += (v[j][0] + v[j][1]) + (v[j][2] + v[j][3]); }
        const float mean = wave_sum_u(s) * (1.0f / DM); float s2 = 0.f;
#pragma unroll
        for (int j = 0; j < 4; ++j) { v[j] = v[j] - mean; s2 += (v[j][0] * v[j][0] + v[j][1] * v[j][1]) + (v[j][2] * v[j][2] + v[j][3] * v[j][3]); }
        const float rstd = rsqrtf(wave_sum_u(s2) * (1.0f / DM) + LN_EPS);
#pragma unroll
        for (int j = 0; j < 4; ++j) __builtin_nontemporal_store(v[j] * rstd * gv[j] + bv[j], (f32x4*)(F.out + (size_t)row * DM + 4 * lane + 256 * j));
    }
}

constexpr int NPHASE = 10;
struct Args { const float* in[33]; float* out; unsigned char* ws; int ph_lo, ph_hi; };
#ifndef PH_MASK
#define PH_MASK 0x3ff
#endif
__global__ void __launch_bounds__(NWAVES * 64, 2) hymba_fwd(const Args args) {
    extern __shared__ __attribute__((aligned(16))) unsigned char lds[];
    Frame F;
    F.lds = (LAS unsigned char*)lds;
    F.MISC = (volatile LAS unsigned*)(F.lds + MISC_OFF);
    F.tid = threadIdx.x; F.lane = F.tid & 63; F.wave = __builtin_amdgcn_readfirstlane(F.tid >> 6);
    F.G = gridDim.x; { const int bx = blockIdx.x; F.vcu = (F.G % 8 == 0) ? (bx % 8) * (F.G / 8) + bx / 8 : bx; }
    F.ws = args.ws; F.ctl = (unsigned*)(args.ws + WS_CTL); F.out = args.out;
    F.in = args.in;
    for (int u = F.tid; u < (LDS_BYTES - LDSCTL_OFF) / 4; u += NWAVES * 64) ((LAS unsigned*)(F.lds + LDSCTL_OFF))[u] = 0u;
    __syncthreads();
    const int lo = args.ph_lo, hi = args.ph_hi;
    XcdBarrier bar; bar.bar = F.ctl + CW_BAR; bar.x = 0; bar.st = nullptr;
    if (hi - lo > 1) bar = xcd_barrier_post(F.ctl + CW_BAR, F.MISC + MW_BAR);
#define IN(k) (((PH_MASK >> (k)) & 1) && lo <= (k) && (k) < hi)
#ifdef PROBE_T
#define STAMP(k) do { if (blockIdx.x == 0 && F.tid == 0) { const unsigned long long ts_ = wall_clock64(); F.ctl[CW_STAMP + 2 * (k)] = (unsigned)ts_; F.ctl[CW_STAMP + 2 * (k) + 1] = (unsigned)(ts_ >> 32); } } while (0)
#else
#define STAMP(k) do { } while (0)
#endif
#define SEAM(k) do { if (IN(k) && IN((k) + 1)) xcd_barrier(bar); STAMP((k) + 1); } while (0)
    LAS unsigned char* ring = F.lds + RING_OFF;

    STAMP(0);
    if (IN(0)) { ph_prologue(F); } SEAM(0);
    if (IN(1)) {
        pg8::Gemm g{(const bf16_t*)(F.ws + WS_XB), (const bf16_t*)(F.ws + WS_WINT), DM}; pg8::StaticOrder S; S.init(NTOK, NEXT, F.G, (int)blockIdx.x);
        EpiProj E{(bf16_t*)(F.ws + WS_P), (bf16_t*)(F.ws + WS_LORA1)};
        pg8::gemm_phase<EpiProj, pg8::StaticOrder>(ring, g, S, E);
        ph_prologue_small(F);
    } SEAM(1);
    if (IN(2)) { ph_lora_act(F); } SEAM(2);
    if (IN(3)) {
        pg8::Gemm g{(const bf16_t*)(F.ws + WS_Y), (const bf16_t*)(F.ws + WS_W2T), KL2}; pg8::LoraOrder S; S.init(NTOK, NL2, F.G, (int)blockIdx.x);
        EpiDag E{(bf16_t*)(F.ws + WS_LW), (bf16_t*)(F.ws + WS_AG), F.in[I_W0], F.in[I_A0]};
        pg8::gemm_phase<EpiDag, pg8::LoraOrder>(ring, g, S, E);
    } SEAM(3);
    if (IN(4)) { ph_scan_pipe3(F); ph_attn_mfma2(F); } SEAM(4);
    if (IN(5)) {
        pg8::Gemm g{(const bf16_t*)(F.ws + WS_Y), (const bf16_t*)(F.ws + WS_WOT), DM}; pg8::StaticOrder S; S.init(NTOK, DM, F.G, (int)blockIdx.x);
        EpiWo E{(bf16_t*)(F.ws + WS_HDN)};
        pg8::gemm_phase<EpiWo, pg8::StaticOrder>(ring, g, S, E);
    } SEAM(5);
    if (IN(6)) { ph_ln1_router_mfma(F); } SEAM(6);
    if (IN(7)) { ph_positions(F); } SEAM(7);
    if (IN(8)) {
        {
            pg8::MoeOrder<true> S{(const int*)(F.ctl + CW_TILEE), (const int*)(F.ws + WS_ROWTOK), (int)__hip_atomic_load(F.ctl + CW_NTILES, RLX_AGENT), F.G, F.vcu};
            pg8::Gemm g{(const bf16_t*)(F.ws + WS_Y), (const bf16_t*)(F.ws + WS_WGUT), DM};
            EpiGU E{(bf16_t*)(F.ws + WS_HDN)};
            pg8::gemm_phase<EpiGU, pg8::MoeOrder<true>>(ring, g, S, E);
        }
        if (F.tid == 0) {
            __builtin_amdgcn_fence(__ATOMIC_RELEASE, "agent");
            asm volatile("s_waitcnt vmcnt(0)" ::: "memory");
            (void)__hip_atomic_fetch_add(F.ctl + CW_GUDONE, 1u, RLX_AGENT);
        }
        {
            pg8::Gemm g{(const bf16_t*)(F.ws + WS_PB), (const bf16_t*)(F.ws + WS_PT), 256}; pg8::StaticOrder S; S.init(NTOK, DM, F.G, (int)blockIdx.x);
            EpiBf E{(bf16_t*)(F.ws + WS_PLE), DM};
            pg8::gemm_phase<EpiBf, pg8::StaticOrder>(ring, g, S, E);
        }
        {
            pg8::Gemm g{(const bf16_t*)(F.ws + WS_Y), (const bf16_t*)(F.ws + WS_GT), DM}; pg8::StaticOrder S; S.init(NTOK, DM, F.G, (int)blockIdx.x);
            EpiPle E{(bf16_t*)(F.ws + WS_PLE), DM, (const bf16_t*)(F.ws + WS_Y)};
            pg8::gemm_phase<EpiPle, pg8::StaticOrder>(ring, g, S, E);
        }
        if (F.tid == 0) {
            unsigned* barw = F.ctl + CW_BAR;
            XB_SPIN(__hip_atomic_load(F.ctl + CW_GUDONE, RLX_AGENT) < (unsigned)F.G, barw);
            __builtin_amdgcn_fence(__ATOMIC_ACQUIRE, "agent");
            asm volatile("s_waitcnt vmcnt(0)" ::: "memory");
        }
        __syncthreads();
        {
            pg8::MoeDownOrder S{(const int*)(F.ctl + CW_TILEE), (int)__hip_atomic_load(F.ctl + CW_NTILES, RLX_AGENT), F.G, F.vcu};
            pg8::Gemm g{(const bf16_t*)(F.ws + WS_HDN), (const bf16_t*)(F.ws + WS_WDT), DEXP};
            EpiDown E{(bf16_t*)(F.ws + WS_X1), (bf16_t*)(F.ws + WS_X1), (const int*)(F.ws + WS_ROWASG), (const float*)(F.ws + WS_ROWW)};
            pg8::gemm_phase<EpiDown, pg8::MoeDownOrder>(ring, g, S, E);
        }
    } SEAM(8);
    if (IN(9)) { ph_final(F); }
#undef IN
#undef SEAM
}

extern "C" void kernel_launch(void* const* d_in, const int* in_sizes, int n_in, void* d_out, int out_size, void* d_ws, size_t ws_size, hipStream_t stream) {
    static int grid = 0;
    if (grid == 0) {
        if (n_in != 33 || in_sizes[0] != NTOK * DM || out_size != NTOK * DM || ws_size < WS_END) { fprintf(stderr, "kernel_launch: unexpected problem (n_in %d, in0 %d, out %d, ws %zu)\n", n_in, n_in > 0 ? in_sizes[0] : -1, out_size, ws_size); grid = -1; return; }
        int dev = 0, cus = 0;
        if (hipGetDevice(&dev) != hipSuccess || hipDeviceGetAttribute(&cus, hipDeviceAttributeMultiprocessorCount, dev) != hipSuccess) { grid = -1; return; }
        if (hipFuncSetAttribute((const void*)hymba_fwd, hipFuncAttributeMaxDynamicSharedMemorySize, LDS_BYTES) != hipSuccess) { fprintf(stderr, "kernel_launch: hipFuncSetAttribute failed\n"); grid = -1; return; }
        int per_cu = 0;
        if (hipOccupancyMaxActiveBlocksPerMultiprocessor(&per_cu, (const void*)hymba_fwd, NWAVES * 64, LDS_BYTES) != hipSuccess || per_cu < 1) fprintf(stderr, "kernel_launch: occupancy query reports %d\n", per_cu);
        (void)hipGetLastError();
        grid = cus;
    }
    if (grid < 0) return;
    if (hipMemsetAsync((char*)d_ws + WS_CTL, 0, CTL_ZERO_BYTES, stream) != hipSuccess) return;
    Args a{};
    for (int i = 0; i < 33; ++i) a.in[i] = (const float*)d_in[i];
    a.out = (float*)d_out; a.ws = (unsigned char*)d_ws;
#if MK_ONE_LAUNCH
    a.ph_lo = 0; a.ph_hi = NPHASE;
    hipLaunchKernelGGL(hymba_fwd, dim3(grid), dim3(NWAVES * 64), LDS_BYTES, stream, a);
#else
    for (int ph = 0; ph < NPHASE; ++ph) { a.ph_lo = ph; a.ph_hi = ph + 1; hipLaunchKernelGGL(hymba_fwd, dim3(grid), dim3(NWAVES * 64), LDS_BYTES, stream, a); }
#endif
}
```

```cpp
#include <hip/hip_runtime.h>
#include <cstdio>
#include <cstdint>

#ifndef MK_ONE_LAUNCH
#define MK_ONE_LAUNCH 1
#endif

#define GAS __attribute__((address_space(1)))
#define LAS __attribute__((address_space(3)))
typedef unsigned short bf16_t;
typedef short bf16x8 __attribute__((ext_vector_type(8)));
typedef float f32x4 __attribute__((ext_vector_type(4)));
typedef float f32x2 __attribute__((ext_vector_type(2)));
typedef unsigned u32x4 __attribute__((ext_vector_type(4)));
typedef unsigned u32x2 __attribute__((ext_vector_type(2)));
#define RLX_AGENT __ATOMIC_RELAXED, __HIP_MEMORY_SCOPE_AGENT
#define LDS_WAIT() asm volatile("s_waitcnt lgkmcnt(0)" ::: "memory")
#define VM_WAIT() asm volatile("s_waitcnt vmcnt(0)" ::: "memory")

__device__ __forceinline__ unsigned f2bf(float f) { unsigned u = __builtin_bit_cast(unsigned, f); return (u + 0x7fffu + ((u >> 16) & 1u)) >> 16; }
typedef __bf16 bf16v2_t __attribute__((ext_vector_type(2)));
__device__ __forceinline__ unsigned cvt2(float lo, float hi) { bf16v2_t v; v.x = (__bf16)lo; v.y = (__bf16)hi; return __builtin_bit_cast(unsigned, v); }
__device__ __forceinline__ unsigned pk2(float lo, float hi) { return cvt2(lo, hi); }
__device__ __forceinline__ float bf_lo(unsigned w) { return __builtin_bit_cast(float, w << 16); }
__device__ __forceinline__ float bf_hi(unsigned w) { return __builtin_bit_cast(float, w & 0xffff0000u); }
__device__ __forceinline__ float bf2f(bf16_t b) { return __builtin_bit_cast(float, ((unsigned)b) << 16); }
__device__ __forceinline__ float sigmoidf_(float z) { return __builtin_amdgcn_rcpf(1.0f + __builtin_amdgcn_exp2f(-1.4426950408889634f * z)); }
__device__ __forceinline__ float wave_sum(float v) {
#pragma unroll
    for (int o = 1; o < 64; o <<= 1) v += __shfl_xor(v, o);
    return v;
}

namespace pg8 {
constexpr int BM = 256, BK = 64, HALF = 128, HTB = HALF * BK * 2, STAGE_BYTES = 8 * HTB, NXCD = 8, WGM = 8;
__host__ __device__ __forceinline__ int lds_byte(int r, int c) { const int st = (r >> 4) * 2 + (c >> 5), rr = r & 15, cc = c & 31, ob = rr * 64 + cc * 2; return st * 1024 + (ob ^ (((ob >> 9) & 1) << 5)); }
__host__ __device__ __forceinline__ void stage_rc(int b, int& R, int& C) { const int st = b / 1024, sb = b % 1024, swz = sb ^ (((sb >> 9) & 1) << 5); R = (st >> 1) * 16 + swz / 64; C = (st & 1) * 32 + (swz % 64) / 2; }
__host__ __device__ __forceinline__ int perm32(int rho) { const int n = rho >> 4, i = rho & 15; return 8 * (i >> 2) + 4 * n + (i & 3); }

struct Unit { int pm, pn, pb; };
struct Gemm { const bf16_t* A; const bf16_t* Bt; int K; };

struct StaticOrder {
    static constexpr bool GATHER = false;
    int nM, nN, nwg, G, c;
    __device__ void init(int M, int N, int G_, int c_) { nM = M / BM; nN = N / BM; nwg = nM * nN; G = G_; c = c_; }
    __device__ bool next(int i, Unit& u) const {
        const long L = (long)i * G + c; if (L >= nwg) return false;
        int wgid = (int)L; { const int q = nwg / NXCD, r = nwg % NXCD, xcd = wgid % NXCD, off = wgid / NXCD; wgid = (xcd < r ? xcd * (q + 1) : r * (q + 1) + (xcd - r) * q) + off; }
        const int nig = WGM * nN, gid = wgid / nig, fm = gid * WGM, gsz = (nM - fm) < WGM ? (nM - fm) : WGM;
        u.pm = fm + ((wgid % nig) % gsz); u.pn = (wgid % nig) / gsz; u.pb = u.pn; return true;
    }
    __device__ __forceinline__ unsigned a_row_off(const Unit&, int, unsigned) const { return 0u; }
    __device__ __forceinline__ int koff(const Unit&) const { return 0; }
    __device__ __forceinline__ int ntk(const Unit&, int nt_full) const { return nt_full; }
};
struct LoraOrder : StaticOrder {
    __device__ __forceinline__ int koff(const Unit& u) const { return u.pn >= 4 ? 128 : 0; }
    __device__ __forceinline__ int ntk(const Unit& u, int) const { return 2 + ((u.pn >> 6) << 1); }
};
template <bool GATHER_> struct MoeOrder {
    static constexpr bool GATHER = GATHER_;
    const LAS unsigned char* tile_e; const LAS unsigned* rs; const LAS unsigned* cnt; const int* la; int ntiles, G, c;
    __device__ bool next(int i, Unit& u) const {
        const long L = (long)i * G + c; if (L >= (long)ntiles * 4) return false;
        const int tile = (int)(L >> 2), pn = (int)(L & 3);
        u.pm = tile; u.pn = pn; u.pb = (int)tile_e[tile] * 4 + pn; return true;
    }
    __device__ __forceinline__ unsigned a_row_off(const Unit& u, int r, unsigned rowbytes) const {
        const unsigned e = tile_e[u.pm]; const unsigned j = (unsigned)(u.pm * 256 + r) - rs[e];
        const unsigned tok = (j < cnt[e]) ? ((unsigned)la[e * 65536u + j] >> 1) : 0u;
        return tok * rowbytes; }
    __device__ __forceinline__ int koff(const Unit&) const { return 0; }
    __device__ __forceinline__ int ntk(const Unit&, int nt_full) const { return nt_full; }
};

struct MoeDownOrder {
    static constexpr bool GATHER = false;
    const LAS unsigned char* tile_e; int ntiles, G, vcu;
    __device__ bool next(int i, Unit& u) const {
        const int NU = ntiles * 4, rem = NU % G, nB = G - rem; long d;
        if (vcu >= rem) { const int ib = vcu - rem; d = (i < 2) ? (long)i * nB + ib : 2L * nB + (long)(i - 2) * G + ib; }
        else d = 2L * nB + (long)i * G + nB + vcu;
        if (d >= NU) return false;
        const int tile = (int)(d >> 2), pn = (int)(d & 3);
        u.pm = tile; u.pn = pn; u.pb = (int)tile_e[tile] * 4 + pn; return true;
    }
    __device__ __forceinline__ unsigned a_row_off(const Unit&, int, unsigned) const { return 0u; }
    __device__ __forceinline__ int koff(const Unit&) const { return 0; }
    __device__ __forceinline__ int ntk(const Unit&, int nt_full) const { return nt_full; }
};

__device__ __forceinline__ unsigned cvt_pk_bf16(float lo, float hi) { unsigned r; asm volatile("v_cvt_pk_bf16_f32 %0, %1, %2" : "=v"(r) : "v"(lo), "v"(hi)); return r; }

template <class Epi, class Sched>
__device__ __forceinline__ void gemm_phase(LAS unsigned char* lds, const Gemm g, const Sched& S, const Epi& E) {
    const int tid = threadIdx.x, wid = __builtin_amdgcn_readfirstlane(tid >> 6), lane = tid & 63, wr = wid >> 2, wc = wid & 3, fr = lane & 15, fq = lane >> 4;
    const int K = g.K, nt_full = K / BK;
    int Rr[2], Cc[2];
    unsigned voffB[2];
#pragma unroll
    for (int i = 0; i < 2; ++i) { int R, C; stage_rc(tid * 16 + i * 8192, R, C); const int Rb = Epi::PERM ? ((R & ~31) + perm32(R & 31)) : R;
        Rr[i] = R; Cc[i] = C; voffB[i] = (unsigned)(Rb * K + C) * 2u; }
    const unsigned rowbytes = (unsigned)K * 2u;
    const size_t kstep = (size_t)(BK * 2);
    const size_t hstep = (size_t)HALF * K * 2;
    const size_t tstep = 2 * hstep;
    const unsigned ldsw = (unsigned)wid * 1024u;
    const int aoff = lds_byte(wr * 64 + fr, fq * 8), boff = lds_byte(wc * 32 + fr, fq * 8);
#define PG8_SA(b, h) (((b) * 2 + (h)) * HTB)
#define PG8_SB(b, h) ((4 + (b) * 2 + (h)) * HTB)
#define PG8_STAGE(bufoff, gbase, voff) do { _Pragma("unroll") for (int _i = 0; _i < 2; ++_i) \
        __builtin_amdgcn_global_load_lds((const unsigned*)((const char*)(gbase) + (voff)[_i]), (LAS unsigned*)(lds + (bufoff) + ldsw + _i * 8192), 16, 0, 0); } while (0)
#define PG8_STAGE_A(bufoff, gbase, vv, h) do { _Pragma("unroll") for (int _i = 0; _i < 2; ++_i) \
        __builtin_amdgcn_global_load_lds((const unsigned*)((const char*)(gbase) + (vv)[h][_i]), (LAS unsigned*)(lds + (bufoff) + ldsw + _i * 8192), 16, 0, 0); } while (0)
#define PG8_LDA(dst, b, h) do { _Pragma("unroll") for (int m = 0; m < 4; ++m) _Pragma("unroll") for (int k = 0; k < 2; ++k) dst[m][k] = *(const LAS bf16x8*)(lds + PG8_SA(b, h) + aoff + m * 2048 + k * 1024); } while (0)
#define PG8_LDB(dst, b, h) do { _Pragma("unroll") for (int n = 0; n < 2; ++n) _Pragma("unroll") for (int k = 0; k < 2; ++k) dst[n][k] = *(const LAS bf16x8*)(lds + PG8_SB(b, h) + boff + n * 2048 + k * 1024); } while (0)
#define PG8_MMA(ai, bj, At, Bt) do { __builtin_amdgcn_s_setprio(1); _Pragma("unroll") for (int m = 0; m < 4; ++m) _Pragma("unroll") for (int n = 0; n < 2; ++n) _Pragma("unroll") for (int k = 0; k < 2; ++k) \
        acc[ai][bj][m][n] = __builtin_amdgcn_mfma_f32_16x16x32_bf16(Bt[n][k], At[m][k], acc[ai][bj][m][n], 0, 0, 0); __builtin_amdgcn_s_setprio(0); } while (0)
#define PG8_WAIT_V(n) asm volatile("s_waitcnt vmcnt(" #n ")" ::: "memory")
#define PG8_WAIT_L(n) asm volatile("s_waitcnt lgkmcnt(" #n ")" ::: "memory")
#define PG8_BAR __builtin_amdgcn_s_barrier()
#define PG8_SCHED __builtin_amdgcn_sched_barrier(0)
#define PG8_SETOFF(vv, uu) do { _Pragma("unroll") for (int _h = 0; _h < 2; ++_h) _Pragma("unroll") for (int _i = 0; _i < 2; ++_i) { \
        if constexpr (Sched::GATHER) (vv)[_h][_i] = S.a_row_off((uu), _h * HALF + Rr[_i], rowbytes) + (unsigned)Cc[_i] * 2u; \
        else (vv)[_h][_i] = (unsigned)((_h * HALF + Rr[_i]) * K + Cc[_i]) * 2u; } } while (0)
    Unit cur, nxt; int ui = 0;
    if (!S.next(0, cur)) return;
    f32x4 acc[2][2][4][2];
#pragma unroll
    for (int a = 0; a < 2; ++a)
#pragma unroll
        for (int b = 0; b < 2; ++b)
#pragma unroll
            for (int m = 0; m < 4; ++m)
#pragma unroll
                for (int n = 0; n < 2; ++n) acc[a][b][m][n] = (f32x4){0.f, 0.f, 0.f, 0.f};
    bf16x8 At[4][2], B0[2][2], B1[2][2];
    unsigned vAc[2][2], vAn[2][2];
    PG8_SETOFF(vAc, cur);
    const char* cA = (Sched::GATHER ? (const char*)g.A : (const char*)g.A + (size_t)cur.pm * tstep) + (size_t)S.koff(cur) * 2;
    const char* cB = (const char*)g.Bt + (size_t)cur.pb * tstep + (size_t)S.koff(cur) * 2;
    int nt = S.ntk(cur, nt_full);
    PG8_STAGE(PG8_SB(0, 0), cB, voffB); PG8_STAGE(PG8_SB(0, 1), cB + hstep, voffB); PG8_STAGE_A(PG8_SA(0, 0), cA, vAc, 0); PG8_STAGE_A(PG8_SA(0, 1), cA, vAc, 1);
    if (wr == 1) PG8_BAR;
    PG8_WAIT_V(2); PG8_BAR;
    PG8_STAGE(PG8_SB(1, 0), cB + kstep, voffB); PG8_STAGE_A(PG8_SA(1, 0), cA + kstep, vAc, 0); PG8_STAGE(PG8_SB(1, 1), cB + hstep + kstep, voffB);
    PG8_WAIT_V(6); PG8_BAR;
    for (;;) {
        const bool has_next = S.next(ui + 1, nxt);
        const char* nA = cA; const char* nB = cB;
        if (has_next) { nA = (Sched::GATHER ? (const char*)g.A : (const char*)g.A + (size_t)nxt.pm * tstep) + (size_t)S.koff(nxt) * 2; nB = (const char*)g.Bt + (size_t)nxt.pb * tstep + (size_t)S.koff(nxt) * 2; }
        if constexpr (Sched::GATHER) {
            if (has_next) { PG8_SETOFF(vAn, nxt); }
            else {
#pragma unroll
                for (int h = 0; h < 2; ++h)
#pragma unroll
                    for (int i = 0; i < 2; ++i) vAn[h][i] = vAc[h][i];
            }
        }
#pragma unroll 1
        for (int t = 0; t < nt; t += 2) {
            const bool last = (t == nt - 2);
            const char* a1 = cA + (size_t)(t + 1) * kstep;
            const char* a2 = last ? nA : cA + (size_t)(t + 2) * kstep; const char* b2 = last ? nB : cB + (size_t)(t + 2) * kstep;
            const char* a3 = a2 + kstep; const char* b3 = b2 + kstep;
            unsigned vs[2][2];
#pragma unroll
            for (int h = 0; h < 2; ++h)
#pragma unroll
                for (int i = 0; i < 2; ++i) { if constexpr (Sched::GATHER) vs[h][i] = last ? vAn[h][i] : vAc[h][i]; else vs[h][i] = vAc[h][i]; }
            PG8_LDB(B0, 0, 0); PG8_LDB(B1, 0, 1); PG8_SCHED; PG8_LDA(At, 0, 0); PG8_STAGE_A(PG8_SA(1, 1), a1, vAc, 1);
            PG8_WAIT_V(8); PG8_WAIT_L(0); PG8_BAR; PG8_MMA(0, 0, At, B0); PG8_MMA(0, 1, At, B1); PG8_BAR; PG8_SCHED;
            PG8_LDA(At, 0, 1); PG8_STAGE(PG8_SB(0, 0), b2, voffB); PG8_STAGE(PG8_SB(0, 1), b2 + hstep, voffB); PG8_STAGE_A(PG8_SA(0, 0), a2, vs, 0);
            PG8_WAIT_V(8); PG8_WAIT_L(0); PG8_BAR; PG8_MMA(1, 0, At, B0); PG8_MMA(1, 1, At, B1); PG8_BAR; PG8_SCHED;
            PG8_LDB(B0, 1, 0); PG8_LDB(B1, 1, 1); PG8_SCHED; PG8_LDA(At, 1, 0); PG8_STAGE_A(PG8_SA(0, 1), a2, vs, 1);
            PG8_WAIT_V(8); PG8_WAIT_L(0); PG8_BAR; PG8_MMA(0, 0, At, B0); PG8_MMA(0, 1, At, B1); PG8_BAR; PG8_SCHED;
            PG8_LDA(At, 1, 1); PG8_STAGE(PG8_SB(1, 0), b3, voffB); PG8_STAGE(PG8_SB(1, 1), b3 + hstep, voffB); PG8_STAGE_A(PG8_SA(1, 0), a3, vs, 0);
            PG8_WAIT_V(8); PG8_WAIT_L(0); PG8_BAR; PG8_MMA(1, 0, At, B0); PG8_MMA(1, 1, At, B1); PG8_BAR; PG8_SCHED;
        }
        if (wr == 0) PG8_BAR;
        E(acc, cur, wr, wc, fr, fq);
        if (!has_next) break;
#pragma unroll
        for (int a = 0; a < 2; ++a)
#pragma unroll
            for (int b = 0; b < 2; ++b)
#pragma unroll
                for (int m = 0; m < 4; ++m)
#pragma unroll
                    for (int n = 0; n < 2; ++n) acc[a][b][m][n] = (f32x4){0.f, 0.f, 0.f, 0.f};
        cur = nxt; cA = nA; cB = nB; ++ui; nt = S.ntk(cur, nt_full);
        if constexpr (Sched::GATHER) {
#pragma unroll
            for (int h = 0; h < 2; ++h)
#pragma unroll
                for (int i = 0; i < 2; ++i) vAc[h][i] = vAn[h][i];
        }
        if (wr == 1) PG8_BAR;
    }
    PG8_WAIT_V(0);
    PG8_BAR;
#undef PG8_SA
#undef PG8_SB
#undef PG8_STAGE
#undef PG8_STAGE_A
#undef PG8_LDA
#undef PG8_LDB
#undef PG8_MMA
#undef PG8_WAIT_V
#undef PG8_WAIT_L
#undef PG8_BAR
#undef PG8_SCHED
#undef PG8_SETOFF
}
}

#define XB_TMO      128
#define XB_XCNT(j)  (256  + 64 * (j))
#define XB_XSUB(j)  (1280 + 64 * (j))
#define XB_XGEN(j)  (2304 + 64 * (j))
#define XB_TOP      3328
#define XB_TOPGEN   3392
#define XCD_BAR_WORDS 3456
#define XB_SPIN_CAP (1u << 18)
__device__ __forceinline__ unsigned xb_ld(unsigned* p)              { return __hip_atomic_load(p, __ATOMIC_RELAXED, __HIP_MEMORY_SCOPE_AGENT); }
__device__ __forceinline__ unsigned xb_add(unsigned* p, unsigned v) { return __hip_atomic_fetch_add(p, v, __ATOMIC_RELAXED, __HIP_MEMORY_SCOPE_AGENT); }
__device__ __forceinline__ unsigned xb_xcc_id() { return (unsigned)__builtin_amdgcn_s_getreg((3 << 11) | 20) & 0xFu; }
#define XB_SPIN(cond, bar) do { unsigned _sp = 0; while (cond) { __builtin_amdgcn_s_sleep(1); \
    if ((++_sp & 255u) == 0u) { if (xb_ld(&(bar)[XB_TMO])) break; if (_sp > XB_SPIN_CAP) { atomicAdd(&(bar)[XB_TMO], 1u); break; } } } } while (0)
struct XcdBarrier { unsigned* bar; unsigned x; volatile LAS unsigned* st; };
__device__ __forceinline__ XcdBarrier xcd_barrier_post(unsigned* bar, volatile LAS unsigned* st) {
    XcdBarrier b; b.bar = bar; b.x = xb_xcc_id(); b.st = st;
    if (threadIdx.x == 0) (void)xb_add(&bar[XB_XCNT(b.x)], 1u);
    return b;
}
__device__ __forceinline__ void xcd_barrier_complete(unsigned* bar, unsigned x, unsigned& nloc, unsigned& nx) {
    const unsigned G = gridDim.x * gridDim.y * gridDim.z;
    unsigned sum, cnt, mine, sp = 0u;
    for (;;) {
        sum = 0u; cnt = 0u; mine = 0u;
#pragma unroll
        for (unsigned j = 0; j < 16; ++j) { const unsigned c = xb_ld(&bar[XB_XCNT(j)]); sum += c; cnt += (c > 0u) ? 1u : 0u; mine = (j == x) ? c : mine; }
        if (sum == G) break;
        __builtin_amdgcn_s_sleep(1);
        if ((++sp & 255u) == 0u) { if (xb_ld(&bar[XB_TMO])) break; if (sp > XB_SPIN_CAP) { atomicAdd(&bar[XB_TMO], 1u); break; } }
    }
    nloc = mine > 0u ? mine : 1u; nx = cnt > 0u ? cnt : 1u;
}
__device__ __forceinline__ void xcd_barrier(const XcdBarrier& b) {
    asm volatile("s_waitcnt vmcnt(0)" ::: "memory");
    __syncthreads();
    if (threadIdx.x == 0) {
        unsigned* bar = b.bar;
        __builtin_amdgcn_s_waitcnt(0);
        unsigned nloc = b.st[0], nx = b.st[1];
        if (nloc == 0u) { xcd_barrier_complete(bar, b.x, nloc, nx); b.st[0] = nloc; b.st[1] = nx; }
        const unsigned old = xb_add(&bar[XB_XSUB(b.x)], 1u);
        const unsigned gen = old / nloc;
        if (old + 1u == (gen + 1u) * nloc) {
            __builtin_amdgcn_fence(__ATOMIC_RELEASE, "agent");
            asm volatile("s_waitcnt vmcnt(0)" ::: "memory");
            const unsigned og = xb_add(&bar[XB_TOP], 1u);
            const unsigned tg = og / nx;
            if (og + 1u == (tg + 1u) * nx) xb_add(&bar[XB_TOPGEN], 1u);
            else XB_SPIN(xb_ld(&bar[XB_TOPGEN]) == tg, bar);
            __builtin_amdgcn_fence(__ATOMIC_ACQUIRE, "agent");
            xb_add(&bar[XB_XGEN(b.x)], 1u);
            asm volatile("s_waitcnt vmcnt(0)" ::: "memory");
        } else {
            XB_SPIN(xb_ld(&bar[XB_XGEN(b.x)]) == gen, bar);
            __builtin_amdgcn_fence(__ATOMIC_ACQUIRE, "agent");
            asm volatile("s_waitcnt vmcnt(0)" ::: "memory");
        }
    }
    __syncthreads();
}

constexpr int NWAVES = 8;
constexpr int SEQ = 2048, NB = 16, DM = 1024, NTOK = NB * SEQ;
constexpr int DRW = 512, HD = 64;
constexpr int NPROJ = 3072, NEXT = 3584, NL1 = 512, KL2 = 256, NL2 = 1536;
constexpr int NEXP = 32, DEXP = 512;
constexpr int PROWS_MAX = 65536 + 32 * 256, MAXTILES = PROWS_MAX / 256;
constexpr float LN_EPS = 1e-5f, LNX_EPS = 64e-5f, ALPHA = 1.189207115002721f;

constexpr size_t MiB = 1u << 20;
constexpr size_t WS_CTL = 0, CTL_ZERO_BYTES = 65536;
constexpr size_t WS_WINT = 1 * MiB;
constexpr size_t WS_W2T = 8 * MiB;
constexpr size_t WS_WOT = 9 * MiB;
constexpr size_t WS_GT = 11 * MiB;
constexpr size_t WS_PT = 13 * MiB;
constexpr size_t WS_BIAS = 13 * MiB + 512 * 1024;
constexpr size_t WS_WRT = 13 * MiB + 640 * 1024;
constexpr size_t WS_TOKE = 14 * MiB;
constexpr size_t WS_TOKW = 14 * MiB + 256 * 1024;
constexpr size_t WS_ROWTOK = 14 * MiB + 512 * 1024;
constexpr size_t WS_ROWASG = 15 * MiB;
constexpr size_t WS_ROWW = 15 * MiB + 512 * 1024;
constexpr size_t WS_PB = 16 * MiB;
constexpr size_t WS_X1 = 32 * MiB;
constexpr size_t WS_XB = WS_X1, WS_LORA1 = WS_X1 + 64 * MiB;
constexpr size_t WS_LW = WS_X1, WS_AG = WS_X1 + 64 * MiB;
constexpr size_t WS_P = 160 * MiB;
constexpr size_t WS_HDN = WS_P;
constexpr size_t WS_LA = WS_P + 136 * MiB, WS_LWT = WS_P + 144 * MiB;
constexpr size_t WS_PLE = WS_P + 72 * MiB;
constexpr size_t WS_Y = 352 * MiB;
constexpr size_t WS_WGUT = 416 * MiB;
constexpr size_t WS_WDT = 480 * MiB;
constexpr size_t WS_END = 512 * MiB;
constexpr int BIAS_LD = 132;
constexpr int CW_BAR = 4096;
constexpr int CW_CNT = 8192, CW_FILL = 8192 + 64, CW_NTILES = 8192 + 128, CW_TILEE = 8192 + 256;

constexpr int RING_OFF = 0, RING_BYTES = 131072;
constexpr int WRT_BYTES = 36 * 1024 * 4;
constexpr int LDS_BYTES = 160 * 1024;
constexpr int LDSCTL_OFF = LDS_BYTES - 1024, MISC_OFF = LDSCTL_OFF;
constexpr int MW_HIST = 0, MW_CNT = 32, MW_RS = 64, MW_LBASE = 96, MW_LFILL = 128, MW_BAR = 160, MW_NTILES = 162, MW_TILEB = 164;
static_assert(MW_TILEB * 4 + MAXTILES <= 1024, "tile table fits the LDS control words");

struct Frame {
    LAS unsigned char* lds;
    volatile LAS unsigned* MISC;
    unsigned* ctl;
    int tid, lane, wave, vcu, G;
    unsigned char* ws;
    const float* const* in;
    float* out;
};
enum InIdx { I_X = 0, I_P, I_WIN, I_MURKV, I_MULORA, I_W0, I_WL1, I_WL2, I_A0, I_AL1, I_AL2, I_GL1, I_GL2, I_KK, I_KA, I_RK, I_LNXG, I_LNXB, I_RELB, I_WO,
             I_LN1G, I_LN1B, I_RG, I_RGB, I_RE, I_REB, I_WG, I_WU, I_WD, I_PG, I_PP, I_LN2G, I_LN2B };

__device__ __forceinline__ void tr_item(const float* W, int ldw, int k0, int n0, bf16_t* dst, int ldt, const float* mu, int smode, LAS float* scr, int lane) {
#pragma unroll 8
    for (int i = 0; i < 32; ++i) { const int kk = 2 * i + (lane >> 5); float v = W[(size_t)(k0 + kk) * ldw + n0 + (lane & 31)];
        if (smode == 1) v *= (1.0f - mu[k0 + kk]); else if (smode == 2) v *= mu[k0 + kk];
        scr[kk * 33 + (lane & 31)] = v; }
    LDS_WAIT(); asm volatile("" ::: "memory");
    const int c = lane & 7;
#pragma unroll
    for (int j = 0; j < 4; ++j) { const int n = (lane >> 3) + 8 * j; const LAS float* s = scr + (8 * c) * 33 + n;
        u32x4 o; o.x = pk2(s[0 * 33], s[1 * 33]); o.y = pk2(s[2 * 33], s[3 * 33]); o.z = pk2(s[4 * 33], s[5 * 33]); o.w = pk2(s[6 * 33], s[7 * 33]);
        *(u32x4*)(dst + (size_t)n * ldt + k0 + 8 * c) = o; }
    LDS_WAIT(); asm volatile("" ::: "memory");
}
__device__ __forceinline__ int t5_bucket(int n) {
    if (n < 16) return n;
    int b = 16;
    b += (n >= 22); b += (n >= 30); b += (n >= 40); b += (n >= 54); b += (n >= 73); b += (n >= 99); b += (n >= 134); b += (n >= 182);
    b += (n >= 246); b += (n >= 332); b += (n >= 450); b += (n >= 609); b += (n >= 825); b += (n >= 1117); b += (n >= 1513);
    return b;
}

__device__ __forceinline__ void ph_prologue_small(Frame& F) {
    const int gt = F.vcu * 512 + F.tid, NGT = F.G * 512;
    { bf16_t* w2t = (bf16_t*)(F.ws + WS_W2T);
      for (int i = gt; i < NL2 * KL2; i += NGT) { const int n = i / KL2, k = i % KL2; float v = 0.f;
          if (n < 512) { if (k < 64) v = F.in[I_WL2][k * 512 + n]; }
          else if (n < 1024) { if (k >= 64 && k < 128) v = F.in[I_AL2][(k - 64) * 512 + (n - 512)]; }
          else { if (k >= 128) v = F.in[I_GL2][(k - 128) * 512 + (n - 1024)]; }
          w2t[i] = (bf16_t)f2bf(v); } }
    { float* bt = (float*)(F.ws + WS_BIAS);
      for (int i = gt; i < 3 * 8 * BIAS_LD; i += NGT) { const int p = i / (8 * BIAS_LD), h = (i / BIAS_LD) % 8, m = i % BIAS_LD; const int dil = 1 << (2 * p);
          bt[i] = (m <= 128) ? F.in[I_RELB][t5_bucket(m * dil) * 8 + h] : 0.f; } }
    { bf16_t* wrt = (bf16_t*)(F.ws + WS_WRT);
      for (int i = gt; i < 48 * 1024; i += NGT) { const int n = i >> 10, k = i & 1023; float v = 0.f;
          if (n < 4) v = F.in[I_RG][k * 4 + n]; else if (n < 36) v = F.in[I_RE][k * 32 + (n - 4)];
          const unsigned hb = f2bf(v); const float hf = __builtin_bit_cast(float, hb << 16);
          wrt[i] = (bf16_t)hb; wrt[48 * 1024 + i] = (bf16_t)f2bf(v - hf); } }
}
__device__ __forceinline__ void ph_prologue(Frame& F) {
    const int gt = F.vcu * 512 + F.tid, NGT = F.G * 512;
    const int gw = F.vcu * NWAVES + F.wave, NGW = F.G * NWAVES;
    { const f32x4* x4 = (const f32x4*)F.in[I_X]; u32x4* o = (u32x4*)(F.ws + WS_XB);
      for (int i = gt; i < NTOK * DM / 8; i += NGT) { const f32x4 a = __builtin_nontemporal_load(x4 + 2 * i), b = __builtin_nontemporal_load(x4 + 2 * i + 1); u32x4 w;
        w.x = pk2(a.x, a.y); w.y = pk2(a.z, a.w); w.z = pk2(b.x, b.y); w.w = pk2(b.z, b.w); o[i] = w; } }
    LAS float* scr = (LAS float*)(F.lds + RING_OFF + F.wave * 16384);
    constexpr int IT_WIN = 16 * 96, IT_L1 = 256;
    constexpr int NIT = IT_WIN + IT_L1;
    bf16_t* WinT = (bf16_t*)(F.ws + WS_WINT);
    for (int it = gw; it < NIT; it += NGW) {
        int r = it;
        if (r < IT_WIN) { const int kb = r / 96, nb = r % 96; tr_item(F.in[I_WIN], NPROJ, kb * 64, nb * 32, WinT + (size_t)(nb * 32) * DM, DM, nullptr, 0, scr, F.lane); continue; } r -= IT_WIN;
        if (r < IT_L1) {
            int piece, sub;
            if (r < 128) { piece = r / 32; sub = r % 32; } else { piece = 4 + (r - 128) / 64; sub = (r - 128) % 64; }
            const int which = piece >> 1, isprev = piece & 1;
            const int ncols = (which == 2) ? 128 : 64, nblk = ncols / 32;
            const int kb = sub / nblk, nb = sub % nblk;
            const float* src = (which == 0) ? F.in[I_WL1] : (which == 1) ? F.in[I_AL1] : F.in[I_GL1];
            const int rowbase = (which == 0) ? 3072 + 64 * isprev : (which == 1) ? 3200 + 64 * isprev : 3328 + 128 * isprev;
            tr_item(src, ncols, kb * 64, nb * 32, WinT + (size_t)(rowbase + nb * 32) * DM, DM, F.in[I_MULORA] + which * DM, isprev ? 2 : 1, scr, F.lane); }
    }
}
constexpr int LATE_TILE_UNITS = (512 + 512 + 128) / NWAVES;
struct PRegs { f32x4 a[2], b[2]; };
__device__ __forceinline__ void late_p_loads(Frame& F, int unit, PRegs& P) {
    const f32x4* x4 = (const f32x4*)F.in[I_P];
    int tid_ = F.tid; asm volatile("" : "+v"(tid_));
#pragma unroll
    for (int q = 0; q < 2; ++q) { const int i = unit * 1024 + q * 512 + tid_; P.a[q] = __builtin_nontemporal_load(x4 + 2 * i); P.b[q] = __builtin_nontemporal_load(x4 + 2 * i + 1); }
}
__device__ __forceinline__ void late_p_stores(Frame& F, int unit, const PRegs& P) {
    u32x4* o = (u32x4*)(F.ws + WS_PB);
    int tid_ = F.tid; asm volatile("" : "+v"(tid_));
#pragma unroll
    for (int q = 0; q < 2; ++q) { const int i = unit * 1024 + q * 512 + tid_; u32x4 w; w.x = pk2(P.a[q].x, P.a[q].y); w.y = pk2(P.a[q].z, P.a[q].w); w.z = pk2(P.b[q].x, P.b[q].y); w.w = pk2(P.b[q].z, P.b[q].w); o[i] = w; }
}
__device__ __forceinline__ void late_prologue_items(Frame& F, int unit, LAS float* scr) {
    if (unit < LATE_TILE_UNITS) { int r = unit * NWAVES + F.wave; int lane_ = F.lane; asm volatile("" : "+v"(lane_));
        if (r < 512) { const int kb = r / 32, nb = r % 32; tr_item(F.in[I_WO], DM, kb * 64, nb * 32, (bf16_t*)(F.ws + WS_WOT) + (size_t)(nb * 32) * DM, DM, nullptr, 0, scr, lane_); }
        else if (r < 1024) { r -= 512; const int kb = r / 32, nb = r % 32; tr_item(F.in[I_PG], DM, kb * 64, nb * 32, (bf16_t*)(F.ws + WS_GT) + (size_t)(nb * 32) * DM, DM, nullptr, 0, scr, lane_); }
        else { r -= 1024; const int kb = r / 32, nb = r % 32; tr_item(F.in[I_PP], DM, kb * 64, nb * 32, (bf16_t*)(F.ws + WS_PT) + (size_t)(nb * 32) * 256, 256, nullptr, 0, scr, lane_); } }
}
constexpr int MOE_IT_GU = 64 * 256, MOE_IT_D = 32 * 256, MOE_ROUNDS_PER_UNIT = 3;
static_assert((MOE_IT_GU + MOE_IT_D) == NB * 8 * 8 * MOE_ROUNDS_PER_UNIT * NWAVES, "conversion items tile the attention queue exactly");
struct MoeItem { const float* src; bf16_t* dst; int ldw, ldt, k0; };
__device__ __forceinline__ MoeItem moe_item(const Frame& F, int it) {
    MoeItem m;
    if (it < MOE_IT_GU) { const int mat = it / 256, sub = it % 256, e = mat >> 1, up = mat & 1, kb = sub / 16, nb = sub % 16, n0 = nb * 32;
        m.src = (up ? F.in[I_WU] : F.in[I_WG]) + (size_t)e * DM * DEXP + (size_t)(kb * 64) * DEXP + n0; m.ldw = DEXP;
        m.dst = (bf16_t*)(F.ws + WS_WGUT) + ((size_t)e * 1024 + (n0 >> 7) * 256 + up * 128 + (n0 & 127)) * DM; m.ldt = DM; m.k0 = kb * 64; }
    else { const int r = it - MOE_IT_GU, e = r / 256, sub = r % 256, kb = sub / 32, nb = sub % 32;
        m.src = F.in[I_WD] + (size_t)e * DEXP * DM + (size_t)(kb * 64) * DM + nb * 32; m.ldw = DM;
        m.dst = (bf16_t*)(F.ws + WS_WDT) + ((size_t)e * 1024 + nb * 32) * DEXP; m.ldt = DEXP; m.k0 = kb * 64; }
    return m;
}
__device__ __forceinline__ void moe_weight_items3(Frame& F, int it0, LAS float* scr) {
    const int lane = F.lane;
    float v[MOE_ROUNDS_PER_UNIT][32]; MoeItem m[MOE_ROUNDS_PER_UNIT];
#pragma unroll
    for (int j = 0; j < MOE_ROUNDS_PER_UNIT; ++j) { m[j] = moe_item(F, it0 + j * NWAVES);
        const float* p = m[j].src + (size_t)(lane >> 5) * m[j].ldw + (lane & 31);
#pragma unroll
        for (int i = 0; i < 32; ++i) v[j][i] = __builtin_nontemporal_load(p + (size_t)(2 * i) * m[j].ldw); }
#pragma unroll
    for (int j = 0; j < MOE_ROUNDS_PER_UNIT; ++j) {
#pragma unroll
        for (int i = 0; i < 32; ++i) scr[(2 * i + (lane >> 5)) * 33 + (lane & 31)] = v[j][i];
        LDS_WAIT(); asm volatile("" ::: "memory");
        const int c = lane & 7;
#pragma unroll
        for (int q = 0; q < 4; ++q) { const int n = (lane >> 3) + 8 * q; const LAS float* sp = scr + (8 * c) * 33 + n;
            u32x4 o; o.x = pk2(sp[0 * 33], sp[1 * 33]); o.y = pk2(sp[2 * 33], sp[3 * 33]); o.z = pk2(sp[4 * 33], sp[5 * 33]); o.w = pk2(sp[6 * 33], sp[7 * 33]);
            *(u32x4*)(m[j].dst + (size_t)n * m[j].ldt + m[j].k0 + 8 * c) = o; }
        LDS_WAIT(); asm volatile("" ::: "memory");
    }
}

using pg8::Unit; using pg8::cvt_pk_bf16;
struct EpiProj {
    static constexpr bool PERM = true;
    bf16_t* proj; bf16_t* lora1;
    __device__ __forceinline__ void operator()(const f32x4 (&acc)[2][2][4][2], const Unit& u, int wr, int wc, int fr, int fq) const {
        const int row0 = u.pm * 256 + wr * 64 + fr;
        const bool isl = (u.pn >= 12);
        bf16_t* base = isl ? lora1 : proj; const int ld = isl ? NL1 : NPROJ;
        const int col0 = (isl ? (u.pn - 12) : u.pn) * 256 + wc * 32 + 8 * fq;
#pragma unroll
        for (int ai = 0; ai < 2; ++ai)
#pragma unroll
            for (int m = 0; m < 4; ++m) { bf16_t* rowp = base + (size_t)(row0 + ai * 128 + m * 16) * ld + col0;
#pragma unroll
                for (int bj = 0; bj < 2; ++bj) { const f32x4 v0 = acc[ai][bj][m][0], v1 = acc[ai][bj][m][1]; u32x4 w;
                    w.x = cvt2(v0[0], v0[1]); w.y = cvt2(v0[2], v0[3]); w.z = cvt2(v1[0], v1[1]); w.w = cvt2(v1[2], v1[3]);
                    *(u32x4*)(rowp + bj * 128) = w; } }
    }
};
struct EpiDag {
    static constexpr bool PERM = true;
    bf16_t* lw; bf16_t* ag; const float* w0; const float* a0;
    __device__ __forceinline__ void operator()(const f32x4 (&acc)[2][2][4][2], const Unit& u, int wr, int wc, int fr, int fq) const {
        const int row0 = u.pm * 256 + wr * 64 + fr;
        const int colt = u.pn * 256 + wc * 32 + 8 * fq;
        if (u.pn < 2) {
#pragma unroll
            for (int bj = 0; bj < 2; ++bj) {
                const f32x4 b0 = *(const f32x4*)(w0 + colt + bj * 128), b1 = *(const f32x4*)(w0 + colt + bj * 128 + 4);
#pragma unroll
                for (int ai = 0; ai < 2; ++ai)
#pragma unroll
                    for (int m = 0; m < 4; ++m) { bf16_t* rowp = lw + (size_t)(row0 + ai * 128 + m * 16) * 512 + colt + bj * 128;
                        const f32x4 z0 = acc[ai][bj][m][0] + b0, z1 = acc[ai][bj][m][1] + b1; f32x4 o0, o1;
#pragma unroll
                        for (int j = 0; j < 4; ++j) { o0[j] = -0.6065306597126334f * sigmoidf_(z0[j]); o1[j] = -0.6065306597126334f * sigmoidf_(z1[j]); }
                        u32x4 w; w.x = cvt2(o0[0], o0[1]); w.y = cvt2(o0[2], o0[3]); w.z = cvt2(o1[0], o1[1]); w.w = cvt2(o1[2], o1[3]);
                        *(u32x4*)(rowp) = w; }
                asm volatile("" ::: "memory");
            }
        } else {
            const bool isa = (u.pn < 4);
#pragma unroll
            for (int bj = 0; bj < 2; ++bj) {
                f32x4 b0 = (f32x4){0.f, 0.f, 0.f, 0.f}, b1 = (f32x4){0.f, 0.f, 0.f, 0.f};
                if (isa) { b0 = *(const f32x4*)(a0 + (colt - 512) + bj * 128); b1 = *(const f32x4*)(a0 + (colt - 512) + bj * 128 + 4); }
#pragma unroll
                for (int ai = 0; ai < 2; ++ai)
#pragma unroll
                    for (int m = 0; m < 4; ++m) { bf16_t* rowp = ag + (size_t)(row0 + ai * 128 + m * 16) * 1024 + (colt - 512) + bj * 128;
                        f32x4 v0 = acc[ai][bj][m][0] + b0, v1 = acc[ai][bj][m][1] + b1;
                        if (isa) {
#pragma unroll
                            for (int j = 0; j < 4; ++j) { v0[j] = sigmoidf_(v0[j]); v1[j] = sigmoidf_(v1[j]); } }
                        u32x4 w; w.x = cvt2(v0[0], v0[1]); w.y = cvt2(v0[2], v0[3]); w.z = cvt2(v1[0], v1[1]); w.w = cvt2(v1[2], v1[3]);
                        *(u32x4*)(rowp) = w; }
                asm volatile("" ::: "memory");
            }
        }
    }
};
struct EpiWo {
    static constexpr bool PERM = true;
    bf16_t* mix;
    __device__ __forceinline__ void operator()(const f32x4 (&acc)[2][2][4][2], const Unit& u, int wr, int wc, int fr, int fq) const {
        const int row0 = u.pm * 256 + wr * 64 + fr, col0 = u.pn * 256 + wc * 32 + 8 * fq;
#pragma unroll
        for (int ai = 0; ai < 2; ++ai)
#pragma unroll
            for (int m = 0; m < 4; ++m) { bf16_t* rowp = mix + (size_t)(row0 + ai * 128 + m * 16) * DM + col0;
#pragma unroll
                for (int bj = 0; bj < 2; ++bj) { const f32x4 v0 = acc[ai][bj][m][0], v1 = acc[ai][bj][m][1]; u32x4 w;
                    w.x = cvt2(v0[0], v0[1]); w.y = cvt2(v0[2], v0[3]); w.z = cvt2(v1[0], v1[1]); w.w = cvt2(v1[2], v1[3]);
                    *(u32x4*)(rowp + bj * 128) = w; } }
    }
};
struct EpiBf {
    static constexpr bool PERM = true;
    bf16_t* O; int ldc;
    __device__ __forceinline__ void operator()(const f32x4 (&acc)[2][2][4][2], const Unit& u, int wr, int wc, int fr, int fq) const {
        const int row0 = u.pm * 256 + wr * 64 + fr, col0 = u.pn * 256 + wc * 32 + 8 * fq;
#pragma unroll
        for (int ai = 0; ai < 2; ++ai)
#pragma unroll
            for (int m = 0; m < 4; ++m) { bf16_t* rowp = O + (size_t)(row0 + ai * 128 + m * 16) * ldc + col0;
#pragma unroll
                for (int bj = 0; bj < 2; ++bj) { const f32x4 v0 = acc[ai][bj][m][0], v1 = acc[ai][bj][m][1]; u32x4 w;
                    w.x = cvt2(v0[0], v0[1]); w.y = cvt2(v0[2], v0[3]); w.z = cvt2(v1[0], v1[1]); w.w = cvt2(v1[2], v1[3]);
                    *(u32x4*)(rowp + bj * 128) = w; } }
    }
};
struct EpiPle {
    static constexpr bool PERM = true;
    bf16_t* O; int ldc; const bf16_t* x1b;
    __device__ __forceinline__ void operator()(const f32x4 (&acc)[2][2][4][2], const Unit& u, int wr, int wc, int fr, int fq) const {
        const int row0 = u.pm * 256 + wr * 64 + fr, col0 = u.pn * 256 + wc * 32 + 8 * fq;
#pragma unroll
        for (int ai = 0; ai < 2; ++ai) {
            u32x4 pv[4][2], xv[4][2];
#pragma unroll
            for (int m = 0; m < 4; ++m)
#pragma unroll
                for (int bj = 0; bj < 2; ++bj) { const size_t off = (size_t)(row0 + ai * 128 + m * 16) * ldc + col0 + bj * 128; pv[m][bj] = *(const u32x4*)(O + off); xv[m][bj] = *(const u32x4*)(x1b + off); }
#pragma unroll
            for (int m = 0; m < 4; ++m)
#pragma unroll
                for (int bj = 0; bj < 2; ++bj) { const f32x4 a0 = acc[ai][bj][m][0], a1 = acc[ai][bj][m][1]; const u32x4 p = pv[m][bj], x = xv[m][bj]; u32x4 w;
                    w.x = cvt2(ALPHA * bf_lo(x.x) + sigmoidf_(a0[0]) * bf_lo(p.x), ALPHA * bf_hi(x.x) + sigmoidf_(a0[1]) * bf_hi(p.x));
                    w.y = cvt2(ALPHA * bf_lo(x.y) + sigmoidf_(a0[2]) * bf_lo(p.y), ALPHA * bf_hi(x.y) + sigmoidf_(a0[3]) * bf_hi(p.y));
                    w.z = cvt2(ALPHA * bf_lo(x.z) + sigmoidf_(a1[0]) * bf_lo(p.z), ALPHA * bf_hi(x.z) + sigmoidf_(a1[1]) * bf_hi(p.z));
                    w.w = cvt2(ALPHA * bf_lo(x.w) + sigmoidf_(a1[2]) * bf_lo(p.w), ALPHA * bf_hi(x.w) + sigmoidf_(a1[3]) * bf_hi(p.w));
                    *(u32x4*)(O + (size_t)(row0 + ai * 128 + m * 16) * ldc + col0 + bj * 128) = w; }
            asm volatile("" ::: "memory");
        }
    }
};
struct EpiGU {
    static constexpr bool PERM = true;
    bf16_t* hdn;
    __device__ __forceinline__ void operator()(const f32x4 (&acc)[2][2][4][2], const Unit& u, int wr, int wc, int fr, int fq) const {
        const int row0 = u.pm * 256 + wr * 64 + fr, col0 = u.pn * 128 + wc * 32 + 8 * fq;
#pragma unroll
        for (int ai = 0; ai < 2; ++ai)
#pragma unroll
            for (int m = 0; m < 4; ++m) { bf16_t* rowp = hdn + (size_t)(row0 + ai * 128 + m * 16) * DEXP + col0; float h[8];
#pragma unroll
                for (int n = 0; n < 2; ++n)
#pragma unroll
                    for (int j = 0; j < 4; ++j) { const float gt = acc[ai][0][m][n][j], up = acc[ai][1][m][n][j]; h[4 * n + j] = gt * sigmoidf_(gt) * up; }
                u32x4 w; w.x = cvt2(h[0], h[1]); w.y = cvt2(h[2], h[3]); w.z = cvt2(h[4], h[5]); w.w = cvt2(h[6], h[7]);
                *(u32x4*)rowp = w; }
    }
};
struct EpiDown {
    static constexpr bool PERM = true;
    bf16_t* lo; bf16_t* hi; const int* la; const float* lw; const LAS unsigned char* tile_e; const LAS unsigned* rs; const LAS unsigned* cnt;
    __device__ __forceinline__ void operator()(const f32x4 (&acc)[2][2][4][2], const Unit& u, int wr, int wc, int fr, int fq) const {
        const int row0 = u.pm * 256 + wr * 64 + fr, col0 = u.pn * 256 + wc * 32 + 8 * fq;
        const unsigned e = tile_e[u.pm], rs_e = rs[e], cn_e = cnt[e];
        int asg[2][4]; float wv[2][4];
#pragma unroll
        for (int ai = 0; ai < 2; ++ai)
#pragma unroll
            for (int m = 0; m < 4; ++m) { const unsigned j = (unsigned)(row0 + ai * 128 + m * 16) - rs_e; const bool ok = j < cn_e; const unsigned li = e * 65536u + (ok ? j : 0u);
                asg[ai][m] = ok ? la[li] : -1; wv[ai][m] = ok ? lw[li] : 0.f; }
#pragma unroll
        for (int ai = 0; ai < 2; ++ai)
#pragma unroll
            for (int m = 0; m < 4; ++m) { const int ag_ = asg[ai][m]; const float w = wv[ai][m];
                if (ag_ >= 0) { bf16_t* rowp = lo + (size_t)ag_ * DM + col0;
#pragma unroll
                    for (int bj = 0; bj < 2; ++bj) { const f32x4 v0 = acc[ai][bj][m][0] * w, v1 = acc[ai][bj][m][1] * w; u32x4 o;
                        o.x = cvt2(v0[0], v0[1]); o.y = cvt2(v0[2], v0[3]); o.z = cvt2(v1[0], v1[1]); o.w = cvt2(v1[2], v1[3]);
                        *(u32x4*)(rowp + bj * 128) = o; } } }
    }
};

__device__ __forceinline__ void ph_lora_act(Frame& F) {
    const int gt = F.vcu * 512 + F.tid, NGT = F.G * 512;
    const bf16_t* l1 = (const bf16_t*)(F.ws + WS_LORA1); bf16_t* act = (bf16_t*)(F.ws + WS_Y);
    for (int i = gt; i < NTOK * 32; i += NGT) {
        const int t = i >> 5, c8 = (i & 31) * 8; const bool first = (t % SEQ) == 0;
        int ca, cb, mode;
        if (c8 < 64) { ca = c8; cb = 64 + c8; mode = 0; } else if (c8 < 128) { ca = 128 + (c8 - 64); cb = 192 + (c8 - 64); mode = 1; } else { ca = 256 + (c8 - 128); cb = 384 + (c8 - 128); mode = 2; }
        const u32x4 wa = *(const u32x4*)(l1 + (size_t)t * NL1 + ca);
        u32x4 wb = (u32x4){0u, 0u, 0u, 0u};
        if (!first) wb = *(const u32x4*)(l1 + (size_t)(t - 1) * NL1 + cb);
        float a[8];
        a[0] = bf_lo(wa.x) + bf_lo(wb.x); a[1] = bf_hi(wa.x) + bf_hi(wb.x); a[2] = bf_lo(wa.y) + bf_lo(wb.y); a[3] = bf_hi(wa.y) + bf_hi(wb.y);
        a[4] = bf_lo(wa.z) + bf_lo(wb.z); a[5] = bf_hi(wa.z) + bf_hi(wb.z); a[6] = bf_lo(wa.w) + bf_lo(wb.w); a[7] = bf_hi(wa.w) + bf_hi(wb.w);
        float o[8];
#pragma unroll
        for (int j = 0; j < 8; ++j) {
            const float sg = sigmoidf_(mode == 0 ? 2.0f * a[j] : a[j]);
            o[j] = (mode == 0) ? 2.0f * sg - 1.0f : (mode == 1) ? a[j] : sg; }
        u32x4 w; w.x = pk2(o[0], o[1]); w.y = pk2(o[2], o[3]); w.z = pk2(o[4], o[5]); w.w = pk2(o[6], o[7]);
        *(u32x4*)(act + (size_t)t * KL2 + c8) = w;
    }
}

__device__ __forceinline__ int sigma64(int i) { return (i & ~31) | (((i >> 2) & 3) << 3) | (((i >> 4) & 1) << 2) | (i & 3); }
__device__ __forceinline__ bf16x8 mk8(unsigned a, unsigned b, unsigned c, unsigned d) { u32x4 v; v.x = a; v.y = b; v.z = c; v.w = d; return __builtin_bit_cast(bf16x8, v); }
#define MFMA16(A, B, C) __builtin_amdgcn_mfma_f32_16x16x32_bf16((A), (B), (C), 0, 0, 0)

template <int CTRL> __device__ __forceinline__ float dppf(float v) { return __builtin_bit_cast(float, __builtin_amdgcn_update_dpp(0, __builtin_bit_cast(int, v), CTRL, 0xf, 0xf, true)); }
template <int CTRL, int ROWMASK> __device__ __forceinline__ float dppf_rm(float v) { return __builtin_bit_cast(float, __builtin_amdgcn_update_dpp(0, __builtin_bit_cast(int, v), CTRL, ROWMASK, 0xf, false)); }
__device__ __forceinline__ float wave_sum_u(float v) {
    v += dppf<0xB1>(v); v += dppf<0x4E>(v); v += dppf<0x141>(v); v += dppf<0x140>(v);
    v += dppf_rm<0x142, 0xA>(v);
    v += dppf_rm<0x143, 0xC>(v);
    return __builtin_bit_cast(float, __builtin_amdgcn_readlane(__builtin_bit_cast(int, v), 63));
}
__device__ __forceinline__ bf16_t bf1(float x) { return __builtin_bit_cast(bf16_t, (__bf16)x); }

#define SC_BAR() do { asm volatile("s_waitcnt lgkmcnt(0)" ::: "memory"); __builtin_amdgcn_s_barrier(); asm volatile("" ::: "memory"); } while (0)
constexpr int S3_RS = 144, S3_TS = 144;
constexpr int S3_AP = 0, S3_RP = 2304, S3_BN = 4608, S3_VN = 9216, S3_BR = 11520, S3_KR = 13824, S3_Y = 11520, S3_LF = 11520, S3_LKA = 16128, S3_TA = 17152, S3_LRA = 18176, S3_GC = 19200, S3_BON = 19456;
constexpr int S3_SL = 19584, S3_CT = 8 * S3_SL;
static_assert(S3_AP + 16 * S3_TS <= S3_RP && S3_RP + 16 * S3_TS <= S3_BN && S3_BN + 32 * S3_RS <= S3_VN && S3_VN + 16 * S3_RS <= S3_BR && S3_BR + 16 * S3_TS <= S3_KR && S3_KR + 16 * S3_TS <= S3_LKA && S3_Y + 4096 <= S3_LKA && S3_BON + 64 <= S3_SL, "scan slot map");
static_assert(S3_CT + 6 * 64 * 4 <= LDSCTL_OFF, "scan slots fit below the LDS control words");
__device__ __forceinline__ float rowsum4(float v) {
    const unsigned b = __builtin_bit_cast(unsigned, v);
    const auto r = __builtin_amdgcn_permlane16_swap(b, b, false, false);
    const float s = __builtin_bit_cast(float, (unsigned)r[0]) + __builtin_bit_cast(float, (unsigned)r[1]);
    const unsigned sb = __builtin_bit_cast(unsigned, s);
    const auto q = __builtin_amdgcn_permlane32_swap(sb, sb, false, false);
    return __builtin_bit_cast(float, (unsigned)q[0]) + __builtin_bit_cast(float, (unsigned)q[1]);
}
template <int CTRL> __device__ __forceinline__ float dpp_old(float oldv, float v) { return __builtin_bit_cast(float, __builtin_amdgcn_update_dpp(__builtin_bit_cast(int, oldv), __builtin_bit_cast(int, v), CTRL, 0xf, 0xf, false)); }
__device__ __forceinline__ u32x2 tr_read1(unsigned a) { u32x2 r; asm volatile("ds_read_b64_tr_b16 %0, %1\n\ts_waitcnt lgkmcnt(0)" : "=v"(r) : "v"(a) : "memory"); return r; }
__device__ __forceinline__ void tr_read_bk(unsigned a, bf16x8 (&bk)[4]) {
    u32x2 r[8];
    asm volatile("ds_read_b64_tr_b16 %0, %8\n\tds_read_b64_tr_b16 %1, %8 offset:576\n\tds_read_b64_tr_b16 %2, %8 offset:32\n\tds_read_b64_tr_b16 %3, %8 offset:608\n\t"
                 "ds_read_b64_tr_b16 %4, %8 offset:64\n\tds_read_b64_tr_b16 %5, %8 offset:640\n\tds_read_b64_tr_b16 %6, %8 offset:96\n\tds_read_b64_tr_b16 %7, %8 offset:672\n\ts_waitcnt lgkmcnt(0)"
                 : "=v"(r[0]), "=v"(r[1]), "=v"(r[2]), "=v"(r[3]), "=v"(r[4]), "=v"(r[5]), "=v"(r[6]), "=v"(r[7]) : "v"(a) : "memory");
#pragma unroll
    for (int m = 0; m < 4; ++m) bk[m] = mk8(r[2 * m].x, r[2 * m].y, r[2 * m + 1].x, r[2 * m + 1].y);
}
static_assert(4 * S3_RS == 576, "tr_read_bk offsets");

__device__ __forceinline__ void s3_gram_t(LAS unsigned char* myslot, int cc, int g) {
                f32x4 d1 = (f32x4){0.f, 0.f, 0.f, 0.f}, d2 = d1, d3 = d1, d4 = d1;
#pragma unroll
                for (int ks = 0; ks < 2; ++ks) {
                    const int off = cc * S3_TS + (32 * ks + 8 * g) * 2;
                    const bf16x8 fa = *(const LAS bf16x8*)(myslot + S3_AP + off), fr = *(const LAS bf16x8*)(myslot + S3_RP + off);
                    const bf16x8 fb = *(const LAS bf16x8*)(myslot + S3_BR + off), fk = *(const LAS bf16x8*)(myslot + S3_KR + off);
                    d1 = MFMA16(fa, fb, d1); d2 = MFMA16(fa, fk, d2); d3 = MFMA16(fr, fb, d3); d4 = MFMA16(fr, fk, d4);
                }
                asm volatile("" ::: "memory");
                const int colA = 8 * (cc >> 2) + (cc & 3);
#pragma unroll
                for (int reg = 0; reg < 4; ++reg) {
                    const int tt = 4 * g + reg, s = cc; const bool lo = s < tt, le = s <= tt;
                    *(LAS float*)(myslot + S3_LF + (tt * 16 + s) * 4) = lo ? d1[reg] : 0.f;
                    *(LAS bf16_t*)(myslot + S3_LKA + tt * 64 + (colA + 4) * 2) = bf1(lo ? d2[reg] : 0.f);
                    *(LAS bf16_t*)(myslot + S3_LKA + tt * 64 + colA * 2) = (bf16_t)0;
                    *(LAS bf16_t*)(myslot + S3_LRA + tt * 64 + colA * 2) = bf1(le ? d3[reg] : 0.f);
                    *(LAS bf16_t*)(myslot + S3_LRA + tt * 64 + (colA + 4) * 2) = bf1(le ? d4[reg] : 0.f);
                }
                LDS_WAIT();
                float Tc[16];
#pragma unroll
                for (int tt = 0; tt < 16; ++tt) {
                    float pa[4]; pa[0] = (cc == tt) ? 1.f : 0.f; pa[1] = 0.f; pa[2] = 0.f; pa[3] = 0.f;
#pragma unroll
                    for (int s4 = 0; s4 < (tt + 3) / 4; ++s4) { const f32x4 l4 = *(const LAS f32x4*)(myslot + S3_LF + (tt * 16 + 4 * s4) * 4);
#pragma unroll
                        for (int j = 0; j < 4; ++j) if (4 * s4 + j < tt) pa[j] += l4[j] * Tc[4 * s4 + j]; }
                    Tc[tt] = (pa[0] + pa[1]) + (pa[2] + pa[3]);
                }
                if (g == 0) {
#pragma unroll
                    for (int tt = 0; tt < 16; ++tt) { *(LAS bf16_t*)(myslot + S3_TA + tt * 64 + colA * 2) = bf1(Tc[tt]); *(LAS bf16_t*)(myslot + S3_TA + tt * 64 + (colA + 4) * 2) = (bf16_t)0; }
                }
}

__device__ __forceinline__ void ph_scan_pipe3(Frame& F) {
    if (F.vcu & 1) return;
    const int bh = F.vcu >> 1, b = bh >> 3, h = bh & 7, lane = F.lane, wave = F.wave;
    const int g = lane >> 4, cc = lane & 15;
    const bf16_t* proj = (const bf16_t*)(F.ws + WS_P); const bf16_t* lwb = (const bf16_t*)(F.ws + WS_LW); const bf16_t* ag = (const bf16_t*)(F.ws + WS_AG);
    bf16_t* ycat = (bf16_t*)(F.ws + WS_Y);
    constexpr int NR = SEQ / 64;
    for (int i = F.tid; i < 6 * 64; i += 512) { const int w_ = i >> 6, c_ = h * 64 + (i & 63);
        *(LAS float*)(F.lds + S3_CT + i * 4) = (w_ < 3) ? F.in[I_MURKV][w_ * 512 + c_] : (w_ == 3) ? F.in[I_KK][c_] : (w_ == 4) ? F.in[I_KA][c_] : F.in[I_RK][c_]; }
    __syncthreads();
    if (wave >= 4) {
        const int pw = wave - 4, t = cc;
        u32x4 qr[2], qk[2], qv[2], qa[2], pr[2], pk[2], pv[2], qlw[2];
#define S3_PREFETCH(cidx_) do { const int tl_ = 16 * (cidx_) + t; const size_t T_ = (size_t)b * SEQ + tl_; \
            const bf16_t* rp_ = proj + T_ * NPROJ + h * 64 + 16 * g; const bf16_t* ap_ = ag + T_ * 1024 + h * 64 + 16 * g; const bf16_t* lp_ = lwb + T_ * 512 + h * 64 + 16 * g; \
            _Pragma("unroll") for (int e_ = 0; e_ < 2; ++e_) { qr[e_] = *(const u32x4*)(rp_ + 8 * e_); qk[e_] = *(const u32x4*)(rp_ + 512 + 8 * e_); qv[e_] = *(const u32x4*)(rp_ + 1024 + 8 * e_); qa[e_] = *(const u32x4*)(ap_ + 8 * e_); } \
            _Pragma("unroll") for (int e_ = 0; e_ < 2; ++e_) qlw[e_] = *(const u32x4*)(lp_ + 8 * e_); \
            if (tl_ > 0) { _Pragma("unroll") for (int e_ = 0; e_ < 2; ++e_) { pr[e_] = *(const u32x4*)(rp_ - NPROJ + 8 * e_); pk[e_] = *(const u32x4*)(rp_ - NPROJ + 512 + 8 * e_); pv[e_] = *(const u32x4*)(rp_ - NPROJ + 1024 + 8 * e_); } } \
            else { _Pragma("unroll") for (int e_ = 0; e_ < 2; ++e_) { pr[e_] = (u32x4){0u, 0u, 0u, 0u}; pk[e_] = pr[e_]; pv[e_] = pr[e_]; } } } while (0)
        const LAS float* ct = (const LAS float*)(F.lds + S3_CT) + 16 * g;
        typedef float f32x2 __attribute__((ext_vector_type(2)));
#define S3_BF2(arr, j2) ((f32x2){bf_lo(arr[(j2) >> 2][(j2) & 3]), bf_hi(arr[(j2) >> 2][(j2) & 3])})
        f32x2 rr[8], kk[8], kq[8], av[8]; float cl[16]; unsigned vpk[8]; float ss = 0.f, bon = 0.f;
        auto stage1 = [&]() __attribute__((always_inline)) {
            f32x2 ssv = (f32x2){0.f, 0.f}, bov = ssv;
#pragma unroll
            for (int j4 = 0; j4 < 4; ++j4) {
                const f32x4 mur = *(const LAS f32x4*)(ct + 4 * j4), muk = *(const LAS f32x4*)(ct + 64 + 4 * j4), muv = *(const LAS f32x4*)(ct + 128 + 4 * j4);
                const f32x4 ckk = *(const LAS f32x4*)(ct + 192 + 4 * j4), cka = *(const LAS f32x4*)(ct + 256 + 4 * j4), crk = *(const LAS f32x4*)(ct + 320 + 4 * j4);
#pragma unroll
                for (int e = 0; e < 2; ++e) { const int j2 = 2 * j4 + e;
                    const f32x2 mur2 = (f32x2){mur[2 * e], mur[2 * e + 1]}, muk2 = (f32x2){muk[2 * e], muk[2 * e + 1]}, muv2 = (f32x2){muv[2 * e], muv[2 * e + 1]};
                    const f32x2 ckk2 = (f32x2){ckk[2 * e], ckk[2 * e + 1]}, cka2 = (f32x2){cka[2 * e], cka[2 * e + 1]}, crk2 = (f32x2){crk[2 * e], crk[2 * e + 1]};
                    const f32x2 r_ = S3_BF2(qr, j2), k_ = S3_BF2(qk, j2), v_ = S3_BF2(qv, j2); av[j2] = S3_BF2(qa, j2);
                    rr[j2] = r_ + (S3_BF2(pr, j2) - r_) * mur2; const f32x2 kx = k_ + (S3_BF2(pk, j2) - k_) * muk2; const f32x2 vv = v_ + (S3_BF2(pv, j2) - v_) * muv2;
                    kk[j2] = kx * ckk2; ssv += kk[j2] * kk[j2];
                    kq[j2] = kx * (1.0f + (av[j2] - 1.0f) * cka2); bov += rr[j2] * kq[j2] * crk2;
                    vpk[j2] = cvt2(vv[0], vv[1]); }
            }
#pragma unroll
            for (int j = 0; j < 16; ++j) cl[j] = (j & 1) ? bf_hi(qlw[j >> 3][(j >> 1) & 3]) : bf_lo(qlw[j >> 3][(j >> 1) & 3]);
            ss = rowsum4(ssv[0] + ssv[1]); bon = rowsum4(bov[0] + bov[1]);
        };
        S3_PREFETCH(pw);
        stage1();
#pragma unroll 1
        for (int R = 0; R <= NR; ++R) {
            __builtin_amdgcn_s_setprio(3);
            if (R < NR) {
                LAS unsigned char* myslot = F.lds + (4 * (R & 1) + pw) * S3_SL;
                if (R + 1 < NR) { S3_PREFETCH(4 * (R + 1) + pw); }
                { u32x4 w0, w1; w0.x = vpk[0]; w0.y = vpk[1]; w0.z = vpk[2]; w0.w = vpk[3]; w1.x = vpk[4]; w1.y = vpk[5]; w1.z = vpk[6]; w1.w = vpk[7];
                  *(LAS u32x4*)(myslot + S3_VN + t * S3_RS + 32 * g) = w0; *(LAS u32x4*)(myslot + S3_VN + t * S3_RS + 32 * g + 16) = w1; }
                const float nrm = rsqrtf(fmaxf(ss, 1e-24f));
                if (g == 0) *(LAS float*)(myslot + S3_BON + t * 4) = bon;
#pragma unroll
                for (int j = 0; j < 16; ++j) cl[j] += dppf<0x111>(cl[j]);
#pragma unroll
                for (int j = 0; j < 16; ++j) cl[j] += dppf<0x112>(cl[j]);
#pragma unroll
                for (int j = 0; j < 16; ++j) cl[j] += dppf<0x114>(cl[j]);
#pragma unroll
                for (int j = 0; j < 16; ++j) cl[j] += dppf<0x118>(cl[j]);
                const int rowb = (8 * (t >> 2) + (t & 3)) * S3_RS + 32 * g;
#pragma unroll
                for (int hf = 0; hf < 2; ++hf) {
                    f32x2 ec[4], ei[4], ep[4];
#pragma unroll
                    for (int e = 0; e < 4; ++e) { const int j2 = 4 * hf + e; ec[e][0] = __builtin_amdgcn_exp2f(1.4426950408889634f * cl[2 * j2]); ec[e][1] = __builtin_amdgcn_exp2f(1.4426950408889634f * cl[2 * j2 + 1]); }
#pragma unroll
                    for (int e = 0; e < 4; ++e) { ei[e][0] = __builtin_amdgcn_rcpf(ec[e][0]); ei[e][1] = __builtin_amdgcn_rcpf(ec[e][1]); ep[e][0] = dpp_old<0x111>(1.0f, ec[e][0]); ep[e][1] = dpp_old<0x111>(1.0f, ec[e][1]); }
                    if (t == 15) {
#pragma unroll
                        for (int q = 0; q < 2; ++q) *(LAS f32x4*)(myslot + S3_GC + (16 * g + 8 * hf + 4 * q) * 4) = (f32x4){ec[2 * q][0], ec[2 * q][1], ec[2 * q + 1][0], ec[2 * q + 1][1]}; }
                    unsigned apk[4], rpk[4], bpk[4], kpk[4];
#pragma unroll
                    for (int e = 0; e < 4; ++e) { const int j2 = 4 * hf + e;
                        const f32x2 kn = kk[j2] * nrm;
                        const f32x2 ah = -kn * ep[e], rh = rr[j2] * ec[e], bv = kn * av[j2] * ei[e], kv = kq[j2] * ei[e];
                        apk[e] = cvt2(ah[0], ah[1]); rpk[e] = cvt2(rh[0], rh[1]); bpk[e] = cvt2(bv[0], bv[1]); kpk[e] = cvt2(kv[0], kv[1]); }
#pragma unroll
                    for (int q2 = 0; q2 < 2; ++q2) { const int q = 2 * hf + q2; const int off = t * S3_TS + (32 * (g >> 1) + 8 * q + 4 * (g & 1)) * 2;
                        u32x2 w; w.x = apk[2 * q2]; w.y = apk[2 * q2 + 1]; *(LAS u32x2*)(myslot + S3_AP + off) = w;
                        w.x = rpk[2 * q2]; w.y = rpk[2 * q2 + 1]; *(LAS u32x2*)(myslot + S3_RP + off) = w;
                        w.x = bpk[2 * q2]; w.y = bpk[2 * q2 + 1]; *(LAS u32x2*)(myslot + S3_BR + off) = w;
                        w.x = kpk[2 * q2]; w.y = kpk[2 * q2 + 1]; *(LAS u32x2*)(myslot + S3_KR + off) = w; }
                    { u32x4 w0; w0.x = bpk[0]; w0.y = bpk[1]; w0.z = bpk[2]; w0.w = bpk[3]; *(LAS u32x4*)(myslot + S3_BN + rowb + 16 * hf) = w0;
                      w0.x = kpk[0]; w0.y = kpk[1]; w0.z = kpk[2]; w0.w = kpk[3]; *(LAS u32x4*)(myslot + S3_BN + 4 * S3_RS + rowb + 16 * hf) = w0; }
                }
            }
            SC_BAR();
            __builtin_amdgcn_s_setprio(0);
            if (R + 1 < NR) stage1();
            SC_BAR();
        }
#undef S3_PREFETCH
#undef S3_BF
#undef S3_BF2
    } else {
        const int es = lane >> 2, jq = lane & 3, jb = 16 * wave;
        float lnxg[16], lnxb[16];
#pragma unroll
        for (int j = 0; j < 16; ++j) { lnxg[j] = F.in[I_LNXG][h * 64 + 16 * jq + j]; lnxb[j] = F.in[I_LNXB][h * 64 + 16 * jq + j]; }
        f32x4 St[4];
#pragma unroll
        for (int m = 0; m < 4; ++m) St[m] = (f32x4){0.f, 0.f, 0.f, 0.f};
        bf16x8 Sb0 = mk8(0u, 0u, 0u, 0u), Sb1 = mk8(0u, 0u, 0u, 0u);
        const unsigned trl = (unsigned)((cc >> 2) * S3_RS + (cc & 3) * 8);
        SC_BAR();
        s3_gram_t(F.lds + (0 + wave) * S3_SL, cc, g);
        SC_BAR();
#pragma unroll 1
        for (int R = 0; R < NR; ++R) {
            const size_t tE = (size_t)b * SEQ + 16 * (4 * R + wave) + es;
            const u32x4 g0 = *(const u32x4*)(ag + tE * 1024 + 512 + h * 64 + 16 * jq), g1 = *(const u32x4*)(ag + tE * 1024 + 512 + h * 64 + 16 * jq + 8);
#pragma unroll 1
            for (int q = 0; q < 4; ++q) {
                const LAS unsigned char* sl = F.lds + (4 * (R & 1) + q) * S3_SL;
                const unsigned slb = (unsigned)(__UINTPTR_TYPE__)sl;
                const bf16x8 a0 = *(const LAS bf16x8*)(sl + S3_AP + cc * S3_TS + (8 * g) * 2), a1 = *(const LAS bf16x8*)(sl + S3_AP + cc * S3_TS + (32 + 8 * g) * 2);
                const bf16x8 r0 = *(const LAS bf16x8*)(sl + S3_RP + cc * S3_TS + (8 * g) * 2), r1 = *(const LAS bf16x8*)(sl + S3_RP + cc * S3_TS + (32 + 8 * g) * 2);
                const bf16x8 lka = *(const LAS bf16x8*)(sl + S3_LKA + cc * 64 + 16 * g), ta = *(const LAS bf16x8*)(sl + S3_TA + cc * 64 + 16 * g), lra = *(const LAS bf16x8*)(sl + S3_LRA + cc * 64 + 16 * g);
                f32x4 gc[4];
#pragma unroll
                for (int m = 0; m < 4; ++m) gc[m] = *(const LAS f32x4*)(sl + S3_GC + (16 * m + 4 * g) * 4);
                const u32x2 vd = tr_read1(slb + S3_VN + 4 * g * S3_RS + trl + 32 * wave);
                bf16x8 bkt[4]; tr_read_bk(slb + S3_BN + 8 * g * S3_RS + trl, bkt);
                const f32x4 z4 = (f32x4){0.f, 0.f, 0.f, 0.f};
                f32x4 X = MFMA16(lka, mk8(0u, 0u, vd.x, vd.y), z4); X = MFMA16(a0, Sb0, X); X = MFMA16(a1, Sb1, X);
                f32x4 Y = MFMA16(r0, Sb0, z4); Y = MFMA16(r1, Sb1, Y);
                const f32x4 U = MFMA16(ta, mk8(cvt2(X[0], X[1]), cvt2(X[2], X[3]), 0u, 0u), z4);
                const bf16x8 Bu = mk8(cvt2(U[0], U[1]), cvt2(U[2], U[3]), vd.x, vd.y);
#pragma unroll
                for (int m = 0; m < 4; ++m) St[m] = MFMA16(bkt[m], Bu, St[m]) * gc[m];
                Y = MFMA16(lra, Bu, Y);
                Sb0 = mk8(cvt2(St[0][0], St[0][1]), cvt2(St[0][2], St[0][3]), cvt2(St[1][0], St[1][1]), cvt2(St[1][2], St[1][3]));
                Sb1 = mk8(cvt2(St[2][0], St[2][1]), cvt2(St[2][2], St[2][3]), cvt2(St[3][0], St[3][1]), cvt2(St[3][2], St[3][3]));
#pragma unroll
                for (int reg = 0; reg < 4; ++reg) *(LAS float*)((LAS unsigned char*)sl + S3_Y + ((4 * g + reg) * 64 + jb + cc) * 4) = Y[reg];
            }
            SC_BAR();
            __builtin_amdgcn_s_setprio(3);
            {
                const LAS unsigned char* sl = F.lds + (4 * (R & 1) + wave) * S3_SL;
                const size_t t = tE;
                f32x4 y[4]; float s1 = 0.f;
#pragma unroll
                for (int k = 0; k < 4; ++k) { y[k] = *(const LAS f32x4*)(sl + S3_Y + (es * 64 + 16 * jq + 4 * k) * 4); s1 += (y[k][0] + y[k][1]) + (y[k][2] + y[k][3]); }
                s1 += dppf<0xB1>(s1); s1 += dppf<0x4E>(s1);
                const float mean = s1 * (1.0f / 64.0f); float s2 = 0.f;
#pragma unroll
                for (int k = 0; k < 4; ++k) { y[k] = y[k] - mean; s2 += (y[k][0] * y[k][0] + y[k][1] * y[k][1]) + (y[k][2] * y[k][2] + y[k][3] * y[k][3]); }
                s2 += dppf<0xB1>(s2); s2 += dppf<0x4E>(s2);
                const float rstd = rsqrtf(s2 * (1.0f / 64.0f) + LNX_EPS);
                const float bon = *(const LAS float*)(sl + S3_BON + es * 4);
                const u32x4 vv0 = *(const LAS u32x4*)(sl + S3_VN + es * S3_RS + 32 * jq), vv1 = *(const LAS u32x4*)(sl + S3_VN + es * S3_RS + 32 * jq + 16);
                float gg[16], vv[16];
                gg[0] = bf_lo(g0.x); gg[1] = bf_hi(g0.x); gg[2] = bf_lo(g0.y); gg[3] = bf_hi(g0.y); gg[4] = bf_lo(g0.z); gg[5] = bf_hi(g0.z); gg[6] = bf_lo(g0.w); gg[7] = bf_hi(g0.w);
                gg[8] = bf_lo(g1.x); gg[9] = bf_hi(g1.x); gg[10] = bf_lo(g1.y); gg[11] = bf_hi(g1.y); gg[12] = bf_lo(g1.z); gg[13] = bf_hi(g1.z); gg[14] = bf_lo(g1.w); gg[15] = bf_hi(g1.w);
                vv[0] = bf_lo(vv0.x); vv[1] = bf_hi(vv0.x); vv[2] = bf_lo(vv0.y); vv[3] = bf_hi(vv0.y); vv[4] = bf_lo(vv0.z); vv[5] = bf_hi(vv0.z); vv[6] = bf_lo(vv0.w); vv[7] = bf_hi(vv0.w);
                vv[8] = bf_lo(vv1.x); vv[9] = bf_hi(vv1.x); vv[10] = bf_lo(vv1.y); vv[11] = bf_hi(vv1.y); vv[12] = bf_lo(vv1.z); vv[13] = bf_hi(vv1.z); vv[14] = bf_lo(vv1.w); vv[15] = bf_hi(vv1.w);
                float o[16];
#pragma unroll
                for (int j = 0; j < 16; ++j) o[j] = (y[j >> 2][j & 3] * rstd * lnxg[j] + lnxb[j] + bon * vv[j]) * gg[j];
                u32x4 w0, w1; w0.x = cvt2(o[0], o[1]); w0.y = cvt2(o[2], o[3]); w0.z = cvt2(o[4], o[5]); w0.w = cvt2(o[6], o[7]);
                w1.x = cvt2(o[8], o[9]); w1.y = cvt2(o[10], o[11]); w1.z = cvt2(o[12], o[13]); w1.w = cvt2(o[14], o[15]);
                *(u32x4*)(ycat + t * DM + h * 64 + 16 * jq) = w0; *(u32x4*)(ycat + t * DM + h * 64 + 16 * jq + 8) = w1;
            }
            if (R + 1 < NR) s3_gram_t(F.lds + (4 * ((R + 1) & 1) + wave) * S3_SL, cc, g);
            __builtin_amdgcn_s_setprio(0);
            SC_BAR();
        }
    }
    __syncthreads();
}

constexpr int AT_OST = 0, AT_OST_CH = 4352, AT_ML = 69632, AT_BIAS = 71680, AT_V = 77824, AT_VW = 5120, AT_VRS = 160;
constexpr int AT_BLD = 512, AT_BOFF = 192;
static_assert(AT_V + 8 * AT_VW <= LDSCTL_OFF, "attention LDS map");
constexpr int MW_UNIT = 164;
constexpr int CW_ATTQ = 8192 + 192;
constexpr int CW_GUDONE = 8192 + 224;
constexpr int CW_STAMP = 8192 + 1024;
typedef short at_s16x4 __attribute__((ext_vector_type(4)));
__device__ __forceinline__ u32x2 at_tr16(unsigned a) { return __builtin_bit_cast(u32x2, __builtin_amdgcn_ds_read_tr16_b64_v4i16((LAS at_s16x4*)(__UINTPTR_TYPE__)a)); }
__device__ __forceinline__ void tr_read8(unsigned a, bf16x8 (&vt)[4]) {
#pragma unroll
    for (int mm = 0; mm < 4; ++mm) { const u32x2 r0 = at_tr16(a + 32 * mm), r1 = at_tr16(a + 2560 + 32 * mm); vt[mm] = mk8(r0.x, r0.y, r1.x, r1.y); }
}
static_assert(16 * AT_VRS == 2560, "tr_read8 offsets");
constexpr int AT2_OST = 0, AT2_OST_CH = 2176, AT2_ML = 34816, AT2_BIAS = 36864, AT2_V = 43008;
constexpr int AT_KRS = 144, AT_KW = 32 * AT_KRS, AT_WAVE = 2 * AT_VW + AT_KW;
static_assert(AT2_V + 8 * AT_WAVE <= LDSCTL_OFF, "paired attention LDS map");
constexpr int AT2_SK = AT2_V, AT2_SV = AT2_V + 12 * AT_KW;
static_assert(AT2_SV + 12 * AT_VW <= LDSCTL_OFF, "shared phase-A tiles");
struct AtSt { float m, l; f32x4 o[4]; };
__device__ __forceinline__ float rowmax4(float v) {
    const unsigned b = __builtin_bit_cast(unsigned, v);
    const auto r = __builtin_amdgcn_permlane16_swap(b, b, false, false);
    const float f0 = __builtin_bit_cast(float, (unsigned)r[0]), f1 = __builtin_bit_cast(float, (unsigned)r[1]);
    const float m = f0 > f1 ? f0 : f1;
    const unsigned mb = __builtin_bit_cast(unsigned, m);
    const auto q = __builtin_amdgcn_permlane32_swap(mb, mb, false, false);
    const float g0 = __builtin_bit_cast(float, (unsigned)q[0]), g1 = __builtin_bit_cast(float, (unsigned)q[1]);
    return g0 > g1 ? g0 : g1;
}
struct AtRegs { bf16x8 qfX[2], qfY[2]; u32x4 krX[4], krY[4], vrX[4], vrY[4]; };
template <bool SHARED, int YSHIFT, bool PRE, int NEXT, bool LDSK = false>
__device__ __forceinline__ void attn_pair(const bf16_t* projb, int h, int qposX, int qposY, int lq, int lk_start, int ntiles, int dil, int residX, int residY,
                                          const LAS float* biasp, LAS unsigned char* vbufX, LAS unsigned char* vbufY, LAS unsigned char* kst, int lane, AtSt& X, AtSt& Y,
                                          AtRegs& R, int n_qposX, int n_qposY, int n_lk_start, int n_dil, int n_residX, int n_residY) {
    const int g = lane >> 4, c = lane & 15;
    bf16x8 (&qfX)[2] = R.qfX; bf16x8 (&qfY)[2] = R.qfY;
    if (!PRE) {
#pragma unroll
        for (int ks = 0; ks < 2; ++ks) { qfX[ks] = *(const bf16x8*)(projb + (size_t)qposX * NPROJ + 1536 + h * 64 + 32 * ks + 8 * g); qfY[ks] = *(const bf16x8*)(projb + (size_t)qposY * NPROJ + 1536 + h * 64 + 32 * ks + 8 * g); }
    }
    const int kt0 = (lk_start < 0) ? ((-lk_start) >> 5) : 0;
    __builtin_assume(kt0 < ntiles);
    bf16x8 kfX[2][2], kfY[2][2]; u32x4 (&krX)[4] = R.krX; u32x4 (&krY)[4] = R.krY; u32x4 (&vrX)[4] = R.vrX; u32x4 (&vrY)[4] = R.vrY;
    constexpr int ROWB = NPROJ * 2;
    const char* hb = (const char*)(projb + h * 64);
    const unsigned koX = (unsigned)(((lane >> 3) * dil + residX) * ROWB + (2048 + 8 * (lane & 7)) * 2), koY = (unsigned)(((lane >> 3) * dil + residY) * ROWB + (2048 + 8 * (lane & 7)) * 2);
    const int step8 = 8 * dil * ROWB;
    const __amdgpu_buffer_rsrc_t rs = __builtin_amdgcn_make_buffer_rsrc((void*)hb, 0, 0x7fffffff, 0x00020000);
#define AT2_LOADKV(kr, vr, so, ko) do { \
        _Pragma("unroll") for (int k_ = 0; k_ < 4; ++k_) { kr[k_] = __builtin_amdgcn_raw_buffer_load_b128(rs, ko, (so) + k_ * step8, 0); vr[k_] = __builtin_amdgcn_raw_buffer_load_b128(rs, ko + 1024u, (so) + k_ * step8, 0); } } while (0)
#define AT2_LOADFIRST_G(kr, vr, resid_, lks_, kt0_, dil_) do { \
        _Pragma("unroll") for (int k_ = 0; k_ < 4; ++k_) { int lk_ = (lks_) + 32 * (kt0_) + 8 * k_ + (lane >> 3); lk_ = lk_ < 0 ? 0 : lk_; const unsigned o_ = (unsigned)((lk_ * (dil_) + (resid_)) * ROWB + (2048 + 8 * (lane & 7)) * 2); \
            kr[k_] = __builtin_amdgcn_raw_buffer_load_b128(rs, o_, 0, 0); vr[k_] = __builtin_amdgcn_raw_buffer_load_b128(rs, o_ + 1024u, 0, 0); } } while (0)
#define AT2_LOADFIRST(kr, vr, resid_) AT2_LOADFIRST_G(kr, vr, resid_, lk_start, kt0, dil)
#define AT2_KFRAGS(kf, kr) do { \
        _Pragma("unroll") for (int k_ = 0; k_ < 4; ++k_) *(LAS u32x4*)(kst + ((lane >> 3) + 8 * k_) * AT_KRS + (lane & 7) * 16) = kr[k_]; \
        _Pragma("unroll") for (int st = 0; st < 2; ++st) { kf[st][0] = *(const LAS bf16x8*)(kst + (16 * st + c) * AT_KRS + g * 16); kf[st][1] = *(const LAS bf16x8*)(kst + (16 * st + c) * AT_KRS + (4 + g) * 16); } } while (0)
    if (!PRE && !LDSK && kt0 < ntiles) { AT2_LOADFIRST(krX, vrX, residX); if (!SHARED) AT2_LOADFIRST(krY, vrY, residY); }
    const bool negfirst = (lk_start + 32 * kt0) < 0;
    const unsigned trX = (unsigned)(__UINTPTR_TYPE__)vbufX + (unsigned)((4 * g + ((lane & 15) >> 2)) * AT_VRS + (lane & 3) * 8);
    const unsigned trY = (unsigned)(__UINTPTR_TYPE__)vbufY + (unsigned)((4 * g + ((lane & 15) >> 2)) * AT_VRS + (lane & 3) * 8);
    constexpr float C2 = 0.125f * 1.4426950408889634f;
#pragma unroll 1
    for (int kt = kt0; kt < ntiles; ++kt) {
        if (!LDSK) {
#pragma unroll
            for (int k = 0; k < 4; ++k) { const int id = lane + 64 * k; *(LAS u32x4*)(vbufX + (id >> 3) * AT_VRS + (id & 7) * 16) = vrX[k]; if (!SHARED) *(LAS u32x4*)(vbufY + (id >> 3) * AT_VRS + (id & 7) * 16) = vrY[k]; }
        }
        const int lkb = lk_start + 32 * kt + 4 * g;
        const int rel0 = lq - lkb;
        const LAS float* bp = biasp + (rel0 - 19 + AT_BOFF);
        float biaX[2][4], biaY[2][4];
#pragma unroll
        for (int st = 0; st < 2; ++st)
#pragma unroll
            for (int reg = 0; reg < 4; ++reg) biaX[st][reg] = bp[19 - 16 * st - reg];
#pragma unroll
        for (int reg = 0; reg < 4; ++reg) {
            if (SHARED && YSHIFT == 16) { biaY[0][reg] = bp[35 - reg]; biaY[1][reg] = biaX[0][reg]; }
            else if (SHARED) { biaY[0][reg] = reg ? biaX[0][reg - 1] : bp[19 + YSHIFT]; biaY[1][reg] = reg ? biaX[1][reg - 1] : bp[3 + YSHIFT]; }
            else { biaY[0][reg] = biaX[0][reg]; biaY[1][reg] = biaX[1][reg]; }
        }
        if (!LDSK) { AT2_KFRAGS(kfX, krX); if (!SHARED) AT2_KFRAGS(kfY, krY); }
        else { const LAS unsigned char* kt_ = kst + kt * AT_KW;
#pragma unroll
            for (int st = 0; st < 2; ++st) { kfX[st][0] = *(const LAS bf16x8*)(kt_ + (16 * st + c) * AT_KRS + g * 16); kfX[st][1] = *(const LAS bf16x8*)(kt_ + (16 * st + c) * AT_KRS + (4 + g) * 16); } }
        const f32x4 z4 = (f32x4){0.f, 0.f, 0.f, 0.f}; f32x4 sX[2], sY[2];
#pragma unroll
        for (int st = 0; st < 2; ++st) {
            sX[st] = MFMA16(kfX[st][0], qfX[0], z4); sX[st] = MFMA16(kfX[st][1], qfX[1], sX[st]);
            if (SHARED) { sY[st] = MFMA16(kfX[st][0], qfY[0], z4); sY[st] = MFMA16(kfX[st][1], qfY[1], sY[st]); }
            else { sY[st] = MFMA16(kfY[st][0], qfY[0], z4); sY[st] = MFMA16(kfY[st][1], qfY[1], sY[st]); }
        }
        if (kt + 1 < ntiles) { if (!LDSK) { const int so = (lk_start + 32 * (kt + 1)) * dil * ROWB;
            AT2_LOADKV(krX, vrX, so, koX); if (!SHARED) AT2_LOADKV(krY, vrY, so, koY); } }
        else if (NEXT != 0) {
            const int n_kt0 = (n_lk_start < 0) ? ((-n_lk_start) >> 5) : 0;
            if (NEXT == 1) {
#pragma unroll
                for (int ks = 0; ks < 2; ++ks) { qfX[ks] = *(const bf16x8*)(projb + (size_t)n_qposX * NPROJ + 1536 + h * 64 + 32 * ks + 8 * g); qfY[ks] = *(const bf16x8*)(projb + (size_t)n_qposY * NPROJ + 1536 + h * 64 + 32 * ks + 8 * g); }
                AT2_LOADFIRST_G(krX, vrX, n_residX, n_lk_start, n_kt0, n_dil);
            } else { AT2_LOADFIRST_G(krX, vrX, n_residX, n_lk_start, n_kt0, n_dil); AT2_LOADFIRST_G(krY, vrY, n_residY, n_lk_start, n_kt0, n_dil); }
        }
        bf16x8 vt[4], vu[4]; tr_read8(LDSK ? trX + (unsigned)(kt * AT_VW) : trX, vt); if (!SHARED) tr_read8(trY, vu);
        if (negfirst && kt == kt0) {
#pragma unroll
            for (int st = 0; st < 2; ++st)
#pragma unroll
                for (int reg = 0; reg < 4; ++reg) { const bool neg = (lkb + 16 * st + reg) < 0; biaX[st][reg] = neg ? -INFINITY : biaX[st][reg]; biaY[st][reg] = neg ? -INFINITY : biaY[st][reg]; }
        }
        float lgX[2][4], lgY[2][4];
#pragma unroll
        for (int st = 0; st < 2; ++st)
#pragma unroll
            for (int reg = 0; reg < 4; ++reg) { lgX[st][reg] = sX[st][reg] * C2 + biaX[st][reg]; lgY[st][reg] = sY[st][reg] * C2 + biaY[st][reg]; }
        float pX[2][4], pY[2][4]; float psX = 0.f, psY = 0.f;
#pragma unroll
        for (int st = 0; st < 2; ++st)
#pragma unroll
            for (int reg = 0; reg < 4; ++reg) { pX[st][reg] = __builtin_amdgcn_exp2f(lgX[st][reg] - X.m); psX += pX[st][reg];
                                                pY[st][reg] = __builtin_amdgcn_exp2f(lgY[st][reg] - Y.m); psY += pY[st][reg]; }
        if (__builtin_amdgcn_ballot_w64(!(psX <= 256.0f) || !(psY <= 256.0f)) != 0ull) {
            float tmX = fmaxf(fmaxf(lgX[0][0], lgX[0][1]), lgX[0][2]), tmY = fmaxf(fmaxf(lgY[0][0], lgY[0][1]), lgY[0][2]);
            tmX = fmaxf(fmaxf(tmX, lgX[0][3]), lgX[1][0]); tmY = fmaxf(fmaxf(tmY, lgY[0][3]), lgY[1][0]);
            tmX = fmaxf(fmaxf(tmX, lgX[1][1]), lgX[1][2]); tmY = fmaxf(fmaxf(tmY, lgY[1][1]), lgY[1][2]);
            tmX = fmaxf(tmX, lgX[1][3]); tmY = fmaxf(tmY, lgY[1][3]);
            tmX = rowmax4(tmX); tmY = rowmax4(tmY);
            const float mnX = fmaxf(X.m, tmX), mnY = fmaxf(Y.m, tmY);
            const float alX = __builtin_amdgcn_exp2f(X.m - mnX), alY = __builtin_amdgcn_exp2f(Y.m - mnY); X.m = mnX; Y.m = mnY;
            X.l *= alX; Y.l *= alY;
#pragma unroll
            for (int mm = 0; mm < 4; ++mm) { X.o[mm] = X.o[mm] * alX; Y.o[mm] = Y.o[mm] * alY; }
            psX = 0.f; psY = 0.f;
#pragma unroll
            for (int st = 0; st < 2; ++st)
#pragma unroll
                for (int reg = 0; reg < 4; ++reg) { pX[st][reg] = __builtin_amdgcn_exp2f(lgX[st][reg] - mnX); psX += pX[st][reg];
                                                    pY[st][reg] = __builtin_amdgcn_exp2f(lgY[st][reg] - mnY); psY += pY[st][reg]; }
        }
        X.l += psX; Y.l += psY;
        const bf16x8 PbX = mk8(cvt2(pX[0][0], pX[0][1]), cvt2(pX[0][2], pX[0][3]), cvt2(pX[1][0], pX[1][1]), cvt2(pX[1][2], pX[1][3]));
        const bf16x8 PbY = mk8(cvt2(pY[0][0], pY[0][1]), cvt2(pY[0][2], pY[0][3]), cvt2(pY[1][0], pY[1][1]), cvt2(pY[1][2], pY[1][3]));
#pragma unroll
        for (int mm = 0; mm < 4; ++mm) X.o[mm] = MFMA16(vt[mm], PbX, X.o[mm]);
#pragma unroll
        for (int mm = 0; mm < 4; ++mm) Y.o[mm] = MFMA16(SHARED ? vt[mm] : vu[mm], PbY, Y.o[mm]);
    }
#undef AT2_LOADKV
#undef AT2_LOADFIRST
#undef AT2_LOADFIRST_G
#undef AT2_KFRAGS
}

__device__ __forceinline__ void ph_attn_mfma2(Frame& F) {
    const bf16_t* proj = (const bf16_t*)(F.ws + WS_P); bf16_t* ycat = (bf16_t*)(F.ws + WS_Y); const float* bt = (const float*)(F.ws + WS_BIAS);
    const int lane = F.lane, wave = F.wave, g = lane >> 4, c = lane & 15;
    LAS unsigned char* vbufX = F.lds + AT2_V + wave * AT_WAVE; LAS unsigned char* vbufY = vbufX + AT_VW; LAS unsigned char* kst = vbufX + 2 * AT_VW;
    LAS float* biasl = (LAS float*)(F.lds + AT2_BIAS);
    int hload = -1;
    for (;;) {
        if (F.tid == 0) F.MISC[MW_UNIT] = atomicAdd(F.ctl + CW_ATTQ, 1u);
        __syncthreads();
        const int unit = __builtin_amdgcn_readfirstlane((int)F.MISC[MW_UNIT]);
        if (unit >= NB * 8 * 8) break;
        int u, b, h; if (unit < NB * 8 * 7) { h = unit / (NB * 7); const int r_ = unit % (NB * 7); b = r_ / 7; u = 1 + r_ % 7; } else { const int r_ = unit - NB * 8 * 7; h = r_ / NB; b = r_ % NB; u = 0; }
        if (h != hload) { hload = h;
            for (int i = F.tid; i < 3 * AT_BLD; i += 512) { const int p_ = i / AT_BLD, rel_ = (i % AT_BLD) - AT_BOFF; biasl[i] = (rel_ >= 0 && rel_ <= 128) ? 1.4426950408889634f * bt[(p_ * 8 + h) * BIAS_LD + rel_] : -INFINITY; }
            __syncthreads(); }
        const bf16_t* projb = proj + (size_t)b * SEQ * NPROJ;
        AtSt X, Y; AtRegs R;
        const int d0 = (wave & 3) + 8 * (wave >> 2);
        {
            const int base = 256 * u + 32 * wave;
            X.m = -1e30f; X.l = 0.f; Y.m = -1e30f; Y.l = 0.f;
#pragma unroll
            for (int mm = 0; mm < 4; ++mm) { X.o[mm] = (f32x4){0.f, 0.f, 0.f, 0.f}; Y.o[mm] = (f32x4){0.f, 0.f, 0.f, 0.f}; }
            {
                constexpr int ROWB = NPROJ * 2;
#pragma unroll
                for (int ks = 0; ks < 2; ++ks) { R.qfX[ks] = *(const bf16x8*)(projb + (size_t)(base + c) * NPROJ + 1536 + h * 64 + 32 * ks + 8 * g); R.qfY[ks] = *(const bf16x8*)(projb + (size_t)(base + 16 + c) * NPROJ + 1536 + h * 64 + 32 * ks + 8 * g); }
                const __amdgpu_buffer_rsrc_t rs = __builtin_amdgcn_make_buffer_rsrc((void*)(projb + h * 64), 0, 0x7fffffff, 0x00020000);
                u32x4 kr[6], vr[6];
#pragma unroll
                for (int k_ = 0; k_ < 6; ++k_) { const int tt = k_ < 4 ? wave : 8 + (wave >> 1); const int rw = k_ < 4 ? 8 * k_ + (lane >> 3) : 16 * (wave & 1) + 8 * (k_ - 4) + (lane >> 3);
                    int lk_ = 256 * u - 128 + 32 * tt + rw; lk_ = lk_ < 0 ? 0 : lk_; const unsigned o_ = (unsigned)(lk_ * ROWB + (2048 + 8 * (lane & 7)) * 2);
                    kr[k_] = __builtin_amdgcn_raw_buffer_load_b128(rs, o_, 0, 0); vr[k_] = __builtin_amdgcn_raw_buffer_load_b128(rs, o_ + 1024u, 0, 0); }
#pragma unroll
                for (int k_ = 0; k_ < 6; ++k_) { const int tt = k_ < 4 ? wave : 8 + (wave >> 1); const int rw = k_ < 4 ? 8 * k_ + (lane >> 3) : 16 * (wave & 1) + 8 * (k_ - 4) + (lane >> 3);
                    *(LAS u32x4*)(F.lds + AT2_SK + tt * AT_KW + rw * AT_KRS + (lane & 7) * 16) = kr[k_];
                    *(LAS u32x4*)(F.lds + AT2_SV + tt * AT_VW + rw * AT_VRS + (lane & 7) * 16) = vr[k_]; }
                __syncthreads();
            }
            attn_pair<true, 16, true, 1, true>(projb, h, base + c, base + 16 + c, base + c, base - 128, 5, 1, 0, 0, biasl, F.lds + AT2_SV + wave * AT_VW, F.lds + AT2_SV + wave * AT_VW, F.lds + AT2_SK + wave * AT_KW, lane, X, Y,
                                          R, 256 * u + 16 * c + d0, 256 * u + 16 * c + d0 + 4, 64 * u + 61 + (d0 >> 2) - 191, 4, d0 & 3, d0 & 3);
            X.l += __shfl_xor(X.l, 16); X.l += __shfl_xor(X.l, 32); Y.l += __shfl_xor(Y.l, 16); Y.l += __shfl_xor(Y.l, 32);
#pragma unroll
            for (int t2 = 0; t2 < 2; ++t2) { const AtSt& S = t2 ? Y : X; const int ql = 32 * wave + 16 * t2 + c, qp = ql + (ql >> 4);
#pragma unroll
                for (int mm = 0; mm < 4; ++mm) { u32x2 w; w.x = cvt2(S.o[mm][0], S.o[mm][1]); w.y = cvt2(S.o[mm][2], S.o[mm][3]); *(LAS u32x2*)(F.lds + AT2_OST + (mm * 4 + g) * AT2_OST_CH + qp * 8) = w; }
                if (g == 0) { *(LAS float*)(F.lds + AT2_ML + ql * 4) = S.m; *(LAS float*)(F.lds + AT2_ML + 1024 + ql * 4) = S.l; } }
        }
        __syncthreads();
        {
#pragma unroll
            for (int t2 = 0; t2 < 2; ++t2) { AtSt& S = t2 ? Y : X; const int ql = 16 * c + d0 + 4 * t2, qp = ql + (ql >> 4);
                S.m = *(const LAS float*)(F.lds + AT2_ML + ql * 4); S.l = (g == 0) ? *(const LAS float*)(F.lds + AT2_ML + 1024 + ql * 4) : 0.f;
#pragma unroll
                for (int mm = 0; mm < 4; ++mm) { const u32x2 w = *(const LAS u32x2*)(F.lds + AT2_OST + (mm * 4 + g) * AT2_OST_CH + qp * 8);
                    S.o[mm] = (f32x4){bf_lo(w.x), bf_hi(w.x), bf_lo(w.y), bf_hi(w.y)}; } }
            const int qposX = 256 * u + 16 * c + d0, qposY = qposX + 4;
            attn_pair<true, 1, true, 2>(projb, h, qposX, qposY, 64 * u + 4 * c + (d0 >> 2), 64 * u + 61 + (d0 >> 2) - 191, 6, 4, d0 & 3, d0 & 3, biasl + AT_BLD, vbufX, vbufX, kst, lane, X, Y,
                                        R, qposX, qposY, 16 * u - 144, 16, d0, d0 + 4);
            attn_pair<false, 0, true, 0>(projb, h, qposX, qposY, 16 * u + c, 16 * u - 144, 5, 16, d0, d0 + 4, biasl + 2 * AT_BLD, vbufX, vbufY, kst, lane, X, Y, R, 0, 0, 0, 1, 0, 0);
#pragma unroll
            for (int t2 = 0; t2 < 2; ++t2) { AtSt& S = t2 ? Y : X; float l = S.l; l += __shfl_xor(l, 16); l += __shfl_xor(l, 32); const float inv = 1.0f / l;
                bf16_t* op = ycat + ((size_t)b * SEQ + qposX + 4 * t2) * DM + 512 + h * 64 + 4 * g;
#pragma unroll
                for (int mm = 0; mm < 4; ++mm) { u32x2 w; w.x = cvt2(S.o[mm][0] * inv, S.o[mm][1] * inv); w.y = cvt2(S.o[mm][2] * inv, S.o[mm][3] * inv); *(u32x2*)(op + 16 * mm) = w; } }
        }
        __syncthreads();
        PRegs PQ; late_p_loads(F, unit, PQ);
        moe_weight_items3(F, unit * MOE_ROUNDS_PER_UNIT * NWAVES + wave, (LAS float*)(F.lds + AT2_V + wave * 8448));
        late_p_stores(F, unit, PQ);
        late_prologue_items(F, unit, (LAS float*)(F.lds + AT2_V + wave * 8448));
    }
}

constexpr int LR_XH = 0, LR_XL = 33280, LR_RS = 2064, LR_PP = 66560, LR_LG = 91136, LR_GB = 94208, LR_TOKE = 102400, LR_TOKW = 103424;
#define LR_BAR() do { asm volatile("s_waitcnt lgkmcnt(0)" ::: "memory"); __builtin_amdgcn_s_barrier(); asm volatile("" ::: "memory"); } while (0)
__device__ __forceinline__ void ph_ln1_router_mfma(Frame& F) {
    const int lane = F.lane, wave = F.wave, g = lane >> 4, c = lane & 15;
    if (F.tid < 32) F.MISC[MW_HIST + F.tid] = 0u;
    bf16_t* x1b = (bf16_t*)(F.ws + WS_Y);
    int* toke = (int*)(F.ws + WS_TOKE); float* tokw = (float*)(F.ws + WS_TOKW);
    const bf16_t* wrt = (const bf16_t*)(F.ws + WS_WRT);
    bf16x8 wf[2][4][3];
#pragma unroll
    for (int hl = 0; hl < 2; ++hl)
#pragma unroll
        for (int ks = 0; ks < 4; ++ks)
#pragma unroll
            for (int nt = 0; nt < 3; ++nt) wf[hl][ks][nt] = *(const bf16x8*)(wrt + (size_t)hl * 48 * 1024 + (size_t)(16 * nt + c) * 1024 + 128 * wave + 32 * ks + 8 * g);
    for (int i = F.tid; i < DM / 4; i += 512) { *(LAS f32x4*)(F.lds + LR_GB + i * 16) = *(const f32x4*)(F.in[I_LN1G] + 4 * i); *(LAS f32x4*)(F.lds + LR_GB + 4096 + i * 16) = *(const f32x4*)(F.in[I_LN1B] + 4 * i); }
    float rbias0, rbias1;
    { const int c0 = F.tid % 48, c1 = (F.tid + 512) % 48;
      rbias0 = (c0 < 4) ? F.in[I_RGB][c0] : (c0 < 36) ? F.in[I_REB][c0 - 4] : 0.f;
      rbias1 = (c1 < 4) ? F.in[I_RGB][c1] : (c1 < 36) ? F.in[I_REB][c1 - 4] : 0.f; }
    const int rows_per_wg = NTOK / F.G;
    const int ngrp = rows_per_wg / 16;
    __syncthreads();
    f32x4 pxv[2][4]; u32x2 pmw[2][4];
#define LR_PREFETCH(grp_) do { _Pragma("unroll") for (int rr_ = 0; rr_ < 2; ++rr_) { const int row_ = F.vcu * rows_per_wg + 16 * (grp_) + 2 * wave + rr_; \
        const float* xin_ = F.in[I_X] + (size_t)row_ * DM + 4 * lane; const bf16_t* mx_ = (const bf16_t*)(F.ws + WS_HDN) + (size_t)row_ * DM + 4 * lane; \
        _Pragma("unroll") for (int j_ = 0; j_ < 4; ++j_) { pxv[rr_][j_] = __builtin_nontemporal_load((const f32x4*)(xin_ + 256 * j_)); pmw[rr_][j_] = __builtin_nontemporal_load((const u32x2*)(mx_ + 256 * j_)); } } } while (0)
    LR_PREFETCH(0);
#pragma unroll 1
    for (int grp = 0; grp < ngrp; ++grp) {
        const int row0 = F.vcu * rows_per_wg + 16 * grp;
#pragma unroll
        for (int rr = 0; rr < 2; ++rr) {
            const int rl = 2 * wave + rr, row = row0 + rl;
            f32x4 v[4]; float s = 0.f;
#pragma unroll
            for (int j = 0; j < 4; ++j) { const f32x4 xv = pxv[rr][j]; const u32x2 mw = pmw[rr][j];
                v[j] = xv * ALPHA + (f32x4){bf_lo(mw.x), bf_hi(mw.x), bf_lo(mw.y), bf_hi(mw.y)}; s += (v[j][0] + v[j][1]) + (v[j][2] + v[j][3]); }
            const float mean = wave_sum_u(s) * (1.0f / DM); float s2 = 0.f;
#pragma unroll
            for (int j = 0; j < 4; ++j) { v[j] = v[j] - mean; s2 += (v[j][0] * v[j][0] + v[j][1] * v[j][1]) + (v[j][2] * v[j][2] + v[j][3] * v[j][3]); }
            const float rstd = rsqrtf(wave_sum_u(s2) * (1.0f / DM) + LN_EPS);
#pragma unroll
            for (int j = 0; j < 4; ++j) { const f32x4 gvj = *(const LAS f32x4*)(F.lds + LR_GB + (lane + 64 * j) * 16), bvj = *(const LAS f32x4*)(F.lds + LR_GB + 4096 + (lane + 64 * j) * 16);
                v[j] = v[j] * rstd * gvj + bvj;
                u32x2 wh; wh.x = cvt2(v[j][0], v[j][1]); wh.y = cvt2(v[j][2], v[j][3]);
                *(u32x2*)(x1b + (size_t)row * DM + 4 * lane + 256 * j) = wh;
                float lo[4];
                lo[0] = v[j][0] - bf_lo(wh.x); lo[1] = v[j][1] - bf_hi(wh.x); lo[2] = v[j][2] - bf_lo(wh.y); lo[3] = v[j][3] - bf_hi(wh.y);
                u32x2 wl; wl.x = cvt2(lo[0], lo[1]); wl.y = cvt2(lo[2], lo[3]);
                *(LAS u32x2*)(F.lds + LR_XH + rl * LR_RS + (4 * lane + 256 * j) * 2) = wh;
                *(LAS u32x2*)(F.lds + LR_XL + rl * LR_RS + (4 * lane + 256 * j) * 2) = wl; }
        }
        if (grp + 1 < ngrp) LR_PREFETCH(grp + 1);
        LR_BAR();
        {
            f32x4 acc[3];
#pragma unroll
            for (int nt = 0; nt < 3; ++nt) acc[nt] = (f32x4){0.f, 0.f, 0.f, 0.f};
#pragma unroll
            for (int ks = 0; ks < 4; ++ks) {
                const int off = c * LR_RS + (128 * wave + 32 * ks + 8 * g) * 2;
                const bf16x8 ah = *(const LAS bf16x8*)(F.lds + LR_XH + off), al = *(const LAS bf16x8*)(F.lds + LR_XL + off);
#pragma unroll
                for (int nt = 0; nt < 3; ++nt) { acc[nt] = MFMA16(ah, wf[0][ks][nt], acc[nt]); acc[nt] = MFMA16(al, wf[0][ks][nt], acc[nt]); acc[nt] = MFMA16(ah, wf[1][ks][nt], acc[nt]); }
            }
#pragma unroll
            for (int nt = 0; nt < 3; ++nt)
#pragma unroll
                for (int reg = 0; reg < 4; ++reg) *(LAS float*)(F.lds + LR_PP + ((wave * 16 + 4 * g + reg) * 48 + 16 * nt + c) * 4) = acc[nt][reg];
        }
        LR_BAR();
        for (int i = F.tid, it_ = 0; i < 16 * 48; i += 512, ++it_) { float a = it_ ? rbias1 : rbias0;
#pragma unroll
            for (int w = 0; w < 8; ++w) a += *(const LAS float*)(F.lds + LR_PP + (w * 16 * 48 + i) * 4);
            *(LAS float*)(F.lds + LR_LG + i * 4) = a; }
        LR_BAR();
        if (F.tid < 16) {
            const int row = row0 + F.tid; const LAS float* lgp = (const LAS float*)(F.lds + LR_LG + F.tid * 48 * 4);
            float gl[4];
#pragma unroll
            for (int i = 0; i < 4; ++i) gl[i] = lgp[i];
            int grpi = 0; float gm = gl[0];
#pragma unroll
            for (int i = 1; i < 4; ++i) if (gl[i] > gm) { gm = gl[i]; grpi = i; }
            float se = 0.f;
#pragma unroll
            for (int i = 0; i < 4; ++i) se += __expf(gl[i] - gm);
            const float wg = 1.0f / se;
            float le[8];
#pragma unroll
            for (int i = 0; i < 8; ++i) le[i] = lgp[4 + grpi * 8 + i];
            int i0 = 0; float v0 = le[0];
#pragma unroll
            for (int i = 1; i < 8; ++i) if (le[i] > v0) { v0 = le[i]; i0 = i; }
            int i1 = (i0 == 0) ? 1 : 0; float v1 = (i0 == 0) ? le[1] : le[0];
#pragma unroll
            for (int i = 0; i < 8; ++i) if (i != i0 && le[i] > v1) { v1 = le[i]; i1 = i; }
            const float e1 = __expf(v1 - v0); const float w0 = wg / (1.0f + e1), w1 = wg * e1 / (1.0f + e1);
            const int ex0 = grpi * 8 + i0, ex1 = grpi * 8 + i1;
            const unsigned ix0 = atomicAdd((unsigned*)&F.MISC[MW_HIST + ex0], 1u), ix1 = atomicAdd((unsigned*)&F.MISC[MW_HIST + ex1], 1u);
            const int al = 2 * (16 * grp + (int)F.tid);
            *(LAS unsigned*)(F.lds + LR_TOKE + al * 4) = (unsigned)ex0 | (ix0 << 5); *(LAS unsigned*)(F.lds + LR_TOKE + al * 4 + 4) = (unsigned)ex1 | (ix1 << 5);
            *(LAS float*)(F.lds + LR_TOKW + al * 4) = w0; *(LAS float*)(F.lds + LR_TOKW + al * 4 + 4) = w1;
        }
    }
    __syncthreads();
    if (F.tid < 32) { const unsigned hc = F.MISC[MW_HIST + F.tid]; F.MISC[MW_LBASE + F.tid] = hc ? atomicAdd(F.ctl + CW_CNT + F.tid, hc) : 0u; }
    __syncthreads();
    { int* la = (int*)(F.ws + WS_LA); float* lw = (float*)(F.ws + WS_LWT);
      const int per = NTOK / F.G, base = F.vcu * per;
      for (int a = F.tid; a < 2 * per; a += 512) {
          const unsigned pk = *(const LAS unsigned*)(F.lds + LR_TOKE + a * 4); const unsigned e = pk & 31u, idx = pk >> 5;
          const unsigned li = e * 65536u + F.MISC[MW_LBASE + e] + idx;
          la[li] = 2 * (base + (a >> 1)) + (a & 1); lw[li] = *(const LAS float*)(F.lds + LR_TOKW + a * 4); } }
}

__device__ __forceinline__ void ph_tiles_local(Frame& F) {
    if (F.wave == 0) {
        const unsigned cnt = (F.lane < 32) ? __hip_atomic_load(F.ctl + CW_CNT + F.lane, RLX_AGENT) : 0u;
        const unsigned pc = ((cnt + 255u) >> 8) << 8; unsigned inc = pc;
#pragma unroll
        for (int d = 1; d < 32; d <<= 1) { const unsigned t = __shfl_up(inc, d); if (F.lane >= d) inc += t; }
        const unsigned rs = inc - pc;
        if (F.lane < 32) { F.MISC[MW_CNT + F.lane] = cnt; F.MISC[MW_RS + F.lane] = rs;
            volatile LAS unsigned char* tb = (volatile LAS unsigned char*)(F.MISC + MW_TILEB);
            for (unsigned q = 0; q < (pc >> 8); ++q) tb[(rs >> 8) + q] = (unsigned char)F.lane;
            if (F.lane == 31) F.MISC[MW_NTILES] = (rs + pc) >> 8; }
    }
    __syncthreads();
}

__device__ __forceinline__ void ph_final(Frame& F) {
    const int gw = F.vcu * NWAVES + F.wave, NGW = F.G * NWAVES, lane = F.lane;
    const bf16_t* x1b = (const bf16_t*)(F.ws + WS_Y); const bf16_t* mo = (const bf16_t*)(F.ws + WS_X1); const bf16_t* ple = (const bf16_t*)(F.ws + WS_PLE);
    f32x4 gv[4], bv[4];
#pragma unroll
    for (int j = 0; j < 4; ++j) { gv[j] = *(const f32x4*)(F.in[I_LN2G] + 4 * lane + 256 * j); bv[j] = *(const f32x4*)(F.in[I_LN2B] + 4 * lane + 256 * j); }
    for (int row = gw; row < NTOK; row += NGW) {
        const bf16_t* m0 = mo + (size_t)(2 * row) * DM;
        f32x4 v[4]; float s = 0.f;
#pragma unroll
        for (int j = 0; j < 4; ++j) { const int cix = 4 * lane + 256 * j;
            const u32x2 pw = __builtin_nontemporal_load((const u32x2*)(ple + (size_t)row * DM + cix));
            const u32x2 a = __builtin_nontemporal_load((const u32x2*)(m0 + cix)), b = __builtin_nontemporal_load((const u32x2*)(m0 + DM + cix));
            f32x4 mv; mv[0] = bf_lo(a.x) + bf_lo(b.x); mv[1] = bf_hi(a.x) + bf_hi(b.x); mv[2] = bf_lo(a.y) + bf_lo(b.y); mv[3] = bf_hi(a.y) + bf_hi(b.y);
            const f32x4 pv = (f32x4){bf_lo(pw.x), bf_hi(pw.x), bf_lo(pw.y), bf_hi(pw.y)};
            v[j] = mv + pv; s += (v[j][0] + v[j][1]) + (v[j][2] + v[j][3]); }
        const float mean = wave_sum_u(s) * (1.0f / DM); float s2 = 0.f;
#pragma unroll
        for (int j = 0; j < 4; ++j) { v[j] = v[j] - mean; s2 += (v[j][0] * v[j][0] + v[j][1] * v[j][1]) + (v[j][2] * v[j][2] + v[j][3] * v[j][3]); }
        const float rstd = rsqrtf(wave_sum_u(s2) * (1.0f / DM) + LN_EPS);
#pragma unroll
        for (int j = 0; j < 4; ++j) __builtin_nontemporal_store(v[j] * rstd * gv[j] + bv[j], (f32x4*)(F.out + (size_t)row * DM + 4 * lane + 256 * j));
    }
}

constexpr int NPHASE = 10;
struct Args { const float* in[33]; float* out; unsigned char* ws; int ph_lo, ph_hi; };
#ifndef PH_MASK
#define PH_MASK 0x3ff
#endif
__global__ void __launch_bounds__(NWAVES * 64, 2) hymba_fwd(const Args args) {
    extern __shared__ __attribute__((aligned(16))) unsigned char lds[];
    Frame F;
    F.lds = (LAS unsigned char*)lds;
    F.MISC = (volatile LAS unsigned*)(F.lds + MISC_OFF);
    F.tid = threadIdx.x; F.lane = F.tid & 63; F.wave = __builtin_amdgcn_readfirstlane(F.tid >> 6);
    F.G = gridDim.x; { const int bx = blockIdx.x; F.vcu = (F.G % 8 == 0) ? (bx % 8) * (F.G / 8) + bx / 8 : bx; }
    F.ws = args.ws; F.ctl = (unsigned*)(args.ws + WS_CTL); F.out = args.out;
    F.in = args.in;
    for (int u = F.tid; u < (LDS_BYTES - LDSCTL_OFF) / 4; u += NWAVES * 64) ((LAS unsigned*)(F.lds + LDSCTL_OFF))[u] = 0u;
    __syncthreads();
    const int lo = args.ph_lo, hi = args.ph_hi;
    XcdBarrier bar; bar.bar = F.ctl + CW_BAR; bar.x = 0; bar.st = nullptr;
    if (hi - lo > 1) bar = xcd_barrier_post(F.ctl + CW_BAR, F.MISC + MW_BAR);
#define IN(k) (((PH_MASK >> (k)) & 1) && lo <= (k) && (k) < hi)
#ifdef PROBE_T
#define STAMP(k) do { if (blockIdx.x == 0 && F.tid == 0) { const unsigned long long ts_ = wall_clock64(); F.ctl[CW_STAMP + 2 * (k)] = (unsigned)ts_; F.ctl[CW_STAMP + 2 * (k) + 1] = (unsigned)(ts_ >> 32); } } while (0)
#else
#define STAMP(k) do { } while (0)
#endif
#define SEAM(k) do { if (IN(k) && IN((k) + 1)) xcd_barrier(bar); STAMP((k) + 1); } while (0)
    LAS unsigned char* ring = F.lds + RING_OFF;

    STAMP(0);
    if (IN(0)) { ph_prologue(F); } SEAM(0);
    if (IN(1)) {
        pg8::Gemm g{(const bf16_t*)(F.ws + WS_XB), (const bf16_t*)(F.ws + WS_WINT), DM}; pg8::StaticOrder S; S.init(NTOK, NEXT, F.G, (int)blockIdx.x);
        EpiProj E{(bf16_t*)(F.ws + WS_P), (bf16_t*)(F.ws + WS_LORA1)};
        pg8::gemm_phase<EpiProj, pg8::StaticOrder>(ring, g, S, E);
        ph_prologue_small(F);
    } SEAM(1);
    if (IN(2)) { ph_lora_act(F); } SEAM(2);
    if (IN(3)) {
        pg8::Gemm g{(const bf16_t*)(F.ws + WS_Y), (const bf16_t*)(F.ws + WS_W2T), KL2}; pg8::LoraOrder S; S.init(NTOK, NL2, F.G, (int)blockIdx.x);
        EpiDag E{(bf16_t*)(F.ws + WS_LW), (bf16_t*)(F.ws + WS_AG), F.in[I_W0], F.in[I_A0]};
        pg8::gemm_phase<EpiDag, pg8::LoraOrder>(ring, g, S, E);
    } SEAM(3);
    if (IN(4)) { ph_scan_pipe3(F); ph_attn_mfma2(F); } SEAM(4);
    if (IN(5)) {
        pg8::Gemm g{(const bf16_t*)(F.ws + WS_Y), (const bf16_t*)(F.ws + WS_WOT), DM}; pg8::StaticOrder S; S.init(NTOK, DM, F.G, (int)blockIdx.x);
        EpiWo E{(bf16_t*)(F.ws + WS_HDN)};
        pg8::gemm_phase<EpiWo, pg8::StaticOrder>(ring, g, S, E);
    } SEAM(5);
    if (IN(6)) { ph_ln1_router_mfma(F); } SEAM(6);
    STAMP(8);
    if (IN(8)) { ph_tiles_local(F);
        {
            pg8::MoeOrder<true> S{(const LAS unsigned char*)(F.lds + MISC_OFF + MW_TILEB * 4), (const LAS unsigned*)(F.lds + MISC_OFF + MW_RS * 4), (const LAS unsigned*)(F.lds + MISC_OFF + MW_CNT * 4), (const int*)(F.ws + WS_LA), (int)F.MISC[MW_NTILES], F.G, F.vcu};
            pg8::Gemm g{(const bf16_t*)(F.ws + WS_Y), (const bf16_t*)(F.ws + WS_WGUT), DM};
            EpiGU E{(bf16_t*)(F.ws + WS_HDN)};
            pg8::gemm_phase<EpiGU, pg8::MoeOrder<true>>(ring, g, S, E);
        }
        if (F.tid == 0) {
            __builtin_amdgcn_fence(__ATOMIC_RELEASE, "agent");
            asm volatile("s_waitcnt vmcnt(0)" ::: "memory");
            (void)__hip_atomic_fetch_add(F.ctl + CW_GUDONE, 1u, RLX_AGENT);
        }
        {
            pg8::Gemm g{(const bf16_t*)(F.ws + WS_PB), (const bf16_t*)(F.ws + WS_PT), 256}; pg8::StaticOrder S; S.init(NTOK, DM, F.G, (int)blockIdx.x);
            EpiBf E{(bf16_t*)(F.ws + WS_PLE), DM};
            pg8::gemm_phase<EpiBf, pg8::StaticOrder>(ring, g, S, E);
        }
        {
            pg8::Gemm g{(const bf16_t*)(F.ws + WS_Y), (const bf16_t*)(F.ws + WS_GT), DM}; pg8::StaticOrder S; S.init(NTOK, DM, F.G, (int)blockIdx.x);
            EpiPle E{(bf16_t*)(F.ws + WS_PLE), DM, (const bf16_t*)(F.ws + WS_Y)};
            pg8::gemm_phase<EpiPle, pg8::StaticOrder>(ring, g, S, E);
        }
        if (F.tid == 0) {
            unsigned* barw = F.ctl + CW_BAR;
            XB_SPIN(__hip_atomic_load(F.ctl + CW_GUDONE, RLX_AGENT) < (unsigned)F.G, barw);
            __builtin_amdgcn_fence(__ATOMIC_ACQUIRE, "agent");
            asm volatile("s_waitcnt vmcnt(0)" ::: "memory");
        }
        __syncthreads();
        {
            pg8::MoeDownOrder S{(const LAS unsigned char*)(F.lds + MISC_OFF + MW_TILEB * 4), (int)F.MISC[MW_NTILES], F.G, F.vcu};
            pg8::Gemm g{(const bf16_t*)(F.ws + WS_HDN), (const bf16_t*)(F.ws + WS_WDT), DEXP};
            EpiDown E{(bf16_t*)(F.ws + WS_X1), (bf16_t*)(F.ws + WS_X1), (const int*)(F.ws + WS_LA), (const float*)(F.ws + WS_LWT), (const LAS unsigned char*)(F.lds + MISC_OFF + MW_TILEB * 4), (const LAS unsigned*)(F.lds + MISC_OFF + MW_RS * 4), (const LAS unsigned*)(F.lds + MISC_OFF + MW_CNT * 4)};
            pg8::gemm_phase<EpiDown, pg8::MoeDownOrder>(ring, g, S, E);
        }
    } SEAM(8);
    if (IN(9)) { ph_final(F); }
#undef IN
#undef SEAM
}

extern "C" void kernel_launch(void* const* d_in, const int* in_sizes, int n_in, void* d_out, int out_size, void* d_ws, size_t ws_size, hipStream_t stream) {
    static int grid = 0;
    if (grid == 0) {
        if (n_in != 33 || in_sizes[0] != NTOK * DM || out_size != NTOK * DM || ws_size < WS_END) { fprintf(stderr, "kernel_launch: unexpected problem (n_in %d, in0 %d, out %d, ws %zu)\n", n_in, n_in > 0 ? in_sizes[0] : -1, out_size, ws_size); grid = -1; return; }
        int dev = 0, cus = 0;
        if (hipGetDevice(&dev) != hipSuccess || hipDeviceGetAttribute(&cus, hipDeviceAttributeMultiprocessorCount, dev) != hipSuccess) { grid = -1; return; }
        if (hipFuncSetAttribute((const void*)hymba_fwd, hipFuncAttributeMaxDynamicSharedMemorySize, LDS_BYTES) != hipSuccess) { fprintf(stderr, "kernel_launch: hipFuncSetAttribute failed\n"); grid = -1; return; }
        int per_cu = 0;
        if (hipOccupancyMaxActiveBlocksPerMultiprocessor(&per_cu, (const void*)hymba_fwd, NWAVES * 64, LDS_BYTES) != hipSuccess || per_cu < 1) fprintf(stderr, "kernel_launch: occupancy query reports %d\n", per_cu);
        (void)hipGetLastError();
        grid = cus;
    }
    if (grid < 0) return;
    if (hipMemsetAsync((char*)d_ws + WS_CTL, 0, CTL_ZERO_BYTES, stream) != hipSuccess) return;
    Args a{};
    for (int i = 0; i < 33; ++i) a.in[i] = (const float*)d_in[i];
    a.out = (float*)d_out; a.ws = (unsigned char*)d_ws;
#if MK_ONE_LAUNCH
    a.ph_lo = 0; a.ph_hi = NPHASE;
    hipLaunchKernelGGL(hymba_fwd, dim3(grid), dim3(NWAVES * 64), LDS_BYTES, stream, a);
#else
    for (int ph = 0; ph < NPHASE; ++ph) { a.ph_lo = ph; a.ph_hi = ph + 1; hipLaunchKernelGGL(hymba_fwd, dim3(grid), dim3(NWAVES * 64), LDS_BYTES, stream, a); }
#endif
}
```
